# Optimizing an MI355X kernel written in HIP

```python
import jax, jax.numpy as jnp
from jax import lax
import numpy as np

D_MODEL = 1024
BATCH = 8
SEQ = 2048
DEPTH = 2
DEC_BATCH = 16
DEC_SEQ = 16
PAST_LEN = 4096

CHUNK = 64
N_META = 16
D_CONV_A = D_MODEL
CONV_A_WIDTH = 31
D_CONV_B = D_MODEL
CONV_B_WIDTH = 3
D_HID = -(-8 * D_MODEL // (3 * 256)) * 256
IN_SPLITS = [D_CONV_A, D_CONV_A, D_CONV_B, D_CONV_B, D_CONV_B, D_MODEL, D_MODEL]
N_IN = sum(IN_SPLITS)
IN_OFFSETS = [int(o) for o in np.cumsum(IN_SPLITS[:-1])]
RMS_EPS = 1e-6
LN_EPS = 1e-5

kernel_name = "hybrid_conformer_shortconv_stream_step"


def rmsnorm(x, g):
    xf = x.astype(jnp.float32)
    y = xf * lax.rsqrt(jnp.mean(xf * xf, axis=-1, keepdims=True) + RMS_EPS)
    return (y * g.astype(jnp.float32)).astype(x.dtype)


def layernorm(x, g, b):
    xf = x.astype(jnp.float32)
    mu = jnp.mean(xf, axis=-1, keepdims=True)
    var = jnp.mean(jnp.square(xf - mu), axis=-1, keepdims=True)
    y = (xf - mu) * lax.rsqrt(var + LN_EPS)
    return (y * g.astype(jnp.float32) + b.astype(jnp.float32)).astype(x.dtype)


def causal_dwconv(x_full, w):
    return lax.conv_general_dilated(
        x_full, w[:, None, :].astype(x_full.dtype), window_strides=(1,), padding='VALID',
        dimension_numbers=('NWC', 'WIO', 'NWC'), feature_group_count=x_full.shape[-1])


def trunk_layer(x, st_a, st_b, norm1_g, w_in, conv_a_w, conv_a_b, ln_a_g, ln_a_b, w_a_out,
                conv_b_w, w_b_out, w_o, norm2_g, w_ffn_gate, w_ffn_up, w_ffn_down):
    xn = rmsnorm(x, norm1_g)
    proj = jnp.einsum('btd,dn->btn', xn, w_in)
    a_val, a_gate, b_b, b_c, b_x, g_a, g_b = jnp.split(proj, IN_OFFSETS, axis=-1)

    u_a = a_val * jax.nn.sigmoid(a_gate)
    u_a_full = jnp.concatenate([st_a.astype(u_a.dtype), u_a], axis=1)
    c_a = causal_dwconv(u_a_full, conv_a_w) + conv_a_b
    c_a = jax.nn.silu(layernorm(c_a, ln_a_g, ln_a_b))
    y_a = jnp.einsum('btc,cd->btd', c_a, w_a_out)

    z_b = b_c * b_x
    z_b_full = jnp.concatenate([st_b.astype(z_b.dtype), z_b], axis=1)
    c_b = causal_dwconv(z_b_full, conv_b_w)
    y_b = jnp.einsum('btc,cd->btd', b_b * c_b, w_b_out)

    merged = jax.nn.sigmoid(g_a) * y_a + jax.nn.sigmoid(g_b) * y_b
    h = x + jnp.einsum('btd,de->bte', merged, w_o)

    hn = rmsnorm(h, norm2_g)
    f = jax.nn.silu(jnp.einsum('btd,dh->bth', hn, w_ffn_gate)) * jnp.einsum('btd,dh->bth', hn, w_ffn_up)
    out = h + jnp.einsum('bth,hd->btd', f, w_ffn_down)

    new_a = u_a_full[:, -(CONV_A_WIDTH - 1):]
    new_b = z_b_full[:, -(CONV_B_WIDTH - 1):]
    return out, new_a, new_b


def setup_inputs(seed: int = 0) -> dict:
    key = jax.random.key(seed)
    ks = jax.random.split(key, 24)
    f32 = jnp.float32
    nrm = lambda k, shape, s: jax.random.normal(k, shape, f32) * s
    return {
        "x_prompt": nrm(ks[0], (BATCH, SEQ, D_MODEL), 1.0),
        "x_sample": nrm(ks[1], (DEC_BATCH, DEC_SEQ, D_MODEL), 1.0),
        "state_conv_a": nrm(ks[2], (DEPTH, DEC_BATCH, CONV_A_WIDTH - 1, D_CONV_A), 0.5),
        "state_conv_b": nrm(ks[3], (DEPTH, DEC_BATCH, CONV_B_WIDTH - 1, D_CONV_B), 0.5),
        "meta_tokens": nrm(ks[4], (N_META, D_MODEL), 1.0),
        "norm1_g": 1.0 + nrm(ks[5], (DEPTH, D_MODEL), 0.01),
        "w_in": nrm(ks[6], (DEPTH, D_MODEL, N_IN), D_MODEL ** -0.5),
        "conv_a_w": nrm(ks[7], (DEPTH, CONV_A_WIDTH, D_CONV_A), CONV_A_WIDTH ** -0.5),
        "conv_a_b": nrm(ks[8], (DEPTH, D_CONV_A), 0.01),
        "ln_a_g": 1.0 + nrm(ks[9], (DEPTH, D_CONV_A), 0.01),
        "ln_a_b": nrm(ks[10], (DEPTH, D_CONV_A), 0.01),
        "w_a_out": nrm(ks[11], (DEPTH, D_CONV_A, D_MODEL), D_CONV_A ** -0.5),
        "conv_b_w": nrm(ks[12], (DEPTH, CONV_B_WIDTH, D_CONV_B), CONV_B_WIDTH ** -0.5),
        "w_b_out": nrm(ks[13], (DEPTH, D_CONV_B, D_MODEL), D_CONV_B ** -0.5),
        "w_o": nrm(ks[14], (DEPTH, D_MODEL, D_MODEL), D_MODEL ** -0.5),
        "norm2_g": 1.0 + nrm(ks[15], (DEPTH, D_MODEL), 0.01),
        "w_ffn_gate": nrm(ks[16], (DEPTH, D_MODEL, D_HID), D_MODEL ** -0.5),
        "w_ffn_up": nrm(ks[17], (DEPTH, D_MODEL, D_HID), D_MODEL ** -0.5),
        "w_ffn_down": nrm(ks[18], (DEPTH, D_HID, D_MODEL), D_HID ** -0.5),
        "final_norm_g": 1.0 + nrm(ks[19], (D_MODEL,), 0.01),
    }


def reference(x_prompt, x_sample, state_conv_a, state_conv_b, meta_tokens, norm1_g, w_in,
              conv_a_w, conv_a_b, ln_a_g, ln_a_b, w_a_out, conv_b_w, w_b_out, w_o, norm2_g,
              w_ffn_gate, w_ffn_up, w_ffn_down, final_norm_g):
    b_p = x_prompt.shape[0]
    meta = jnp.broadcast_to(meta_tokens.astype(x_prompt.dtype)[None], (b_p, N_META, D_MODEL))
    hp = jnp.concatenate([meta, x_prompt], axis=1)
    zero_a = jnp.zeros((b_p, CONV_A_WIDTH - 1, D_CONV_A), x_prompt.dtype)
    zero_b = jnp.zeros((b_p, CONV_B_WIDTH - 1, D_CONV_B), x_prompt.dtype)
    hs = x_sample
    pa, pb, sa, sb = [], [], [], []
    for l in range(DEPTH):
        lw = (norm1_g[l], w_in[l], conv_a_w[l], conv_a_b[l], ln_a_g[l], ln_a_b[l], w_a_out[l],
              conv_b_w[l], w_b_out[l], w_o[l], norm2_g[l], w_ffn_gate[l], w_ffn_up[l], w_ffn_down[l])
        hp, na, nb = trunk_layer(hp, zero_a, zero_b, *lw)
        pa.append(na); pb.append(nb)
        hs, na, nb = trunk_layer(hs, state_conv_a[l], state_conv_b[l], *lw)
        sa.append(na); sb.append(nb)
    y_prompt = rmsnorm(hp, final_norm_g)[:, N_META:]
    y_sample = rmsnorm(hs, final_norm_g)
    new_conv_a_prompt = jnp.stack(pa, axis=0)
    new_conv_b_prompt = jnp.stack(pb, axis=0)
    new_conv_a_sample = jnp.stack(sa, axis=0)
    new_conv_b_sample = jnp.stack(sb, axis=0)
    return (y_prompt, y_sample, new_conv_a_prompt, new_conv_b_prompt, new_conv_a_sample, new_conv_b_sample)
```

```cpp
#include <hip/hip_runtime.h>
#include <cstdio>
#include <cstdint>

#ifndef REP_P0
#define REP_P0 1
#endif
#ifndef REP_G1
#define REP_G1 1
#endif
#ifndef REP_G4
#define REP_G4 1
#endif
#ifndef REP_FIN
#define REP_FIN 1
#endif
#ifndef DRY_G2
#define DRY_G2 0
#endif
#ifndef DRY_G3
#define DRY_G3 0
#endif
#ifndef DRY_G5
#define DRY_G5 0
#endif
#ifndef MK_N_LAUNCHES
#define MK_N_LAUNCHES 1
#endif

constexpr int D = 1024, NIN = 7168, DH = 2816, NGU = 2 * DH;
constexpr int NPROMPT = 8, TP = 2064, NSAMP = 16, TS = 16, NSTREAM = NPROMPT + NSAMP;
constexpr int ROW_S0 = NPROMPT * TP;
constexpr int MREAL = ROW_S0 + NSAMP * TS;
constexpr int MPAD = 16896, NPAN = MPAD / 256;
static_assert(NPAN == 66, "StreamK assumes 66 row panels (a last group of two)");
constexpr float RMS_EPS = 1e-6f, LN_EPS = 1e-5f;
constexpr int NPHASE = 14;

__device__ __forceinline__ int opaque_v(int x) { asm volatile("" : "+v"(x)); return x; }
__device__ __forceinline__ int opaque_s(int x) { asm volatile("" : "+s"(x)); return x; }
__device__ __forceinline__ int lane_id() { int x; asm volatile("v_mbcnt_lo_u32_b32 %0, -1, 0\n\tv_mbcnt_hi_u32_b32 %0, -1, %0" : "=v"(x)); return x; }
namespace pg8 {
#define PG8_LAS __attribute__((address_space(3)))
typedef unsigned short bf16_t;
typedef short bf16x8 __attribute__((ext_vector_type(8)));
typedef float f32x4 __attribute__((ext_vector_type(4)));
typedef unsigned u32x4 __attribute__((ext_vector_type(4)));
constexpr int BM = 256, BK = 64, HALF = 128, HTB = HALF * BK * 2  , STAGE_BYTES = 8 * HTB, NXCD = 8, WGM = 8;

__host__ __device__ __forceinline__ int lds_byte(int r, int c) { const int st = (r >> 4) * 2 + (c >> 5), rr = r & 15, cc = c & 31, ob = rr * 64 + cc * 2; return st * 1024 + (ob ^ (((ob >> 9) & 1) << 5)); }
__host__ __device__ __forceinline__ void stage_rc(int b, int& R, int& C) { const int st = b / 1024, sb = b % 1024, swz = sb ^ (((sb >> 9) & 1) << 5); R = (st >> 1) * 16 + swz / 64; C = (st & 1) * 32 + (swz % 64) / 2; }
__host__ __device__ __forceinline__ int perm32(int rho) { const int n = rho >> 4, i = rho & 15; return 8 * (i >> 2) + 4 * n + (i & 3); }

struct Unit { int pm, pn, kb, nk, flags; };
struct Gemm { const bf16_t* A; const bf16_t* Bt; const bf16_t* A2; const bf16_t* Bt2; };
struct SlotIO { unsigned char* slots; unsigned* flags; int me; int same_next; };

template <int NN  , int P  , int KSPLIT  , int NW = 256  >
struct StreamK {
    static constexpr int nM = 66, nN = NN, NTILES = nM * nN, N_DP_ROUNDS = (NTILES / NW - 1) > 0 ? (NTILES / NW - 1) : 0, N_DP = NW * N_DP_ROUNDS;
    static constexpr bool WHOLE = (NTILES % NW == 0) && KSPLIT == 0;
    int c, t_first, o_s, t_last, o_e, has_head, has_tail, first_full, n_full;
    __device__ static int cut(int c) { return (int)((long)(NTILES - N_DP) * P * c / NW); }
    __device__ void init(int c_) {
        c = c_;
        const int s = cut(c), e = cut(c + 1);
        t_first = s / P; o_s = s % P; t_last = (e - 1) / P; o_e = e - t_last * P;
        has_tail = (o_s > 0 && e > s); has_head = (o_e < P && e > s && !(t_last == t_first && o_s > 0));
        first_full = has_tail ? t_first + 1 : t_first; const int last_full = has_head ? t_last - 1 : t_last; n_full = (e > s) ? last_full - first_full + 1 : 0; if (n_full < 0) n_full = 0;
    }
    __device__ static void tile_of(int t, Unit& u) { constexpr int nig = WGM * nN; const int gid = t / nig, fm = gid * WGM, r = t - gid * nig;
        if (nM - fm >= WGM) { u.pm = fm + (r & (WGM - 1)); u.pn = r / WGM; } else { u.pm = fm + (r & 1); u.pn = r >> 1; } }
    __device__ bool base(int i, Unit& u) const {
        if (has_head) { if (i == 0) { tile_of(N_DP + t_last, u); u.kb = 0; u.nk = 2 * o_e; u.flags = 2; return true; } --i; }
        if (i < N_DP_ROUNDS) { tile_of(NW * i + c, u); u.kb = 0; u.nk = 2 * P; u.flags = 0; return true; } i -= N_DP_ROUNDS;
        if (i < n_full) { tile_of(N_DP + first_full + i, u); u.kb = 0; u.nk = 2 * P; u.flags = 0; return true; } i -= n_full;
        if (has_tail && i == 0) { tile_of(N_DP + t_first, u); u.kb = 2 * o_s; u.nk = 2 * (P - o_s); u.flags = 1; return true; }
        return false;
    }
    mutable int it_i, it_second; mutable Unit it_u;
    __device__ void start() const { it_i = 0; it_second = 0; }
    __device__ bool advance(Unit& u) const {
        if constexpr (KSPLIT > 0) { if (it_second) { u = it_u; u.nk = it_u.kb + it_u.nk - KSPLIT; u.kb = KSPLIT; u.flags = 8 | (it_u.flags & 2); it_second = 0; return true; } }
        if (!base(it_i, u)) return false; ++it_i;
        if constexpr (KSPLIT > 0) {
            if (u.kb < KSPLIT && u.kb + u.nk > KSPLIT) { it_u = u; it_second = 1; u.nk = KSPLIT - u.kb; u.flags = (u.flags & 1) | 4; }
            else if (u.kb + u.nk == KSPLIT) u.flags |= 16;
        }
        return true;
    }
};

typedef __bf16 bf16x2_t __attribute__((ext_vector_type(2)));
typedef float f32x2_t __attribute__((ext_vector_type(2)));
__device__ __forceinline__ unsigned cvt_pk_bf16(float lo, float hi) { const f32x2_t v = {lo, hi}; const bf16x2_t r = __builtin_convertvector(v, bf16x2_t); return __builtin_bit_cast(unsigned, r); }

template <class Epi, class Sched, int KPITCH  , int KWRAP  >
__device__ __forceinline__ void gemm_phase(PG8_LAS unsigned char* lds, const Gemm g, const Sched& S, const Epi& E, const SlotIO io, const int wid_in  ) {
    const int wid = opaque_s(wid_in), lane = lane_id(), tid = wid * 64 + lane, wr = wid >> 2, wc = wid & 3, fr = lane & 15, fq = lane >> 4;
    constexpr int K = KPITCH;
    unsigned voffA[2], voffB[2];
#pragma unroll
    for (int i = 0; i < 2; ++i) { int R, C; stage_rc(tid * 16 + i * 8192, R, C); const int Rb = (R & ~31) + perm32(R & 31);
        voffA[i] = (unsigned)(R * K + C) * 2u; voffB[i] = (unsigned)(Rb * K + C) * 2u; }
    const size_t kstep = (size_t)(BK * 2);
    const size_t hstep = (size_t)HALF * K * 2;
    const size_t tstep = 2 * hstep;
    const unsigned ldsw = (unsigned)wid * 1024u;
    const int aoff = lds_byte(wr * 64 + fr, fq * 8), boff = lds_byte(wc * 32 + fr, fq * 8);
#define PG8_SA(b, h) (((b) * 2 + (h)) * HTB)
#define PG8_SB(b, h) ((4 + (b) * 2 + (h)) * HTB)
#define PG8_STAGE(bufoff, gbase, voff) do { _Pragma("unroll") for (int _i = 0; _i < 2; ++_i) \
        __builtin_amdgcn_global_load_lds((const unsigned*)((const char*)(gbase) + (voff)[_i]), (PG8_LAS unsigned*)(lds + (bufoff) + ldsw + _i * 8192), 16, 0, 0); } while (0)
#define PG8_LDA(dst, b, h) do { _Pragma("unroll") for (int m = 0; m < 4; ++m) _Pragma("unroll") for (int k = 0; k < 2; ++k) dst[m][k] = *(const PG8_LAS bf16x8*)(lds + PG8_SA(b, h) + aoff + m * 2048 + k * 1024); } while (0)
#define PG8_LDB(dst, b, h) do { _Pragma("unroll") for (int n = 0; n < 2; ++n) _Pragma("unroll") for (int k = 0; k < 2; ++k) dst[n][k] = *(const PG8_LAS bf16x8*)(lds + PG8_SB(b, h) + boff + n * 2048 + k * 1024); } while (0)
#define PG8_MMA(ai, bj, At, Bt) do { __builtin_amdgcn_s_setprio(1); _Pragma("unroll") for (int m = 0; m < 4; ++m) _Pragma("unroll") for (int n = 0; n < 2; ++n) _Pragma("unroll") for (int k = 0; k < 2; ++k) \
        acc[ai][bj][m][n] = __builtin_amdgcn_mfma_f32_16x16x32_bf16(Bt[n][k], At[m][k], acc[ai][bj][m][n], 0, 0, 0); __builtin_amdgcn_s_setprio(0); } while (0)
#define PG8_WAIT_V(n) asm volatile("s_waitcnt vmcnt(" #n ")" ::: "memory")
#define PG8_WAIT_L(n) asm volatile("s_waitcnt lgkmcnt(" #n ")" ::: "memory")
#define PG8_BAR __builtin_amdgcn_s_barrier()
#define PG8_SCHED __builtin_amdgcn_sched_barrier(0)
#define PG8_KA(u, T) ((const char*)(((T) < KWRAP) ? g.A : g.A2) + (size_t)(u).pm * tstep + (size_t)(((T) < KWRAP) ? (T) : (T) - KWRAP) * kstep)
#define PG8_KB(u, T) ((const char*)(((T) < KWRAP) ? g.Bt : g.Bt2) + (size_t)(u).pn * tstep + (size_t)(((T) < KWRAP) ? (T) : (T) - KWRAP) * kstep)
    Unit cur, nxt; int ui = 0;
    S.start();
    if (!S.advance(cur)) return;
    f32x4 acc[2][2][4][2];
    bf16x8 At[4][2], B0[2][2], B1[2][2];
    {   const char* cA = PG8_KA(cur, cur.kb); const char* cB = PG8_KB(cur, cur.kb);
        PG8_STAGE(PG8_SB(0, 0), cB, voffB); PG8_STAGE(PG8_SB(0, 1), cB + hstep, voffB); PG8_STAGE(PG8_SA(0, 0), cA, voffA); PG8_STAGE(PG8_SA(0, 1), cA + hstep, voffA);
        if (wr == 1) PG8_BAR;
        PG8_WAIT_V(2); PG8_BAR;
        PG8_STAGE(PG8_SB(1, 0), cB + kstep, voffB); PG8_STAGE(PG8_SA(1, 0), cA + kstep, voffA); PG8_STAGE(PG8_SB(1, 1), cB + hstep + kstep, voffB);
        PG8_WAIT_V(6); PG8_BAR; }
    for (;;) {
        const bool has_next = S.advance(nxt);
        if (!Sched::WHOLE && (cur.flags & 8)) {   }
        else if (!Sched::WHOLE && (cur.flags & 1)) {
            const __amdgpu_buffer_rsrc_t rs_in = __builtin_amdgcn_make_buffer_rsrc((void*)(io.slots + (size_t)(io.me - 1) * 131072), 0, 131072, 0x00020000);
            unsigned* fl = io.flags + (size_t)(io.me - 1) * 64; unsigned spins = 0;
            while ((unsigned)__builtin_amdgcn_readfirstlane(__hip_atomic_load(fl, __ATOMIC_RELAXED, __HIP_MEMORY_SCOPE_AGENT)) < 8u) { __builtin_amdgcn_s_sleep(2); if (++spins > (1u << 22)) break; }
            asm volatile("" ::: "memory");
#pragma unroll
            for (int q = 0; q < 16; ++q) { const u32x4 w = __builtin_amdgcn_raw_buffer_load_b128(rs_in, (q * 512 + tid) * 16, 0, 16);
                acc[q >> 3][(q >> 2) & 1][q & 3][0] = (f32x4){__builtin_bit_cast(float, w.x << 16), __builtin_bit_cast(float, w.x & 0xffff0000u), __builtin_bit_cast(float, w.y << 16), __builtin_bit_cast(float, w.y & 0xffff0000u)};
                acc[q >> 3][(q >> 2) & 1][q & 3][1] = (f32x4){__builtin_bit_cast(float, w.z << 16), __builtin_bit_cast(float, w.z & 0xffff0000u), __builtin_bit_cast(float, w.w << 16), __builtin_bit_cast(float, w.w & 0xffff0000u)}; }
        } else {
#pragma unroll
            for (int a = 0; a < 2; ++a)
#pragma unroll
                for (int b = 0; b < 2; ++b)
#pragma unroll
                    for (int m = 0; m < 4; ++m)
#pragma unroll
                        for (int n = 0; n < 2; ++n) acc[a][b][m][n] = (f32x4){0.f, 0.f, 0.f, 0.f};
        }
        const int nk = cur.nk, kb = cur.kb;
        for (int t = 0; t < nk; t += 2) {
            const bool last = (t == nk - 2); const int T = kb + t;
            const char* a1 = PG8_KA(cur, T) + kstep;
            const char* a2 = last ? (has_next ? PG8_KA(nxt, nxt.kb) : PG8_KA(cur, kb)) : PG8_KA(cur, T + 2);
            const char* b2 = last ? (has_next ? PG8_KB(nxt, nxt.kb) : PG8_KB(cur, kb)) : PG8_KB(cur, T + 2);
            const char* a3 = a2 + kstep; const char* b3 = b2 + kstep;
            PG8_LDB(B0, 0, 0); PG8_LDB(B1, 0, 1); PG8_SCHED; PG8_LDA(At, 0, 0); PG8_STAGE(PG8_SA(1, 1), a1 + hstep, voffA);
            PG8_WAIT_V(8); PG8_WAIT_L(0); PG8_BAR; PG8_MMA(0, 0, At, B0); PG8_MMA(0, 1, At, B1); PG8_BAR; PG8_SCHED;
            if constexpr (Epi::NEED_RSTD) { if (t == 0) { E.prefetch(cur, wid); PG8_SCHED; } }
            PG8_LDA(At, 0, 1); PG8_STAGE(PG8_SB(0, 0), b2, voffB); PG8_STAGE(PG8_SB(0, 1), b2 + hstep, voffB); PG8_STAGE(PG8_SA(0, 0), a2, voffA);
            PG8_WAIT_V(8); PG8_WAIT_L(0); PG8_BAR; PG8_MMA(1, 0, At, B0); PG8_MMA(1, 1, At, B1); PG8_BAR; PG8_SCHED;
            PG8_LDB(B0, 1, 0); PG8_LDB(B1, 1, 1); PG8_SCHED; PG8_LDA(At, 1, 0); PG8_STAGE(PG8_SA(0, 1), a2 + hstep, voffA);
            PG8_WAIT_V(8); PG8_WAIT_L(0); PG8_BAR; PG8_MMA(0, 0, At, B0); PG8_MMA(0, 1, At, B1); PG8_BAR; PG8_SCHED;
            PG8_LDA(At, 1, 1); PG8_STAGE(PG8_SB(1, 0), b3, voffB); PG8_STAGE(PG8_SB(1, 1), b3 + hstep, voffB); PG8_STAGE(PG8_SA(1, 0), a3, voffA);
            PG8_WAIT_V(8); PG8_WAIT_L(0); PG8_BAR; PG8_MMA(1, 0, At, B0); PG8_MMA(1, 1, At, B1); PG8_BAR; PG8_SCHED;
        }
        if (wr == 0) PG8_BAR;
        if constexpr (Epi::KSPLIT > 0) { if (cur.flags & (4 | 16)) E.mid(acc, cur, wr, wc, fr, fq); }
        if (!Sched::WHOLE && (cur.flags & 4)) {   }
        else if (!Sched::WHOLE && (cur.flags & 2)) {
            const __amdgpu_buffer_rsrc_t rs_out = __builtin_amdgcn_make_buffer_rsrc((void*)(io.slots + (size_t)io.me * 131072), 0, 131072, 0x00020000);
#pragma unroll
            for (int q = 0; q < 16; ++q) { const f32x4 v0 = acc[q >> 3][(q >> 2) & 1][q & 3][0], v1 = acc[q >> 3][(q >> 2) & 1][q & 3][1];
                u32x4 w; w.x = cvt_pk_bf16(v0[0], v0[1]); w.y = cvt_pk_bf16(v0[2], v0[3]); w.z = cvt_pk_bf16(v1[0], v1[1]); w.w = cvt_pk_bf16(v1[2], v1[3]);
                if (io.same_next) __builtin_amdgcn_raw_buffer_store_b128(w, rs_out, (q * 512 + tid) * 16, 0, 0);
                else __builtin_amdgcn_raw_buffer_store_b128(w, rs_out, (q * 512 + tid) * 16, 0, 16); }
            asm volatile("s_waitcnt vmcnt(0)" ::: "memory");
            if (lane == 0) __hip_atomic_fetch_add(io.flags + (size_t)io.me * 64, 1u, __ATOMIC_RELAXED, __HIP_MEMORY_SCOPE_AGENT);
        } else E(acc, cur, wr, wc, fr, fq);
        if (!has_next) break;
        cur = nxt; ++ui;
        if (wr == 1) PG8_BAR;
    }
    PG8_WAIT_V(0);
    PG8_BAR;
#undef PG8_SA
#undef PG8_SB
#undef PG8_STAGE
#undef PG8_LDA
#undef PG8_LDB
#undef PG8_MMA
#undef PG8_WAIT_V
#undef PG8_WAIT_L
#undef PG8_BAR
#undef PG8_SCHED
#undef PG8_KA
#undef PG8_KB
}
}

using pg8::bf16_t; using pg8::f32x4; using pg8::u32x4; using pg8::Unit; using pg8::cvt_pk_bf16;
__device__ __forceinline__ unsigned cvt_pk_bf16_pin(float lo, float hi) { unsigned r; asm volatile("v_cvt_pk_bf16_f32 %0, %1, %2" : "=v"(r) : "v"(lo), "v"(hi)); return r; }
#define GAS __attribute__((address_space(1)))
#define LAS __attribute__((address_space(3)))
typedef unsigned u32x2 __attribute__((ext_vector_type(2)));
typedef float f32x2 __attribute__((ext_vector_type(2)));
#define LDS_WAIT() asm volatile("s_waitcnt lgkmcnt(0)" ::: "memory")
#define VM_WAIT() asm volatile("s_waitcnt vmcnt(0)" ::: "memory")

__device__ __forceinline__ float bf_lo(unsigned w) { return __builtin_bit_cast(float, w << 16); }
__device__ __forceinline__ float bf_hi(unsigned w) { return __builtin_bit_cast(float, w & 0xffff0000u); }
__device__ __forceinline__ float sigmoid_fast(float x) { return __builtin_amdgcn_rcpf(1.0f + __builtin_amdgcn_exp2f(-1.4426950408889634f * x)); }
template <int M> __device__ __forceinline__ float swz_xor(float v) { return __builtin_bit_cast(float, __builtin_amdgcn_ds_swizzle(__builtin_bit_cast(int, v), 0x1f | (M << 10))); }
__device__ __forceinline__ float sum_xor32(float v) { const unsigned b = __builtin_bit_cast(unsigned, v); auto r = __builtin_amdgcn_permlane32_swap(b, b, false, false); return __builtin_bit_cast(float, (unsigned)r[0]) + __builtin_bit_cast(float, (unsigned)r[1]); }
__device__ __forceinline__ float sum_fq(float v) { v += swz_xor<16>(v); return sum_xor32(v); }
__device__ __forceinline__ float wave_sum(float v) { v += swz_xor<1>(v); v += swz_xor<2>(v); v += swz_xor<4>(v); v += swz_xor<8>(v); v += swz_xor<16>(v); return sum_xor32(v); }

__device__ __forceinline__ float sum2_swap32(float a, float b) { auto r = __builtin_amdgcn_permlane32_swap(__builtin_bit_cast(unsigned, a), __builtin_bit_cast(unsigned, b), false, false); return __builtin_bit_cast(float, (unsigned)r[0]) + __builtin_bit_cast(float, (unsigned)r[1]); }
__device__ __forceinline__ float sum2_swap16(float a, float b) { auto r = __builtin_amdgcn_permlane16_swap(__builtin_bit_cast(unsigned, a), __builtin_bit_cast(unsigned, b), false, false); return __builtin_bit_cast(float, (unsigned)r[0]) + __builtin_bit_cast(float, (unsigned)r[1]); }
__device__ __forceinline__ float reduce48(const float (&v)[48], int lane) {
    float w[32];
#pragma unroll
    for (int i = 0; i < 32; ++i) w[i] = sum2_swap32(v[i], i + 32 < 48 ? v[i + 32] : 0.f);
    float x[16];
#pragma unroll
    for (int i = 0; i < 16; ++i) x[i] = sum2_swap16(w[i], w[i + 16]);
    float y[8]; const bool b8 = (lane & 8) != 0;
#pragma unroll
    for (int i = 0; i < 8; ++i) { const float keep = b8 ? x[i + 8] : x[i], send = b8 ? x[i] : x[i + 8]; y[i] = keep + swz_xor<8>(send); }
    float z[4]; const bool b4 = (lane & 4) != 0;
#pragma unroll
    for (int i = 0; i < 4; ++i) { const float keep = b4 ? y[i + 4] : y[i], send = b4 ? y[i] : y[i + 4]; z[i] = keep + swz_xor<4>(send); }
    float q[2]; const bool b2 = (lane & 2) != 0;
#pragma unroll
    for (int i = 0; i < 2; ++i) { const float keep = b2 ? z[i + 2] : z[i], send = b2 ? z[i] : z[i + 2]; q[i] = keep + swz_xor<2>(send); }
    const bool b1 = (lane & 1) != 0; const float keep = b1 ? q[1] : q[0], send = b1 ? q[0] : q[1];
    return keep + swz_xor<1>(send);
}

constexpr size_t MiB = 1u << 20;
constexpr size_t ACT_BYTES = (size_t)MPAD * D * 2;
constexpr size_t WS_CTL = 0, CTL_ZERO_BYTES = 1 * MiB;
constexpr size_t WS_XCCTAB = 32 * 1024;
constexpr size_t WS_SKFLAG = 64 * 1024;
static_assert(WS_SKFLAG + (size_t)10 * 256 * 256 <= CTL_ZERO_BYTES, "ctl map");
constexpr size_t SSQ_ONE = (size_t)16 * MPAD * 4;
constexpr size_t WS_SSQ = 1 * MiB;
constexpr size_t WS_HALOA = WS_SSQ + 5 * SSQ_ONE;
constexpr size_t WS_HALOB = WS_HALOA + (size_t)2 * NSTREAM * 30 * D * 2;
constexpr size_t WS_W0 = 10 * MiB;
constexpr size_t W_IN_B = (size_t)NIN * D * 2, W_AB_B = (size_t)2 * D * D * 2, W_O_B = (size_t)D * D * 2, W_GU_B = (size_t)NGU * D * 2, W_D_B = (size_t)D * DH * 2;
constexpr size_t WS_W0_IN = WS_W0, WS_W0_AB = WS_W0_IN + W_IN_B, WS_W0_O = WS_W0_AB + W_AB_B, WS_W0_GU = WS_W0_O + W_O_B, WS_W0_D = WS_W0_GU + W_GU_B, WS_W0_END = WS_W0_D + W_D_B;
constexpr size_t WS_W1_AB = WS_W0_END, WS_W1_O = WS_W1_AB + W_AB_B, WS_W1_END = WS_W1_O + W_O_B;
constexpr size_t WS_H = 53 * MiB;
constexpr size_t WS_UA = 86 * MiB, WS_ZB = WS_UA + ACT_BYTES, WS_BB = WS_ZB + ACT_BYTES, WS_SGA = WS_BB + ACT_BYTES, WS_SGB = WS_SGA + ACT_BYTES, WS_END = WS_SGB + ACT_BYTES;
constexpr size_t WS_F = WS_UA;
static_assert(WS_HALOB + (size_t)2 * NSTREAM * 2 * D * 2 <= WS_W0, "ws map: small buffers");
static_assert(WS_W1_END <= WS_H && WS_H + ACT_BYTES <= WS_UA && WS_END + SSQ_ONE <= 256 * MiB, "ws map (a dummy ssq set for timing probes sits at WS_END)");
static_assert(WS_F + (size_t)MPAD * DH * 2 <= WS_SGA, "F overlay");
constexpr size_t DO_CA = 0, DO_W1_IN = ACT_BYTES, DO_W1_GU = DO_W1_IN + W_IN_B, DO_W1_D = DO_W1_GU + W_GU_B, DO_END = DO_W1_D + W_D_B;
static_assert(DO_END <= (size_t)NPROMPT * 2048 * D * 4, "d_out scratch must stay inside the y_prompt region");
constexpr size_t OUT_YP = 0, OUT_YS = OUT_YP + (size_t)NPROMPT * 2048 * D, OUT_NAP = OUT_YS + (size_t)NSAMP * TS * D, OUT_NBP = OUT_NAP + (size_t)2 * NPROMPT * 30 * D,
                 OUT_NAS = OUT_NBP + (size_t)2 * NPROMPT * 2 * D, OUT_NBS = OUT_NAS + (size_t)2 * NSAMP * 30 * D, OUT_TOTAL = OUT_NBS + (size_t)2 * NSAMP * 2 * D;

constexpr int RING_BYTES = 131072, RSTD_OFF = RING_BYTES, RSTD_PITCH = 1040  , LDSCTL_OFF = RSTD_OFF + 16 * RSTD_PITCH, LDS_BYTES = 149504;

#define XB_TMO      128
#define XB_XCNT(j)  (256  + 64 * (j))
#define XB_XSUB(j)  (1280 + 64 * (j))
#define XB_XGEN(j)  (2304 + 64 * (j))
#define XB_TOP      3328
#define XB_TOPGEN   3392
#define XCD_BAR_WORDS 3456
#define XB_SPIN_CAP (1u << 18)
__device__ __forceinline__ unsigned xb_ld(unsigned* p)              { return __hip_atomic_load(p, __ATOMIC_RELAXED, __HIP_MEMORY_SCOPE_AGENT); }
__device__ __forceinline__ unsigned xb_add(unsigned* p, unsigned v) { return __hip_atomic_fetch_add(p, v, __ATOMIC_RELAXED, __HIP_MEMORY_SCOPE_AGENT); }
__device__ __forceinline__ unsigned xb_xcc_id() { return (unsigned)__builtin_amdgcn_s_getreg((3 << 11) | 20) & 0xFu; }
#define XB_SPIN(cond, bar) do { unsigned _sp = 0; while (cond) { __builtin_amdgcn_s_sleep(1); \
    if ((++_sp & 255u) == 0u) { if (xb_ld(&(bar)[XB_TMO])) break; if (_sp > XB_SPIN_CAP) { atomicAdd(&(bar)[XB_TMO], 1u); break; } } } } while (0)
struct XcdBarrier { unsigned* bar; unsigned x; volatile LAS unsigned* st; };
__device__ __forceinline__ XcdBarrier xcd_barrier_post(unsigned* bar, volatile LAS unsigned* st) {
    XcdBarrier b; b.bar = bar; b.x = xb_xcc_id(); b.st = st;
    if (threadIdx.x == 0) { const unsigned old = xb_add(&bar[XB_XCNT(b.x)], 1u); st[2] = (old == 0u) ? 1u : 0u; }
    return b;
}
__device__ __forceinline__ void xcd_barrier_complete(unsigned* bar, unsigned x, unsigned& nloc, unsigned& nx) {
    const unsigned G = gridDim.x * gridDim.y * gridDim.z;
    unsigned sum, cnt, mine, sp = 0u;
    for (;;) {
        sum = 0u; cnt = 0u; mine = 0u;
#pragma unroll
        for (unsigned j = 0; j < 16; ++j) { const unsigned c = xb_ld(&bar[XB_XCNT(j)]); sum += c; cnt += (c > 0u) ? 1u : 0u; mine = (j == x) ? c : mine; }
        if (sum == G) break;
        __builtin_amdgcn_s_sleep(1);
        if ((++sp & 255u) == 0u) { if (xb_ld(&bar[XB_TMO])) break; if (sp > XB_SPIN_CAP) { atomicAdd(&bar[XB_TMO], 1u); break; } }
    }
    nloc = mine > 0u ? mine : 1u; nx = cnt > 0u ? cnt : 1u;
}
__device__ __forceinline__ void xcd_barrier(const XcdBarrier& b, const int wave) {
    asm volatile("s_waitcnt vmcnt(0)" ::: "memory");
    __syncthreads();
    if (wave == 0 && lane_id() == 0) {
        unsigned* bar = b.bar;
        __builtin_amdgcn_s_waitcnt(0);
        unsigned nloc = b.st[0], nx = b.st[1];
        if (nloc == 0u) { xcd_barrier_complete(bar, b.x, nloc, nx); b.st[0] = nloc; b.st[1] = nx; }
        const unsigned k = b.st[3] + 1u; b.st[3] = k;
        __builtin_amdgcn_fence(__ATOMIC_ACQUIRE, "agent");
        asm volatile("s_waitcnt vmcnt(0)" ::: "memory");
        if (b.st[2] == 0u) {
            (void)__hip_atomic_fetch_add(&bar[XB_XSUB(b.x)], 1u, __ATOMIC_RELAXED, __HIP_MEMORY_SCOPE_AGENT);
        } else {
            const unsigned want = (nloc - 1u) * k;
            XB_SPIN(xb_ld(&bar[XB_XSUB(b.x)]) < want, bar);
            __builtin_amdgcn_fence(__ATOMIC_RELEASE, "agent");
            asm volatile("s_waitcnt vmcnt(0)" ::: "memory");
            (void)__hip_atomic_fetch_add(&bar[XB_TOP], 1u, __ATOMIC_RELAXED, __HIP_MEMORY_SCOPE_AGENT);
        }
        const unsigned want_top = nx * k;
        XB_SPIN(xb_ld(&bar[XB_TOP]) < want_top, bar);
        asm volatile("s_waitcnt vmcnt(0)" ::: "memory");
    }
    __syncthreads();
}


__device__ __forceinline__ void sigmoid8(const float (&x)[8], float (&s)[8]) {
    float e[8];
#pragma unroll
    for (int k = 0; k < 8; ++k) e[k] = __builtin_amdgcn_exp2f(-1.4426950408889634f * x[k]);
#pragma unroll
    for (int k = 0; k < 8; ++k) e[k] = 1.0f + e[k];
#pragma unroll
    for (int k = 0; k < 8; ++k) s[k] = __builtin_amdgcn_rcpf(e[k]);
}
__device__ __forceinline__ void load_rstd(const LAS unsigned char* rl, int wr, int fr, int fq, float (&rs)[2][4]) {
    const LAS float* p = (const LAS float*)(rl + fq * 4 * RSTD_PITCH) + wr * 64 + fr;
#pragma unroll
    for (int ai = 0; ai < 2; ++ai)
#pragma unroll
        for (int m = 0; m < 4; ++m) {
            float s = 0.f;
#pragma unroll
            for (int j = 0; j < 4; ++j) s += p[j * (RSTD_PITCH / 4) + ai * 128 + m * 16];
            s = sum_fq(s);
            rs[ai][m] = 1.0f / sqrtf(s * (1.0f / D) + RMS_EPS);
        }
}
struct RstdPrefetch {
    static constexpr bool NEED_RSTD = true;
    const float* ssq; LAS unsigned char* rl;
    __device__ __forceinline__ void prefetch(const Unit& u, int wid) const {
        const unsigned lo = (unsigned)lane_id() * 16u;
#pragma unroll
        for (int i = 0; i < 2; ++i) { const int j = wid * 2 + i;
            __builtin_amdgcn_global_load_lds((const unsigned*)((const char*)ssq + ((size_t)j * MPAD + (size_t)u.pm * 256) * 4 + lo), (LAS unsigned*)(rl + j * RSTD_PITCH), 16, 0, 0); }
    }
};
struct Epi1 : RstdPrefetch {
    static constexpr int KSPLIT = 0;
    bf16_t* ACT5;
    __device__ __forceinline__ void operator()(const f32x4 (&acc)[2][2][4][2], const Unit& u, int wr, int wc, int fr, int fq) const {
        asm volatile("" : "+v"(fr), "+v"(fq));
        const int row0 = u.pm * 256 + wr * 64 + fr;
        float rs[2][4]; load_rstd(rl, wr, fr, fq, rs);
        const int pn = u.pn;
        if (pn < 16) {
            bf16_t* O = ACT5 + (size_t)(pn >> 3) * ((size_t)MPAD * D) + (pn & 7) * 128 + wc * 32 + 8 * fq;
            if (pn < 8) {
#pragma unroll
                for (int ai = 0; ai < 2; ++ai)
#pragma unroll
                    for (int m = 0; m < 4; ++m) { const float r = rs[ai][m]; float o[8];
                        float gb[8], sg[8];
#pragma unroll
                        for (int n = 0; n < 2; ++n)
#pragma unroll
                            for (int j = 0; j < 4; ++j) gb[n * 4 + j] = acc[ai][1][m][n][j] * r;
                        sigmoid8(gb, sg);
#pragma unroll
                        for (int n = 0; n < 2; ++n)
#pragma unroll
                            for (int j = 0; j < 4; ++j) o[n * 4 + j] = acc[ai][0][m][n][j] * r * sg[n * 4 + j];
                        u32x4 w; w.x = cvt_pk_bf16(o[0], o[1]); w.y = cvt_pk_bf16(o[2], o[3]); w.z = cvt_pk_bf16(o[4], o[5]); w.w = cvt_pk_bf16(o[6], o[7]);
                        *(u32x4*)(O + (size_t)(row0 + ai * 128 + m * 16) * D) = w; }
            } else {
#pragma unroll
                for (int ai = 0; ai < 2; ++ai)
#pragma unroll
                    for (int m = 0; m < 4; ++m) { const float r2 = rs[ai][m] * rs[ai][m]; float o[8];
#pragma unroll
                        for (int n = 0; n < 2; ++n)
#pragma unroll
                            for (int j = 0; j < 4; ++j) o[n * 4 + j] = acc[ai][0][m][n][j] * acc[ai][1][m][n][j] * r2;
                        u32x4 w; w.x = cvt_pk_bf16(o[0], o[1]); w.y = cvt_pk_bf16(o[2], o[3]); w.z = cvt_pk_bf16(o[4], o[5]); w.w = cvt_pk_bf16(o[6], o[7]);
                        *(u32x4*)(O + (size_t)(row0 + ai * 128 + m * 16) * D) = w; }
            }
        } else if (pn < 20) {
            bf16_t* O = ACT5 + (size_t)2 * ((size_t)MPAD * D) + (pn - 16) * 256 + wc * 32 + 8 * fq;
#pragma unroll
            for (int ai = 0; ai < 2; ++ai)
#pragma unroll
                for (int m = 0; m < 4; ++m) { const float r = rs[ai][m];
#pragma unroll
                    for (int bj = 0; bj < 2; ++bj) { float o[8];
#pragma unroll
                        for (int n = 0; n < 2; ++n)
#pragma unroll
                            for (int j = 0; j < 4; ++j) o[n * 4 + j] = acc[ai][bj][m][n][j] * r;
                        u32x4 w; w.x = cvt_pk_bf16(o[0], o[1]); w.y = cvt_pk_bf16(o[2], o[3]); w.z = cvt_pk_bf16(o[4], o[5]); w.w = cvt_pk_bf16(o[6], o[7]);
                        *(u32x4*)(O + (size_t)(row0 + ai * 128 + m * 16) * D + bj * 128) = w; } }
        } else {
            bf16_t* O = ACT5 + (size_t)3 * ((size_t)MPAD * D) + (pn - 20) * 128 + wc * 32 + 8 * fq;
#pragma unroll
            for (int ai = 0; ai < 2; ++ai)
#pragma unroll
                for (int m = 0; m < 4; ++m) { const float r = rs[ai][m]; float o[8], s[8];
                    float ga[8], sa[8], eb[8];
#pragma unroll
                    for (int n = 0; n < 2; ++n)
#pragma unroll
                        for (int j = 0; j < 4; ++j) { ga[n * 4 + j] = acc[ai][0][m][n][j] * r; eb[n * 4 + j] = __builtin_amdgcn_exp2f(-1.4426950408889634f * (acc[ai][1][m][n][j] * r)); }
                    sigmoid8(ga, sa);
#pragma unroll
                    for (int k = 0; k < 8; ++k) eb[k] = 1.0f + fminf(eb[k], 1e30f);
#pragma unroll
                    for (int k = 0; k < 8; ++k) { o[k] = sa[k] * eb[k]; s[k] = __builtin_amdgcn_rcpf(eb[k]); }
                    u32x4 w; w.x = cvt_pk_bf16(o[0], o[1]); w.y = cvt_pk_bf16(o[2], o[3]); w.z = cvt_pk_bf16(o[4], o[5]); w.w = cvt_pk_bf16(o[6], o[7]);
                    *(u32x4*)(O + (size_t)(row0 + ai * 128 + m * 16) * D) = w;
                    w.x = cvt_pk_bf16(s[0], s[1]); w.y = cvt_pk_bf16(s[2], s[3]); w.z = cvt_pk_bf16(s[4], s[5]); w.w = cvt_pk_bf16(s[6], s[7]);
                    *(u32x4*)(O + (size_t)MPAD * D + (size_t)(row0 + ai * 128 + m * 16) * D) = w; }
        }
    }
};
struct Epi2 {
    static constexpr int KSPLIT = 16; static constexpr bool NEED_RSTD = false;
    bf16_t* RT; const bf16_t* SGB; bf16_t* OUT;
    __device__ __forceinline__ void mid(f32x4 (&acc)[2][2][4][2], const Unit& u, int wr, int wc, int fr, int fq) const {
        const int row0 = u.pm * 256 + wr * 64 + fr; const size_t col0 = (size_t)u.pn * 256 + wc * 32 + 8 * fq;
#pragma unroll
        for (int ai = 0; ai < 2; ++ai)
#pragma unroll
            for (int m = 0; m < 4; ++m)
#pragma unroll
                for (int bj = 0; bj < 2; ++bj) { const u32x4 t = *(const u32x4*)(RT + (size_t)(row0 + ai * 128 + m * 16) * D + col0 + bj * 128);
#pragma unroll
                    for (int q = 0; q < 4; ++q) { acc[ai][bj][m][q >> 1][(2 * q) & 3] *= bf_lo(t[q]); acc[ai][bj][m][q >> 1][(2 * q + 1) & 3] *= bf_hi(t[q]); } }
    }
    __device__ __forceinline__ void operator()(const f32x4 (&acc)[2][2][4][2], const Unit& u, int wr, int wc, int fr, int fq) const {
        const int row0 = u.pm * 256 + wr * 64 + fr; const size_t col0 = (size_t)u.pn * 256 + wc * 32 + 8 * fq;
#pragma unroll
        for (int ai = 0; ai < 2; ++ai)
#pragma unroll
            for (int m = 0; m < 4; ++m)
#pragma unroll
                for (int bj = 0; bj < 2; ++bj) { const size_t off = (size_t)(row0 + ai * 128 + m * 16) * D + col0 + bj * 128;
                    const u32x4 s = *(const u32x4*)(SGB + off); float o[8];
#pragma unroll
                    for (int q = 0; q < 4; ++q) { o[2 * q] = bf_lo(s[q]) * acc[ai][bj][m][q >> 1][(2 * q) & 3]; o[2 * q + 1] = bf_hi(s[q]) * acc[ai][bj][m][q >> 1][(2 * q + 1) & 3]; }
                    u32x4 w; w.x = cvt_pk_bf16(o[0], o[1]); w.y = cvt_pk_bf16(o[2], o[3]); w.z = cvt_pk_bf16(o[4], o[5]); w.w = cvt_pk_bf16(o[6], o[7]);
                    *(u32x4*)(OUT + off) = w; }
    }
};
struct EpiRes {
    static constexpr int KSPLIT = 0; static constexpr bool NEED_RSTD = false;
    bf16_t* H; float* ssq_out; bf16_t* OUT;
    __device__ __forceinline__ void operator()(const f32x4 (&acc)[2][2][4][2], const Unit& u, int wr, int wc, int fr, int fq) const {
        const int row0 = u.pm * 256 + wr * 64 + fr; const size_t col0 = (size_t)u.pn * 256 + wc * 32 + 8 * fq;
#pragma unroll
        for (int ai = 0; ai < 2; ++ai)
#pragma unroll
            for (int m = 0; m < 4; ++m) { const int row = row0 + ai * 128 + m * 16; float sq = 0.f;
#pragma unroll
                for (int bj = 0; bj < 2; ++bj) { const size_t off = (size_t)row * D + col0 + bj * 128;
                    const u32x4 t = *(const u32x4*)(H + off); float o[8];
#pragma unroll
                    for (int q = 0; q < 4; ++q) { o[2 * q] = bf_lo(t[q]) + acc[ai][bj][m][q >> 1][(2 * q) & 3]; o[2 * q + 1] = bf_hi(t[q]) + acc[ai][bj][m][q >> 1][(2 * q + 1) & 3]; }
#pragma unroll
                    for (int q = 0; q < 8; ++q) sq += o[q] * o[q];
                    u32x4 w; w.x = cvt_pk_bf16(o[0], o[1]); w.y = cvt_pk_bf16(o[2], o[3]); w.z = cvt_pk_bf16(o[4], o[5]); w.w = cvt_pk_bf16(o[6], o[7]);
                    *(u32x4*)(OUT + off) = w; }
                sq = sum_fq(sq);
                if (fq == 0) ssq_out[(size_t)(u.pn * 4 + wc) * MPAD + row] = sq; }
    }
};
struct Epi4 : RstdPrefetch {
    static constexpr int KSPLIT = 0;
    bf16_t* F;
    __device__ __forceinline__ void operator()(const f32x4 (&acc)[2][2][4][2], const Unit& u, int wr, int wc, int fr, int fq) const {
        asm volatile("" : "+v"(fr), "+v"(fq));
        const int row0 = u.pm * 256 + wr * 64 + fr;
        float rs[2][4]; load_rstd(rl, wr, fr, fq, rs);
        bf16_t* O = F + u.pn * 128 + wc * 32 + 8 * fq;
#pragma unroll
        for (int ai = 0; ai < 2; ++ai)
#pragma unroll
            for (int m = 0; m < 4; ++m) { const float r = rs[ai][m]; float o[8];
                float ga[8], sg[8];
#pragma unroll
                for (int n = 0; n < 2; ++n)
#pragma unroll
                    for (int j = 0; j < 4; ++j) ga[n * 4 + j] = acc[ai][0][m][n][j] * r;
                sigmoid8(ga, sg);
#pragma unroll
                for (int n = 0; n < 2; ++n)
#pragma unroll
                    for (int j = 0; j < 4; ++j) o[n * 4 + j] = ga[n * 4 + j] * sg[n * 4 + j] * (acc[ai][1][m][n][j] * r);
                u32x4 w; w.x = cvt_pk_bf16(o[0], o[1]); w.y = cvt_pk_bf16(o[2], o[3]); w.z = cvt_pk_bf16(o[4], o[5]); w.w = cvt_pk_bf16(o[6], o[7]);
                *(u32x4*)(O + (size_t)(row0 + ai * 128 + m * 16) * DH) = w; }
    }
};

struct Args { const float* in[20]; float* out; unsigned char* ws; int ph_lo, ph_hi; };
#define KAS __attribute__((address_space(4)))
typedef const KAS Args* KArgs;
__device__ __forceinline__ KArgs fresh(KArgs p) { asm volatile("" : "+s"(p)); return p; }

__device__ __forceinline__ unsigned f2bf(float f) { unsigned u = __builtin_bit_cast(unsigned, f); return (u + 0x7fffu + ((u >> 16) & 1u)) >> 16; }
__device__ __forceinline__ unsigned pk2(float lo, float hi) { return pg8::cvt_pk_bf16(lo, hi); }
constexpr int P0_SCR = 64 * 65 * 4;
struct WItem { const float* W; int K, N; bf16_t* WT; int dest_row0; const float* gk; int kb, nb; };
template <bool NT = false> __device__ __forceinline__ void p0_item_load(const WItem& d, int lane, f32x4 (&v)[16]) {
    const float* src = d.W + (size_t)(64 * d.kb + (lane >> 4)) * d.N + 64 * d.nb + 4 * (lane & 15);
#pragma unroll
    for (int i = 0; i < 16; ++i) { if constexpr (NT) v[i] = __builtin_nontemporal_load((const f32x4*)(src + (size_t)(4 * i) * d.N)); else v[i] = *(const f32x4*)(src + (size_t)(4 * i) * d.N); }
}
template <bool NT = false> __device__ __forceinline__ void p0_item_finish(const WItem& d, LAS float* scr, int lane, const f32x4 (&v)[16]) {
    const int k0 = 64 * d.kb, K = d.K;
    const int c = lane & 7;
    f32x4 g0 = (f32x4){1.f, 1.f, 1.f, 1.f}, g1 = g0;
    if (d.gk) { g0 = *(const f32x4*)(d.gk + k0 + 8 * c); g1 = *(const f32x4*)(d.gk + k0 + 8 * c + 4); }
#pragma unroll
    for (int i = 0; i < 16; ++i) { LAS float* q = scr + (4 * i + (lane >> 4)) * 65 + 4 * (lane & 15); q[0] = v[i][0]; q[1] = v[i][1]; q[2] = v[i][2]; q[3] = v[i][3]; }
    LDS_WAIT(); asm volatile("" ::: "memory");
#pragma unroll
    for (int j = 0; j < 8; ++j) { const int n = (lane >> 3) + 8 * j; const LAS float* s = scr + (8 * c) * 65 + n;
        u32x4 o; o.x = pk2(s[0 * 65] * g0[0], s[1 * 65] * g0[1]); o.y = pk2(s[2 * 65] * g0[2], s[3 * 65] * g0[3]); o.z = pk2(s[4 * 65] * g1[0], s[5 * 65] * g1[1]); o.w = pk2(s[6 * 65] * g1[2], s[7 * 65] * g1[3]);
        if constexpr (NT) __builtin_nontemporal_store(o, (u32x4*)(d.WT + (size_t)(d.dest_row0 + n) * K + k0 + 8 * c)); else *(u32x4*)(d.WT + (size_t)(d.dest_row0 + n) * K + k0 + 8 * c) = o; }
    LDS_WAIT(); asm volatile("" ::: "memory");
}
__device__ __forceinline__ void p0_transpose_item(const float* W, int K, int N, bf16_t* WT, int dest_row0, const float* gk, LAS float* scr, int kb, int nb, int lane) {
    const WItem d{W, K, N, WT, dest_row0, gk, kb, nb}; f32x4 v[16]; p0_item_load<true>(d, lane, v); p0_item_finish(d, scr, lane, v);
}
__device__ __forceinline__ int win_map(int n0) {
    const int seg = n0 >> 10, off = n0 & 1023, p = off >> 7, j = off & 127;
    switch (seg) { case 0: return 256 * p + j; case 1: return 256 * p + 128 + j; case 2: return 4096 + off; case 3: return 2048 + 256 * p + j; case 4: return 2048 + 256 * p + 128 + j; case 5: return 5120 + 256 * p + j; default: return 5120 + 256 * p + 128 + j; }
}
constexpr int I_IN = (D / 64) * (NIN / 64), I_SQ = (D / 64) * (D / 64), I_GU = (D / 64) * (DH / 64), I_DN = (DH / 64) * (D / 64), I_LAYER = I_IN + 3 * I_SQ + 2 * I_GU + I_DN;
__device__ __forceinline__ void p0_weight_item(KArgs ap, int l, int r, LAS float* scr, int lane) {
    struct { const float* in[20]; float* out; unsigned char* ws; } a; a.ws = ap->ws; a.out = ap->out;
#pragma unroll
    for (int i = 0; i < 19; ++i) a.in[i] = ap->in[i];
    unsigned char* ws = a.ws; unsigned char* dob = (unsigned char*)a.out;
    bf16_t* w_in_t = (bf16_t*)(l ? dob + DO_W1_IN : ws + WS_W0_IN); bf16_t* w_ab_t = (bf16_t*)(ws + (l ? WS_W1_AB : WS_W0_AB)); bf16_t* w_o_t = (bf16_t*)(ws + (l ? WS_W1_O : WS_W0_O));
    bf16_t* w_gu_t = (bf16_t*)(l ? dob + DO_W1_GU : ws + WS_W0_GU); bf16_t* w_d_t = (bf16_t*)(l ? dob + DO_W1_D : ws + WS_W0_D);
    if (r < I_IN) { const int nblk = NIN / 64, kb = r / nblk, nb = r % nblk; p0_transpose_item(a.in[6] + (size_t)l * D * NIN, D, NIN, w_in_t, win_map(64 * nb), a.in[5] + l * D, scr, kb, nb, lane); return; } r -= I_IN;
    if (r < I_SQ) { const int nblk = D / 64, kb = r / nblk, nb = r % nblk; p0_transpose_item(a.in[11] + (size_t)l * D * D, D, D, w_ab_t, 64 * nb, nullptr, scr, kb, nb, lane); return; } r -= I_SQ;
    if (r < I_SQ) { const int nblk = D / 64, kb = r / nblk, nb = r % nblk; p0_transpose_item(a.in[13] + (size_t)l * D * D, D, D, w_ab_t, D + 64 * nb, nullptr, scr, kb, nb, lane); return; } r -= I_SQ;
    if (r < I_SQ) { const int nblk = D / 64, kb = r / nblk, nb = r % nblk; p0_transpose_item(a.in[14] + (size_t)l * D * D, D, D, w_o_t, 64 * nb, nullptr, scr, kb, nb, lane); return; } r -= I_SQ;
    if (r < I_GU) { const int nblk = DH / 64, kb = r / nblk, nb = r % nblk, n0 = 64 * nb; p0_transpose_item(a.in[16] + (size_t)l * D * DH, D, DH, w_gu_t, 256 * (n0 >> 7) + (n0 & 127), a.in[15] + l * D, scr, kb, nb, lane); return; } r -= I_GU;
    if (r < I_GU) { const int nblk = DH / 64, kb = r / nblk, nb = r % nblk, n0 = 64 * nb; p0_transpose_item(a.in[17] + (size_t)l * D * DH, D, DH, w_gu_t, 256 * (n0 >> 7) + 128 + (n0 & 127), a.in[15] + l * D, scr, kb, nb, lane); return; } r -= I_GU;
    { const int nblk = D / 64, kb = r / nblk, nb = r % nblk; p0_transpose_item(a.in[18] + (size_t)l * DH * D, DH, D, w_d_t, 64 * nb, nullptr, scr, kb, nb, lane); }
}
__device__ __forceinline__ WItem p0_weight_desc(KArgs ap, int l, int r) {
    struct { const float* in[20]; float* out; unsigned char* ws; } a; a.ws = ap->ws; a.out = ap->out;
#pragma unroll
    for (int i = 0; i < 19; ++i) a.in[i] = ap->in[i];
    unsigned char* ws = a.ws; unsigned char* dob = (unsigned char*)a.out;
    bf16_t* w_in_t = (bf16_t*)(l ? dob + DO_W1_IN : ws + WS_W0_IN); bf16_t* w_ab_t = (bf16_t*)(ws + (l ? WS_W1_AB : WS_W0_AB)); bf16_t* w_o_t = (bf16_t*)(ws + (l ? WS_W1_O : WS_W0_O));
    bf16_t* w_gu_t = (bf16_t*)(l ? dob + DO_W1_GU : ws + WS_W0_GU); bf16_t* w_d_t = (bf16_t*)(l ? dob + DO_W1_D : ws + WS_W0_D);
    if (r < I_IN) { const int nblk = NIN / 64, kb = r / nblk, nb = r % nblk; return WItem{a.in[6] + (size_t)l * D * NIN, D, NIN, w_in_t, win_map(64 * nb), a.in[5] + l * D, kb, nb}; } r -= I_IN;
    if (r < I_SQ) { const int nblk = D / 64, kb = r / nblk, nb = r % nblk; return WItem{a.in[11] + (size_t)l * D * D, D, D, w_ab_t, 64 * nb, nullptr, kb, nb}; } r -= I_SQ;
    if (r < I_SQ) { const int nblk = D / 64, kb = r / nblk, nb = r % nblk; return WItem{a.in[13] + (size_t)l * D * D, D, D, w_ab_t, D + 64 * nb, nullptr, kb, nb}; } r -= I_SQ;
    if (r < I_SQ) { const int nblk = D / 64, kb = r / nblk, nb = r % nblk; return WItem{a.in[14] + (size_t)l * D * D, D, D, w_o_t, 64 * nb, nullptr, kb, nb}; } r -= I_SQ;
    if (r < I_GU) { const int nblk = DH / 64, kb = r / nblk, nb = r % nblk, n0 = 64 * nb; return WItem{a.in[16] + (size_t)l * D * DH, D, DH, w_gu_t, 256 * (n0 >> 7) + (n0 & 127), a.in[15] + l * D, kb, nb}; } r -= I_GU;
    if (r < I_GU) { const int nblk = DH / 64, kb = r / nblk, nb = r % nblk, n0 = 64 * nb; return WItem{a.in[17] + (size_t)l * D * DH, D, DH, w_gu_t, 256 * (n0 >> 7) + 128 + (n0 & 127), a.in[15] + l * D, kb, nb}; } r -= I_GU;
    { const int nblk = D / 64, kb = r / nblk, nb = r % nblk; return WItem{a.in[18] + (size_t)l * DH * D, DH, D, w_d_t, 64 * nb, nullptr, kb, nb}; }
}
constexpr int NW_G1 = 231  , NW_G4 = 242  , N_HELPERS = 256 - NW_G1, BG_ITEMS = (I_LAYER - I_IN) + I_LAYER, BG_A = I_LAYER - I_IN, BG_B = BG_A + I_IN, BG_C = BG_ITEMS - I_DN;
struct WgRole { bool compute; int cc, h, vnext; };
__device__ __forceinline__ WgRole wg_role(int vcu, int NW) {
    const int idle = 256 - NW, base = idle >> 3, extra = idle & 7, xq = vcu >> 5, xr = vcu & 31, hx = base + (xq < extra ? 1 : 0), before = base * xq + (xq < extra ? xq : extra);
    WgRole r; r.compute = xr < 32 - hx; r.cc = vcu - before; r.h = before + (xr - (32 - hx)); r.vnext = (xr + 1 < 32 - hx) ? vcu + 1 : (xq + 1) * 32; return r;
}
__device__ __forceinline__ void p0_background(KArgs ap, LAS unsigned char* lds, int h, int nh, int lo, int hi, int wave, int lane) {
    LAS float* scr = (LAS float*)(lds + wave * P0_SCR);
    int it = lo + h * 8 + wave; if (it >= hi) return;
    WItem cur = (it < I_LAYER - I_IN) ? p0_weight_desc(ap, 0, I_IN + it) : p0_weight_desc(ap, 1, it - (I_LAYER - I_IN));
    f32x4 va[16]; p0_item_load<true>(cur, lane, va);
    for (;;) {
        const int nit = it + nh * 8; const bool more = nit < hi;
        const int nr = more ? nit : it;
        const WItem nxt = (nr < I_LAYER - I_IN) ? p0_weight_desc(ap, 0, I_IN + nr) : p0_weight_desc(ap, 1, nr - (I_LAYER - I_IN));
        f32x4 vb[16];
        if (more) p0_item_load<true>(nxt, lane, vb);
        p0_item_finish<true>(cur, scr, lane, va);
        if (!more) break;
#pragma unroll
        for (int i = 0; i < 16; ++i) va[i] = vb[i];
        cur = nxt; it = nit;
    }
}
__device__ __forceinline__ void p0_prologue(KArgs ap, LAS unsigned char* lds, int gw, int NGW, int wave, int lane) {
    struct { const float* in[20]; float* out; unsigned char* ws; } a; a.ws = ap->ws; a.out = ap->out;
#pragma unroll
    for (int i = 0; i < 19; ++i) a.in[i] = ap->in[i];
    LAS float* scr = (LAS float*)(lds + wave * P0_SCR);
    unsigned char* ws = a.ws;
    for (int it = gw; it < (MK_N_LAUNCHES == 1 ? I_IN : 2 * I_LAYER); it += NGW) p0_weight_item(ap, it / I_LAYER, it % I_LAYER, scr, lane);
    bf16_t* H = (bf16_t*)(ws + WS_H); float* ssq0 = (float*)(ws + WS_SSQ);
    for (int row = gw; row < MPAD; row += NGW) {
        const float* src = nullptr;
        if (row < ROW_S0) { const int b = row / TP, t = row % TP; src = t < 16 ? a.in[4] + (size_t)t * D : a.in[0] + ((size_t)b * 2048 + (t - 16)) * D; }
        else if (row < MREAL) src = a.in[1] + (size_t)(row - ROW_S0) * D;
        float s = 0.f;
#pragma unroll
        for (int j = 0; j < 4; ++j) { f32x4 v = src ? __builtin_nontemporal_load((const f32x4*)(src + 256 * j + 4 * lane)) : (f32x4){0.f, 0.f, 0.f, 0.f};
            s += (v[0] * v[0] + v[1] * v[1]) + (v[2] * v[2] + v[3] * v[3]);
            u32x2 o; o.x = pk2(v[0], v[1]); o.y = pk2(v[2], v[3]); *(u32x2*)(H + (size_t)row * D + 256 * j + 4 * lane) = o; }
        s = wave_sum(s);
        if (lane < 16) ssq0[(size_t)lane * MPAD + row] = lane == 0 ? s : 0.f;
    }
    bf16_t* haloA = (bf16_t*)(ws + WS_HALOA); bf16_t* haloB = (bf16_t*)(ws + WS_HALOB);
    for (int it = gw; it < 2 * NSTREAM * 32; it += NGW) {
        const int l = it / (NSTREAM * 32), S = (it / 32) % NSTREAM, p = it % 32;
        const float* src = nullptr; bf16_t* dst;
        if (p < 30) { dst = haloA + ((size_t)(l * NSTREAM + S) * 30 + p) * D; if (S >= NPROMPT) src = a.in[2] + ((size_t)(l * NSAMP + (S - NPROMPT)) * 30 + p) * D; }
        else { dst = haloB + ((size_t)(l * NSTREAM + S) * 2 + (p - 30)) * D; if (S >= NPROMPT) src = a.in[3] + ((size_t)(l * NSAMP + (S - NPROMPT)) * 2 + (p - 30)) * D; }
#pragma unroll
        for (int j = 0; j < 4; ++j) { f32x4 v = src ? *(const f32x4*)(src + 256 * j + 4 * lane) : (f32x4){0.f, 0.f, 0.f, 0.f};
            u32x2 o; o.x = pk2(v[0], v[1]); o.y = pk2(v[2], v[3]); *(u32x2*)(dst + 256 * j + 4 * lane) = o; }
    }
}

static_assert(true, "");
constexpr int CR = 24, N_CONV_ITEMS = NPROMPT * (TP / CR) + NSAMP;
static_assert(TP % CR == 0, "conv chunking");
constexpr int CONV_STAGE_BYTES = (CR + 30) * 2048;
static_assert(CONV_STAGE_BYTES + 8 * CR * 2 * 4 + CR * 2 * 4 <= RING_BYTES, "conv LDS");
static_assert(8 * P0_SCR <= LDSCTL_OFF, "prologue LDS");
struct ConvItem { int S, t0, nrows; size_t rowS; };
__device__ __forceinline__ ConvItem conv_item(int it) {
    ConvItem ci;
    if (it < NPROMPT * (TP / CR)) { ci.S = it / (TP / CR); ci.t0 = (it % (TP / CR)) * CR; ci.nrows = CR; ci.rowS = (size_t)ci.S * TP; }
    else { ci.S = NPROMPT + (it - NPROMPT * (TP / CR)); ci.t0 = 0; ci.nrows = TS; ci.rowS = (size_t)ROW_S0 + (size_t)(ci.S - NPROMPT) * TS; }
    return ci;
}
__device__ __forceinline__ void conv_stage_a(LAS unsigned char* lds, const bf16_t* UA, const bf16_t* haloA_l, const ConvItem& ci, int wave, int lane) {
    const bf16_t* hA = haloA_l + (size_t)ci.S * 30 * D; const bf16_t* uS = UA + ci.rowS * D;
    for (int p = wave; p < 2 * (CR + 30); p += 8) { const int r = p >> 1, h = p & 1, tp = ci.t0 - 30 + r;
        const bf16_t* src = tp >= 0 ? uS + (size_t)tp * D : hA + (size_t)(30 + tp) * D;
        __builtin_amdgcn_global_load_lds((const unsigned*)((const char*)src + h * 1024 + lane * 16), (LAS unsigned*)(lds + r * 2048 + h * 1024), 16, 0, 2  ); }
}
__device__ __forceinline__ void conv_load_b(u32x4 (&zb)[8], u32x4 (&bb)[6], const bf16_t* ZB, const bf16_t* BB, const bf16_t* haloB_l, const ConvItem& ci, int cg, int rg) {
    const bf16_t* hB = haloB_l + (size_t)ci.S * 2 * D; const bf16_t* zS = ZB + ci.rowS * D; const int r0 = ci.t0 + 6 * rg;
    const bf16_t* z0p = r0 == 0 ? hB : zS + (size_t)(r0 - 2) * D; const bf16_t* z1p = r0 == 0 ? hB + D : zS + (size_t)(r0 - 1) * D;
    zb[0] = *(const u32x4*)(z0p + 8 * cg); zb[1] = *(const u32x4*)(z1p + 8 * cg);
    const bf16_t* zp = zS + (size_t)r0 * D + 8 * cg;
#pragma unroll
    for (int i = 0; i < 6; ++i) { zb[2 + i] = __builtin_nontemporal_load((const u32x4*)zp); zp += D; asm volatile("" : "+v"(zp)); }
    const bf16_t* bp = BB + (ci.rowS + r0) * D + 8 * cg;
#pragma unroll
    for (int i = 0; i < 6; ++i) { bb[i] = __builtin_nontemporal_load((const u32x4*)bp); bp += D; asm volatile("" : "+v"(bp)); }
}
__device__ __forceinline__ void conv_phase(KArgs ap, int l, LAS unsigned char* lds, int tid, int wave, int lane) {
    struct { const float* in[20]; float* out; unsigned char* ws; } a; a.ws = ap->ws; a.out = ap->out; a.in[2] = ap->in[2]; a.in[7] = ap->in[7]; a.in[8] = ap->in[8]; a.in[9] = ap->in[9]; a.in[10] = ap->in[10]; a.in[12] = ap->in[12];
    unsigned char* ws = a.ws;
    const bf16_t* UA = (const bf16_t*)(ws + WS_UA); const bf16_t* ZB = (const bf16_t*)(ws + WS_ZB); bf16_t* BB = (bf16_t*)(ws + WS_BB); bf16_t* CA = (bf16_t*)((unsigned char*)a.out + DO_CA);
    const bf16_t* haloA = (const bf16_t*)(ws + WS_HALOA) + (size_t)l * NSTREAM * 30 * D; const bf16_t* haloB = (const bf16_t*)(ws + WS_HALOB) + (size_t)l * NSTREAM * 2 * D;
    LAS float* red = (LAS float*)(lds + CONV_STAGE_BYTES);
    LAS float* fin = red + 8 * CR * 2;
    const LAS unsigned char* xl = lds + tid * 4;
    const int c0 = 2 * tid;
    const int cg = tid & 127, rg = tid >> 7;
    const float* cbw = a.in[12] + (size_t)l * 3 * D + 8 * cg;
    const f32x2 bias = *(const f32x2*)(a.in[8] + l * D + c0), lng = *(const f32x2*)(a.in[9] + l * D + c0), lnb = *(const f32x2*)(a.in[10] + l * D + c0);
    f32x4 wb[3][2];
#pragma unroll
    for (int k = 0; k < 3; ++k) { wb[k][0] = *(const f32x4*)(cbw + k * D); wb[k][1] = *(const f32x4*)(cbw + k * D + 4); }
    f32x2 w[31];
#define CONV_LOAD_TAPS() do { const float* wp = a.in[7] + (size_t)l * 31 * D + c0; asm volatile("" : "+v"(wp)); \
        _Pragma("unroll") for (int k = 0; k < 31; ++k) { w[k] = *(const f32x2*)wp; wp += D; asm volatile("" : "+v"(wp)); } } while (0)
    CONV_LOAD_TAPS();
    u32x4 zb[8], bb[6];
    int it = blockIdx.x; ConvItem ci = conv_item(it < N_CONV_ITEMS ? it : 0);
    __syncthreads();
    if (it < N_CONV_ITEMS) { conv_stage_a(lds, UA, haloA, ci, wave, lane); conv_load_b(zb, bb, ZB, BB, haloB, ci, cg, rg); }
    for (; it < N_CONV_ITEMS; it += gridDim.x) {
        VM_WAIT(); __syncthreads();
        f32x2 acc[CR];
#pragma unroll
        for (int i = 0; i < CR; ++i) acc[i] = bias;
#pragma unroll
        for (int j = 0; j < CR + 30; ++j) {
            const unsigned xw = *(const LAS unsigned*)(xl + j * 2048); const f32x2 xv = {bf_lo(xw), bf_hi(xw)};
#pragma unroll
            for (int i = (j - 30 > 0 ? j - 30 : 0); i <= (j < CR - 1 ? j : CR - 1); ++i) acc[i] = __builtin_elementwise_fma(w[j - i], xv, acc[i]);
            if ((j & 7) == 7) {
#pragma unroll
                for (int i = 0; i < CR; i += 4) asm volatile("" : "+v"(acc[i].x), "+v"(acc[i].y), "+v"(acc[i + 1].x), "+v"(acc[i + 1].y), "+v"(acc[i + 2].x), "+v"(acc[i + 2].y), "+v"(acc[i + 3].x), "+v"(acc[i + 3].y) :: "memory");
            }
        }
        { float pv[2 * CR];
#pragma unroll
          for (int i = 0; i < CR; ++i) { pv[2 * i] = acc[i].x + acc[i].y; pv[2 * i + 1] = acc[i].x * acc[i].x + acc[i].y * acc[i].y; }
          const float tot = reduce48(pv, lane);
          if (lane < 2 * CR) red[wave * 2 * CR + lane] = tot; }
#pragma unroll
        for (int j = 0; j < 6; ++j) if (6 * rg + j < ci.nrows) {
            unsigned o[4];
#pragma unroll
            for (int q = 0; q < 4; ++q) {
                const float c0v = wb[0][q >> 1][(2 * q) & 3] * bf_lo(zb[j][q]) + wb[1][q >> 1][(2 * q) & 3] * bf_lo(zb[j + 1][q]) + wb[2][q >> 1][(2 * q) & 3] * bf_lo(zb[j + 2][q]);
                const float c1v = wb[0][q >> 1][(2 * q + 1) & 3] * bf_hi(zb[j][q]) + wb[1][q >> 1][(2 * q + 1) & 3] * bf_hi(zb[j + 1][q]) + wb[2][q >> 1][(2 * q + 1) & 3] * bf_hi(zb[j + 2][q]);
                o[q] = cvt_pk_bf16_pin(bf_lo(bb[j][q]) * c0v, bf_hi(bb[j][q]) * c1v); }
            u32x4 w4; w4.x = o[0]; w4.y = o[1]; w4.z = o[2]; w4.w = o[3];
            __builtin_nontemporal_store(w4, (u32x4*)(BB + (ci.rowS + ci.t0 + 6 * rg + j) * D + 8 * cg)); }
        LDS_WAIT(); __syncthreads();
        const int nit = it + gridDim.x; const bool more = nit < N_CONV_ITEMS; const ConvItem cn = conv_item(more ? nit : it);
        if (more) conv_stage_a(lds, UA, haloA, cn, wave, lane);
        if (tid < CR) { float s1 = 0.f, s2 = 0.f;
#pragma unroll
            for (int wv = 0; wv < 8; ++wv) { s1 += red[(wv * CR + tid) * 2]; s2 += red[(wv * CR + tid) * 2 + 1]; }
            const float mean = s1 * (1.0f / D); float var = s2 * (1.0f / D) - mean * mean; var = var > 0.f ? var : 0.f;
            fin[tid * 2] = mean; fin[tid * 2 + 1] = 1.0f / sqrtf(var + LN_EPS); }
        LDS_WAIT(); __syncthreads();
#pragma unroll
        for (int i = 0; i < CR; ++i) if (i < ci.nrows) {
            const float mean = fin[i * 2], rstd = fin[i * 2 + 1];
            const f32x2 s = lng * rstd, t = __builtin_elementwise_fma(s, (f32x2){-mean, -mean}, lnb), y = __builtin_elementwise_fma(acc[i], s, t), a = y * -1.4426950408889634f;
            f32x2 e = {__builtin_amdgcn_exp2f(a.x), __builtin_amdgcn_exp2f(a.y)}; e = e + 1.0f;
            const f32x2 r = {__builtin_amdgcn_rcpf(e.x), __builtin_amdgcn_rcpf(e.y)}, o = y * r;
            __builtin_nontemporal_store(cvt_pk_bf16_pin(o.x, o.y), (unsigned*)(CA + (ci.rowS + ci.t0 + i) * D + c0)); }
        if (more) { conv_load_b(zb, bb, ZB, BB, haloB, cn, cg, rg); CONV_LOAD_TAPS(); }
        ci = cn;
    }
    VM_WAIT(); __syncthreads();
    for (int it = blockIdx.x; it < NSTREAM * 32; it += gridDim.x) {
        const int S = it / 32, p = it % 32; float* dst; f32x2 v;
        if (p < 30) {
            if (S < NPROMPT) { dst = a.out + OUT_NAP + ((size_t)(l * NPROMPT + S) * 30 + p) * D; const unsigned xw = *(const unsigned*)(UA + ((size_t)S * TP + (TP - 30) + p) * D + c0); v = (f32x2){bf_lo(xw), bf_hi(xw)}; }
            else { const int s = S - NPROMPT; dst = a.out + OUT_NAS + ((size_t)(l * NSAMP + s) * 30 + p) * D;
                if (p < 30 - TS) v = *(const f32x2*)(a.in[2] + ((size_t)(l * NSAMP + s) * 30 + TS + p) * D + c0);
                else { const unsigned xw = *(const unsigned*)(UA + ((size_t)ROW_S0 + (size_t)s * TS + (p - (30 - TS))) * D + c0); v = (f32x2){bf_lo(xw), bf_hi(xw)}; } }
        } else { const int q = p - 30;
            if (S < NPROMPT) { dst = a.out + OUT_NBP + ((size_t)(l * NPROMPT + S) * 2 + q) * D; const unsigned xw = *(const unsigned*)(ZB + ((size_t)S * TP + (TP - 2) + q) * D + c0); v = (f32x2){bf_lo(xw), bf_hi(xw)}; }
            else { const int s = S - NPROMPT; dst = a.out + OUT_NBS + ((size_t)(l * NSAMP + s) * 2 + q) * D; const unsigned xw = *(const unsigned*)(ZB + ((size_t)ROW_S0 + (size_t)s * TS + (TS - 2) + q) * D + c0); v = (f32x2){bf_lo(xw), bf_hi(xw)}; } }
        *(f32x2*)(dst + c0) = v;
    }
}

__device__ __forceinline__ void final_phase(KArgs ap, int gw, int NGW, int lane) {
    struct { const float* in[20]; float* out; unsigned char* ws; } a; a.ws = ap->ws; a.out = ap->out; a.in[19] = ap->in[19];
    const bf16_t* H = (const bf16_t*)(a.ws + WS_H); const float* ssq = (const float*)(a.ws + WS_SSQ + 4 * SSQ_ONE); const float* g = a.in[19];
    for (int row = gw; row < MREAL; row += NGW) {
        float* dst;
        if (row < ROW_S0) { const int b = row / TP, t = row % TP; if (t < 16) continue; dst = a.out + OUT_YP + ((size_t)b * 2048 + (t - 16)) * D; }
        else dst = a.out + OUT_YS + (size_t)(row - ROW_S0) * D;
        float s = lane < 16 ? ssq[(size_t)lane * MPAD + row] : 0.f; s = wave_sum(s);
        const float r = 1.0f / sqrtf(s * (1.0f / D) + RMS_EPS);
#pragma unroll
        for (int j = 0; j < 2; ++j) { const int c = 512 * j + 8 * lane; const u32x4 h = __builtin_nontemporal_load((const u32x4*)(H + (size_t)row * D + c));
            const f32x4 g0 = *(const f32x4*)(g + c), g1 = *(const f32x4*)(g + c + 4);
            f32x4 o0, o1; o0[0] = bf_lo(h.x) * r * g0[0]; o0[1] = bf_hi(h.x) * r * g0[1]; o0[2] = bf_lo(h.y) * r * g0[2]; o0[3] = bf_hi(h.y) * r * g0[3];
            o1[0] = bf_lo(h.z) * r * g1[0]; o1[1] = bf_hi(h.z) * r * g1[1]; o1[2] = bf_lo(h.w) * r * g1[2]; o1[3] = bf_hi(h.w) * r * g1[3];
            __builtin_nontemporal_store(o0, (f32x4*)(dst + c)); __builtin_nontemporal_store(o1, (f32x4*)(dst + c + 4)); }
    }
}

__global__ void __launch_bounds__(512, 2) mega_fwd(Args a_unused) {
    extern __shared__ __attribute__((aligned(16))) unsigned char lds_raw[];
    LAS unsigned char* lds = (LAS unsigned char*)lds_raw;
    const KArgs kp = (KArgs)__builtin_amdgcn_kernarg_segment_ptr();
    const int wave = __builtin_amdgcn_readfirstlane(threadIdx.x >> 6);
    const int G = gridDim.x, bx = blockIdx.x, vcu = (G % 8 == 0) ? (bx % 8) * (G / 8) + bx / 8 : bx;
    const int gw = vcu * 8 + wave, NGW = G * 8;
    volatile LAS unsigned* ctl = (volatile LAS unsigned*)(lds + LDSCTL_OFF);
    if (threadIdx.x < 64) ctl[threadIdx.x] = 0u;
    __syncthreads();
    XcdBarrier bar; bar.bar = (unsigned*)(kp->ws + WS_CTL); bar.x = 0; bar.st = nullptr;
    if (MK_N_LAUNCHES == 1) bar = xcd_barrier_post((unsigned*)(kp->ws + WS_CTL), ctl + 8);
    const unsigned my_xcc = xb_xcc_id();
    if (threadIdx.x == 0) __hip_atomic_store((unsigned*)(kp->ws + WS_XCCTAB) + vcu, my_xcc + 1u, __ATOMIC_RELAXED, __HIP_MEMORY_SCOPE_AGENT);
    const int lo = kp->ph_lo, hi = kp->ph_hi;
#define IN(k) (lo <= (k) && (k) < hi)
#define SEAM(k) do { if (IN(k) && IN((k) + 1)) xcd_barrier(bar, wave); } while (0)

    if (IN(0)) { for (int rep = 0; rep < REP_P0; ++rep) { p0_prologue(fresh(kp), lds, gw, NGW, wave, lane_id()); __syncthreads(); } SEAM(0); }

    const int same_next = (MK_N_LAUNCHES == 1 && vcu + 1 < G) ? (__builtin_amdgcn_readfirstlane(__hip_atomic_load((unsigned*)(kp->ws + WS_XCCTAB) + vcu + 1, __ATOMIC_RELAXED, __HIP_MEMORY_SCOPE_AGENT)) == my_xcc + 1u) : 0;
#pragma unroll 1
    for (int l = 0; l < 2; ++l) {
        const int pb = 1 + 6 * l;
        if (IN(pb + 0)) {
            const KArgs ap = fresh(kp); unsigned char* ws = ap->ws; unsigned char* dob = (unsigned char*)ap->out;
            const bf16_t* H = (const bf16_t*)(ws + WS_H); const bf16_t* w_in_t = (const bf16_t*)(l ? dob + DO_W1_IN : ws + WS_W0_IN);
            pg8::Gemm g{H, w_in_t, H, w_in_t}; pg8::StreamK<NIN / 256, D / 128, 0> S; S.init(vcu);
            Epi1 E{{(const float*)(ws + WS_SSQ + (size_t)(2 * l) * SSQ_ONE), lds + RSTD_OFF}, (bf16_t*)(ws + WS_UA)}; pg8::SlotIO io{dob + DO_CA, (unsigned*)(ws + WS_SKFLAG) + (size_t)(5 * l + 0) * 256 * 64, vcu, same_next};
            if (MK_N_LAUNCHES == 1) {
                const WgRole wr = wg_role(vcu, NW_G1);
                if (!wr.compute) p0_background(fresh(kp), lds, wr.h, N_HELPERS, l ? BG_B : 0, l ? BG_C : BG_A, wave, lane_id());
                else {
                    const KArgs ap2 = fresh(kp); unsigned char* ws2 = ap2->ws; unsigned char* dob2 = (unsigned char*)ap2->out;
                    const bf16_t* H2 = (const bf16_t*)(ws2 + WS_H); const bf16_t* w2 = (const bf16_t*)(l ? dob2 + DO_W1_IN : ws2 + WS_W0_IN);
                    const pg8::Gemm g2{H2, w2, H2, w2}; pg8::StreamK<NIN / 256, D / 128, 0, NW_G1> S2; S2.init(opaque_s(wr.cc));
                    const Epi1 E2{{(const float*)(ws2 + WS_SSQ + (size_t)(2 * l) * SSQ_ONE), lds + RSTD_OFF}, (bf16_t*)(ws2 + WS_UA)}; const pg8::SlotIO io2{dob2 + DO_CA, (unsigned*)(ws2 + WS_SKFLAG) + (size_t)(5 * l + 0) * 256 * 64, opaque_s(wr.cc), 0};
                    pg8::gemm_phase<Epi1, pg8::StreamK<NIN / 256, D / 128, 0, NW_G1>, D, 1 << 20>(lds, g2, S2, E2, io2, wave);
                }
            } else
            for (int rep = 0; rep < REP_G1; ++rep) pg8::gemm_phase<Epi1, pg8::StreamK<NIN / 256, D / 128, 0>, D, 1 << 20>(lds, g, S, E, io, wave);
            SEAM(pb + 0);
        }
        if (IN(pb + 1)) { const int l_ = lane_id(); conv_phase(fresh(kp), l, lds, wave * 64 + l_, wave, l_); SEAM(pb + 1); }
        if (IN(pb + 2)) {
            const KArgs ap = fresh(kp); unsigned char* ws = ap->ws; unsigned char* dob = (unsigned char*)ap->out;
            const bf16_t* w_ab_t = (const bf16_t*)(ws + (l ? WS_W1_AB : WS_W0_AB));
            pg8::Gemm g{(const bf16_t*)(dob + DO_CA), w_ab_t, (const bf16_t*)(ws + WS_BB), w_ab_t + (size_t)D * D}; pg8::StreamK<D / 256, 2 * D / 128, 16> S; S.init(vcu);
            Epi2 E{(bf16_t*)(ws + WS_SGA), (const bf16_t*)(ws + WS_SGB), (bf16_t*)(ws + WS_SGA)}; pg8::SlotIO io{ws + WS_UA, (unsigned*)(ws + WS_SKFLAG) + (size_t)(5 * l + 1) * 256 * 64, vcu, same_next};
            pg8::gemm_phase<Epi2, pg8::StreamK<D / 256, 2 * D / 128, 16>, D, 16>(lds, g, S, E, io, wave);
            SEAM(pb + 2);
        }
        if (IN(pb + 3)) {
            const KArgs ap = fresh(kp); unsigned char* ws = ap->ws;
            const bf16_t* MG = (const bf16_t*)(ws + WS_SGA); const bf16_t* w_o_t = (const bf16_t*)(ws + (l ? WS_W1_O : WS_W0_O));
            pg8::Gemm g{MG, w_o_t, MG, w_o_t}; pg8::StreamK<D / 256, D / 128, 0> S; S.init(vcu);
            EpiRes E{(bf16_t*)(ws + WS_H), (float*)(ws + WS_SSQ + (size_t)(2 * l + 1) * SSQ_ONE), (bf16_t*)(ws + WS_H)}; pg8::SlotIO io{ws + WS_UA, (unsigned*)(ws + WS_SKFLAG) + (size_t)(5 * l + 2) * 256 * 64, vcu, same_next};
            pg8::gemm_phase<EpiRes, pg8::StreamK<D / 256, D / 128, 0>, D, 1 << 20>(lds, g, S, E, io, wave);
            SEAM(pb + 3);
        }
        if (IN(pb + 4)) {
            const KArgs ap = fresh(kp); unsigned char* ws = ap->ws; unsigned char* dob = (unsigned char*)ap->out;
            const bf16_t* H = (const bf16_t*)(ws + WS_H); const bf16_t* w_gu_t = (const bf16_t*)(l ? dob + DO_W1_GU : ws + WS_W0_GU);
            pg8::Gemm g{H, w_gu_t, H, w_gu_t}; pg8::StreamK<NGU / 256, D / 128, 0> S; S.init(vcu);
            Epi4 E{{(const float*)(ws + WS_SSQ + (size_t)(2 * l + 1) * SSQ_ONE), lds + RSTD_OFF}, (bf16_t*)(ws + WS_F)}; pg8::SlotIO io{ws + WS_SGB, (unsigned*)(ws + WS_SKFLAG) + (size_t)(5 * l + 3) * 256 * 64, vcu, same_next};
            if (MK_N_LAUNCHES == 1) {
                const WgRole wr = wg_role(vcu, NW_G4);
                if (!wr.compute) p0_background(fresh(kp), lds, wr.h, 256 - NW_G4, l ? BG_C : BG_A, l ? BG_ITEMS : BG_B, wave, lane_id());
                else {
                    const KArgs ap2 = fresh(kp); unsigned char* ws2 = ap2->ws; unsigned char* dob2 = (unsigned char*)ap2->out;
                    const bf16_t* H2 = (const bf16_t*)(ws2 + WS_H); const bf16_t* w2 = (const bf16_t*)(l ? dob2 + DO_W1_GU : ws2 + WS_W0_GU);
                    const pg8::Gemm g2{H2, w2, H2, w2}; pg8::StreamK<NGU / 256, D / 128, 0, NW_G4> S2; S2.init(opaque_s(wr.cc));
                    const Epi4 E2{{(const float*)(ws2 + WS_SSQ + (size_t)(2 * l + 1) * SSQ_ONE), lds + RSTD_OFF}, (bf16_t*)(ws2 + WS_F)}; const pg8::SlotIO io2{ws2 + WS_SGB, (unsigned*)(ws2 + WS_SKFLAG) + (size_t)(5 * l + 3) * 256 * 64, opaque_s(wr.cc), 0};
                    pg8::gemm_phase<Epi4, pg8::StreamK<NGU / 256, D / 128, 0, NW_G4>, D, 1 << 20>(lds, g2, S2, E2, io2, wave);
                }
            } else
            for (int rep = 0; rep < REP_G4; ++rep) pg8::gemm_phase<Epi4, pg8::StreamK<NGU / 256, D / 128, 0>, D, 1 << 20>(lds, g, S, E, io, wave);
            SEAM(pb + 4);
        }
        if (IN(pb + 5)) {
            const KArgs ap = fresh(kp); unsigned char* ws = ap->ws; unsigned char* dob = (unsigned char*)ap->out;
            const bf16_t* F = (const bf16_t*)(ws + WS_F); const bf16_t* w_d_t = (const bf16_t*)(l ? dob + DO_W1_D : ws + WS_W0_D);
            pg8::Gemm g{F, w_d_t, F, w_d_t}; pg8::StreamK<D / 256, DH / 128, 0> S; S.init(vcu);
            EpiRes E{(bf16_t*)(ws + WS_H), (float*)(ws + WS_SSQ + (size_t)(2 * l + 2) * SSQ_ONE), (bf16_t*)(ws + WS_H)}; pg8::SlotIO io{ws + WS_SGB, (unsigned*)(ws + WS_SKFLAG) + (size_t)(5 * l + 4) * 256 * 64, vcu, same_next};
            pg8::gemm_phase<EpiRes, pg8::StreamK<D / 256, DH / 128, 0>, DH, 1 << 20>(lds, g, S, E, io, wave);
            SEAM(pb + 5);
        }
    }
    if (IN(13)) for (int rep = 0; rep < REP_FIN; ++rep) final_phase(fresh(kp), gw, NGW, lane_id());
#undef IN
#undef SEAM
}

extern "C" void kernel_launch(void* const* d_in, const int* in_sizes, int n_in, void* d_out, int out_size, void* d_ws, size_t ws_size, hipStream_t stream) {
    static int grid = 0;
    if (grid == 0) {
        if (n_in != 20 || (size_t)out_size != OUT_TOTAL || ws_size < WS_END) { fprintf(stderr, "kernel_launch: unexpected shapes (n_in %d, out %d, ws %zu); nothing launched\n", n_in, out_size, ws_size); grid = -1; return; }
        int dev = 0, cus = 0, per_cu = 0;
        if (hipGetDevice(&dev) != hipSuccess || hipDeviceGetAttribute(&cus, hipDeviceAttributeMultiprocessorCount, dev) != hipSuccess) { grid = -1; return; }
        if (hipFuncSetAttribute((const void*)mega_fwd, hipFuncAttributeMaxDynamicSharedMemorySize, LDS_BYTES) != hipSuccess) { fprintf(stderr, "kernel_launch: hipFuncSetAttribute failed\n"); grid = -1; return; }
        if (hipOccupancyMaxActiveBlocksPerMultiprocessor(&per_cu, (const void*)mega_fwd, 512, LDS_BYTES) != hipSuccess || per_cu < 1) { fprintf(stderr, "kernel_launch: occupancy query says %d blocks per CU\n", per_cu); per_cu = 1; }
        (void)hipGetLastError();
        if (cus != 256) { fprintf(stderr, "kernel_launch: built for a 256-CU device (got %d)\n", cus); grid = -1; return; }
        grid = cus;
    }
    if (grid < 0) return;
    if (hipMemsetAsync((char*)d_ws + WS_CTL, 0, CTL_ZERO_BYTES, stream) != hipSuccess) { fprintf(stderr, "kernel_launch: memset failed\n"); return; }
    Args a{};
    for (int i = 0; i < 20; ++i) a.in[i] = (const float*)d_in[i];
    a.out = (float*)d_out; a.ws = (unsigned char*)d_ws;
    for (int li = 0; li < MK_N_LAUNCHES; ++li) {
        a.ph_lo = (MK_N_LAUNCHES == 1) ? 0 : li; a.ph_hi = (MK_N_LAUNCHES == 1) ? NPHASE : li + 1;
        hipLaunchKernelGGL(mega_fwd, dim3(grid), dim3(512), LDS_BYTES, stream, a);
        const hipError_t le = hipPeekAtLastError();
        if (le != hipSuccess) { fprintf(stderr, "kernel_launch: launch %d failed: %s\n", li, hipGetErrorName(le)); break; }
    }
}
```

```cpp
#include <hip/hip_runtime.h>
#include <cstdio>
#include <cstdint>

#ifndef REP_P0
#define REP_P0 1
#endif
#ifndef REP_G1
#define REP_G1 1
#endif
#ifndef REP_G4
#define REP_G4 1
#endif
#ifndef REP_FIN
#define REP_FIN 1
#endif
#ifndef DRY_G2
#define DRY_G2 0
#endif
#ifndef DRY_G3
#define DRY_G3 0
#endif
#ifndef DRY_G5
#define DRY_G5 0
#endif
#ifndef MK_N_LAUNCHES
#define MK_N_LAUNCHES 1
#endif

constexpr int D = 1024, NIN = 7168, DH = 2816, NGU = 2 * DH;
constexpr int NPROMPT = 8, TP = 2064, NSAMP = 16, TS = 16, NSTREAM = NPROMPT + NSAMP;
constexpr int ROW_S0 = NPROMPT * TP;
constexpr int MREAL = ROW_S0 + NSAMP * TS;
constexpr int MPAD = 16896, NPAN = MPAD / 256;
static_assert(NPAN == 66, "StreamK assumes 66 row panels (a last group of two)");
constexpr float RMS_EPS = 1e-6f, LN_EPS = 1e-5f;
constexpr int NPHASE = 14;

__device__ __forceinline__ int opaque_v(int x) { asm volatile("" : "+v"(x)); return x; }
__device__ __forceinline__ int opaque_s(int x) { asm volatile("" : "+s"(x)); return x; }
__device__ __forceinline__ int lane_id() { int x; asm volatile("v_mbcnt_lo_u32_b32 %0, -1, 0\n\tv_mbcnt_hi_u32_b32 %0, -1, %0" : "=v"(x)); return x; }
namespace pg8 {
#define PG8_LAS __attribute__((address_space(3)))
typedef unsigned short bf16_t;
typedef short bf16x8 __attribute__((ext_vector_type(8)));
typedef float f32x4 __attribute__((ext_vector_type(4)));
typedef unsigned u32x4 __attribute__((ext_vector_type(4)));
constexpr int BM = 256, BK = 64, HALF = 128, HTB = HALF * BK * 2  , STAGE_BYTES = 8 * HTB, NXCD = 8, WGM = 8;

__host__ __device__ __forceinline__ int lds_byte(int r, int c) { const int st = (r >> 4) * 2 + (c >> 5), rr = r & 15, cc = c & 31, ob = rr * 64 + cc * 2; return st * 1024 + (ob ^ (((ob >> 9) & 1) << 5)); }
__host__ __device__ __forceinline__ void stage_rc(int b, int& R, int& C) { const int st = b / 1024, sb = b % 1024, swz = sb ^ (((sb >> 9) & 1) << 5); R = (st >> 1) * 16 + swz / 64; C = (st & 1) * 32 + (swz % 64) / 2; }
__host__ __device__ __forceinline__ int perm32(int rho) { const int n = rho >> 4, i = rho & 15; return 8 * (i >> 2) + 4 * n + (i & 3); }

struct Unit { int pm, pn, kb, nk, flags; };
struct Gemm { const bf16_t* A; const bf16_t* Bt; const bf16_t* A2; const bf16_t* Bt2; };
struct SlotIO { unsigned char* slots; unsigned* flags; int me; int same_next; };

template <int NN  , int P  , int KSPLIT  , int NW = 256  >
struct StreamK {
    static constexpr int nM = 66, nN = NN, NTILES = nM * nN, N_DP_ROUNDS = (NTILES / NW - 1) > 0 ? (NTILES / NW - 1) : 0, N_DP = NW * N_DP_ROUNDS;
    static constexpr bool WHOLE = (NTILES % NW == 0) && KSPLIT == 0;
    int c, t_first, o_s, t_last, o_e, has_head, has_tail, first_full, n_full;
    __device__ static int cut(int c) { return (int)((long)(NTILES - N_DP) * P * c / NW); }
    __device__ void init(int c_) {
        c = c_;
        const int s = cut(c), e = cut(c + 1);
        t_first = s / P; o_s = s % P; t_last = (e - 1) / P; o_e = e - t_last * P;
        has_tail = (o_s > 0 && e > s); has_head = (o_e < P && e > s && !(t_last == t_first && o_s > 0));
        first_full = has_tail ? t_first + 1 : t_first; const int last_full = has_head ? t_last - 1 : t_last; n_full = (e > s) ? last_full - first_full + 1 : 0; if (n_full < 0) n_full = 0;
    }
    __device__ static void tile_of(int t, Unit& u) { constexpr int nig = WGM * nN; const int gid = t / nig, fm = gid * WGM, r = t - gid * nig;
        if (nM - fm >= WGM) { u.pm = fm + (r & (WGM - 1)); u.pn = r / WGM; } else { u.pm = fm + (r & 1); u.pn = r >> 1; } }
    __device__ bool base(int i, Unit& u) const {
        if (has_head) { if (i == 0) { tile_of(N_DP + t_last, u); u.kb = 0; u.nk = 2 * o_e; u.flags = 2; return true; } --i; }
        if (i < N_DP_ROUNDS) { tile_of(NW * i + c, u); u.kb = 0; u.nk = 2 * P; u.flags = 0; return true; } i -= N_DP_ROUNDS;
        if (i < n_full) { tile_of(N_DP + first_full + i, u); u.kb = 0; u.nk = 2 * P; u.flags = 0; return true; } i -= n_full;
        if (has_tail && i == 0) { tile_of(N_DP + t_first, u); u.kb = 2 * o_s; u.nk = 2 * (P - o_s); u.flags = 1; return true; }
        return false;
    }
    mutable int it_i, it_second; mutable Unit it_u;
    __device__ void start() const { it_i = 0; it_second = 0; }
    __device__ bool advance(Unit& u) const {
        if constexpr (KSPLIT > 0) { if (it_second) { u = it_u; u.nk = it_u.kb + it_u.nk - KSPLIT; u.kb = KSPLIT; u.flags = 8 | (it_u.flags & 2); it_second = 0; return true; } }
        if (!base(it_i, u)) return false; ++it_i;
        if constexpr (KSPLIT > 0) {
            if (u.kb < KSPLIT && u.kb + u.nk > KSPLIT) { it_u = u; it_second = 1; u.nk = KSPLIT - u.kb; u.flags = (u.flags & 1) | 4; }
            else if (u.kb + u.nk == KSPLIT) u.flags |= 16;
        }
        return true;
    }
};

typedef __bf16 bf16x2_t __attribute__((ext_vector_type(2)));
typedef float f32x2_t __attribute__((ext_vector_type(2)));
__device__ __forceinline__ unsigned cvt_pk_bf16(float lo, float hi) { const f32x2_t v = {lo, hi}; const bf16x2_t r = __builtin_convertvector(v, bf16x2_t); return __builtin_bit_cast(unsigned, r); }

template <class Epi, class Sched, int KPITCH  , int KWRAP  >
__device__ __forceinline__ void gemm_phase(PG8_LAS unsigned char* lds, const Gemm g, const Sched& S, const Epi& E, const SlotIO io, const int wid_in  ) {
    const int wid = opaque_s(wid_in), lane = lane_id(), tid = wid * 64 + lane, wr = wid >> 2, wc = wid & 3, fr = lane & 15, fq = lane >> 4;
    constexpr int K = KPITCH;
    unsigned voffA[2], voffB[2];
#pragma unroll
    for (int i = 0; i < 2; ++i) { int R, C; stage_rc(tid * 16 + i * 8192, R, C); const int Rb = (R & ~31) + perm32(R & 31);
        voffA[i] = (unsigned)(R * K + C) * 2u; voffB[i] = (unsigned)(Rb * K + C) * 2u; }
    const size_t kstep = (size_t)(BK * 2);
    const size_t hstep = (size_t)HALF * K * 2;
    const size_t tstep = 2 * hstep;
    const unsigned ldsw = (unsigned)wid * 1024u;
    const int aoff = lds_byte(wr * 64 + fr, fq * 8), boff = lds_byte(wc * 32 + fr, fq * 8);
#define PG8_SA(b, h) (((b) * 2 + (h)) * HTB)
#define PG8_SB(b, h) ((4 + (b) * 2 + (h)) * HTB)
#define PG8_STAGE(bufoff, gbase, voff) do { _Pragma("unroll") for (int _i = 0; _i < 2; ++_i) \
        __builtin_amdgcn_global_load_lds((const unsigned*)((const char*)(gbase) + (voff)[_i]), (PG8_LAS unsigned*)(lds + (bufoff) + ldsw + _i * 8192), 16, 0, 0); } while (0)
#define PG8_LDA(dst, b, h) do { _Pragma("unroll") for (int m = 0; m < 4; ++m) _Pragma("unroll") for (int k = 0; k < 2; ++k) dst[m][k] = *(const PG8_LAS bf16x8*)(lds + PG8_SA(b, h) + aoff + m * 2048 + k * 1024); } while (0)
#define PG8_LDB(dst, b, h) do { _Pragma("unroll") for (int n = 0; n < 2; ++n) _Pragma("unroll") for (int k = 0; k < 2; ++k) dst[n][k] = *(const PG8_LAS bf16x8*)(lds + PG8_SB(b, h) + boff + n * 2048 + k * 1024); } while (0)
#define PG8_MMA(ai, bj, At, Bt) do { __builtin_amdgcn_s_setprio(1); _Pragma("unroll") for (int m = 0; m < 4; ++m) _Pragma("unroll") for (int n = 0; n < 2; ++n) _Pragma("unroll") for (int k = 0; k < 2; ++k) \
        acc[ai][bj][m][n] = __builtin_amdgcn_mfma_f32_16x16x32_bf16(Bt[n][k], At[m][k], acc[ai][bj][m][n], 0, 0, 0); __builtin_amdgcn_s_setprio(0); } while (0)
#define PG8_WAIT_V(n) asm volatile("s_waitcnt vmcnt(" #n ")" ::: "memory")
#define PG8_WAIT_L(n) asm volatile("s_waitcnt lgkmcnt(" #n ")" ::: "memory")
#define PG8_BAR __builtin_amdgcn_s_barrier()
#define PG8_SCHED __builtin_amdgcn_sched_barrier(0)
#define PG8_KA(u, T) ((const char*)(((T) < KWRAP) ? g.A : g.A2) + (size_t)(u).pm * tstep + (size_t)(((T) < KWRAP) ? (T) : (T) - KWRAP) * kstep)
#define PG8_KB(u, T) ((const char*)(((T) < KWRAP) ? g.Bt : g.Bt2) + (size_t)(u).pn * tstep + (size_t)(((T) < KWRAP) ? (T) : (T) - KWRAP) * kstep)
    Unit cur, nxt; int ui = 0;
    S.start();
    if (!S.advance(cur)) return;
    f32x4 acc[2][2][4][2];
    bf16x8 At[4][2], B0[2][2], B1[2][2];
    {   const char* cA = PG8_KA(cur, cur.kb); const char* cB = PG8_KB(cur, cur.kb);
        PG8_STAGE(PG8_SB(0, 0), cB, voffB); PG8_STAGE(PG8_SB(0, 1), cB + hstep, voffB); PG8_STAGE(PG8_SA(0, 0), cA, voffA); PG8_STAGE(PG8_SA(0, 1), cA + hstep, voffA);
        if (wr == 1) PG8_BAR;
        PG8_WAIT_V(2); PG8_BAR;
        PG8_STAGE(PG8_SB(1, 0), cB + kstep, voffB); PG8_STAGE(PG8_SA(1, 0), cA + kstep, voffA); PG8_STAGE(PG8_SB(1, 1), cB + hstep + kstep, voffB);
        PG8_WAIT_V(6); PG8_BAR; }
    for (;;) {
        const bool has_next = S.advance(nxt);
        if (!Sched::WHOLE && (cur.flags & 8)) {   }
        else if (!Sched::WHOLE && (cur.flags & 1)) {
            const __amdgpu_buffer_rsrc_t rs_in = __builtin_amdgcn_make_buffer_rsrc((void*)(io.slots + (size_t)(io.me - 1) * 131072), 0, 131072, 0x00020000);
            unsigned* fl = io.flags + (size_t)(io.me - 1) * 64; unsigned spins = 0;
            while ((unsigned)__builtin_amdgcn_readfirstlane(__hip_atomic_load(fl, __ATOMIC_RELAXED, __HIP_MEMORY_SCOPE_AGENT)) < 8u) { __builtin_amdgcn_s_sleep(2); if (++spins > (1u << 22)) break; }
            asm volatile("" ::: "memory");
#pragma unroll
            for (int q = 0; q < 16; ++q) { const u32x4 w = __builtin_amdgcn_raw_buffer_load_b128(rs_in, (q * 512 + tid) * 16, 0, 16);
                acc[q >> 3][(q >> 2) & 1][q & 3][0] = (f32x4){__builtin_bit_cast(float, w.x << 16), __builtin_bit_cast(float, w.x & 0xffff0000u), __builtin_bit_cast(float, w.y << 16), __builtin_bit_cast(float, w.y & 0xffff0000u)};
                acc[q >> 3][(q >> 2) & 1][q & 3][1] = (f32x4){__builtin_bit_cast(float, w.z << 16), __builtin_bit_cast(float, w.z & 0xffff0000u), __builtin_bit_cast(float, w.w << 16), __builtin_bit_cast(float, w.w & 0xffff0000u)}; }
        } else {
#pragma unroll
            for (int a = 0; a < 2; ++a)
#pragma unroll
                for (int b = 0; b < 2; ++b)
#pragma unroll
                    for (int m = 0; m < 4; ++m)
#pragma unroll
                        for (int n = 0; n < 2; ++n) acc[a][b][m][n] = (f32x4){0.f, 0.f, 0.f, 0.f};
        }
        const int nk = cur.nk, kb = cur.kb;
        for (int t = 0; t < nk; t += 2) {
            const bool last = (t == nk - 2); const int T = kb + t;
            const char* a1 = PG8_KA(cur, T) + kstep;
            const char* a2 = last ? (has_next ? PG8_KA(nxt, nxt.kb) : PG8_KA(cur, kb)) : PG8_KA(cur, T + 2);
            const char* b2 = last ? (has_next ? PG8_KB(nxt, nxt.kb) : PG8_KB(cur, kb)) : PG8_KB(cur, T + 2);
            const char* a3 = a2 + kstep; const char* b3 = b2 + kstep;
            PG8_LDB(B0, 0, 0); PG8_LDB(B1, 0, 1); PG8_SCHED; PG8_LDA(At, 0, 0); PG8_STAGE(PG8_SA(1, 1), a1 + hstep, voffA);
            PG8_WAIT_V(8); PG8_WAIT_L(0); PG8_BAR; PG8_MMA(0, 0, At, B0); PG8_MMA(0, 1, At, B1); PG8_BAR; PG8_SCHED;
            if constexpr (Epi::NEED_RSTD) { if (t == 0) { E.prefetch(cur, wid); PG8_SCHED; } }
            PG8_LDA(At, 0, 1); PG8_STAGE(PG8_SB(0, 0), b2, voffB); PG8_STAGE(PG8_SB(0, 1), b2 + hstep, voffB); PG8_STAGE(PG8_SA(0, 0), a2, voffA);
            PG8_WAIT_V(8); PG8_WAIT_L(0); PG8_BAR; PG8_MMA(1, 0, At, B0); PG8_MMA(1, 1, At, B1); PG8_BAR; PG8_SCHED;
            PG8_LDB(B0, 1, 0); PG8_LDB(B1, 1, 1); PG8_SCHED; PG8_LDA(At, 1, 0); PG8_STAGE(PG8_SA(0, 1), a2 + hstep, voffA);
            PG8_WAIT_V(8); PG8_WAIT_L(0); PG8_BAR; PG8_MMA(0, 0, At, B0); PG8_MMA(0, 1, At, B1); PG8_BAR; PG8_SCHED;
            PG8_LDA(At, 1, 1); PG8_STAGE(PG8_SB(1, 0), b3, voffB); PG8_STAGE(PG8_SB(1, 1), b3 + hstep, voffB); PG8_STAGE(PG8_SA(1, 0), a3, voffA);
            PG8_WAIT_V(8); PG8_WAIT_L(0); PG8_BAR; PG8_MMA(1, 0, At, B0); PG8_MMA(1, 1, At, B1); PG8_BAR; PG8_SCHED;
        }
        if (wr == 0) PG8_BAR;
        if constexpr (Epi::KSPLIT > 0) { if (cur.flags & (4 | 16)) E.mid(acc, cur, wr, wc, fr, fq); }
        if (!Sched::WHOLE && (cur.flags & 4)) {   }
        else if (!Sched::WHOLE && (cur.flags & 2)) {
            const __amdgpu_buffer_rsrc_t rs_out = __builtin_amdgcn_make_buffer_rsrc((void*)(io.slots + (size_t)io.me * 131072), 0, 131072, 0x00020000);
#pragma unroll
            for (int q = 0; q < 16; ++q) { const f32x4 v0 = acc[q >> 3][(q >> 2) & 1][q & 3][0], v1 = acc[q >> 3][(q >> 2) & 1][q & 3][1];
                u32x4 w; w.x = cvt_pk_bf16(v0[0], v0[1]); w.y = cvt_pk_bf16(v0[2], v0[3]); w.z = cvt_pk_bf16(v1[0], v1[1]); w.w = cvt_pk_bf16(v1[2], v1[3]);
                if (io.same_next) __builtin_amdgcn_raw_buffer_store_b128(w, rs_out, (q * 512 + tid) * 16, 0, 0);
                else __builtin_amdgcn_raw_buffer_store_b128(w, rs_out, (q * 512 + tid) * 16, 0, 16); }
            asm volatile("s_waitcnt vmcnt(0)" ::: "memory");
            if (lane == 0) __hip_atomic_fetch_add(io.flags + (size_t)io.me * 64, 1u, __ATOMIC_RELAXED, __HIP_MEMORY_SCOPE_AGENT);
        } else E(acc, cur, wr, wc, fr, fq);
        if (!has_next) break;
        cur = nxt; ++ui;
        if (wr == 1) PG8_BAR;
    }
    PG8_WAIT_V(0);
    PG8_BAR;
#undef PG8_SA
#undef PG8_SB
#undef PG8_STAGE
#undef PG8_LDA
#undef PG8_LDB
#undef PG8_MMA
#undef PG8_WAIT_V
#undef PG8_WAIT_L
#undef PG8_BAR
#undef PG8_SCHED
#undef PG8_KA
#undef PG8_KB
}
}

using pg8::bf16_t; using pg8::f32x4; using pg8::u32x4; using pg8::Unit; using pg8::cvt_pk_bf16;
__device__ __forceinline__ unsigned cvt_pk_bf16_pin(float lo, float hi) { unsigned r; asm volatile("v_cvt_pk_bf16_f32 %0, %1, %2" : "=v"(r) : "v"(lo), "v"(hi)); return r; }
#define GAS __attribute__((address_space(1)))
#define LAS __attribute__((address_space(3)))
typedef unsigned u32x2 __attribute__((ext_vector_type(2)));
typedef float f32x2 __attribute__((ext_vector_type(2)));
#define LDS_WAIT() asm volatile("s_waitcnt lgkmcnt(0)" ::: "memory")
#define VM_WAIT() asm volatile("s_waitcnt vmcnt(0)" ::: "memory")

__device__ __forceinline__ float bf_lo(unsigned w) { return __builtin_bit_cast(float, w << 16); }
__device__ __forceinline__ float bf_hi(unsigned w) { return __builtin_bit_cast(float, w & 0xffff0000u); }
__device__ __forceinline__ float sigmoid_fast(float x) { return __builtin_amdgcn_rcpf(1.0f + __builtin_amdgcn_exp2f(-1.4426950408889634f * x)); }
template <int M> __device__ __forceinline__ float swz_xor(float v) { return __builtin_bit_cast(float, __builtin_amdgcn_ds_swizzle(__builtin_bit_cast(int, v), 0x1f | (M << 10))); }
__device__ __forceinline__ float sum_xor32(float v) { const unsigned b = __builtin_bit_cast(unsigned, v); auto r = __builtin_amdgcn_permlane32_swap(b, b, false, false); return __builtin_bit_cast(float, (unsigned)r[0]) + __builtin_bit_cast(float, (unsigned)r[1]); }
__device__ __forceinline__ float sum_fq(float v) { v += swz_xor<16>(v); return sum_xor32(v); }
__device__ __forceinline__ float wave_sum(float v) { v += swz_xor<1>(v); v += swz_xor<2>(v); v += swz_xor<4>(v); v += swz_xor<8>(v); v += swz_xor<16>(v); return sum_xor32(v); }

__device__ __forceinline__ float sum2_swap32(float a, float b) { auto r = __builtin_amdgcn_permlane32_swap(__builtin_bit_cast(unsigned, a), __builtin_bit_cast(unsigned, b), false, false); return __builtin_bit_cast(float, (unsigned)r[0]) + __builtin_bit_cast(float, (unsigned)r[1]); }
__device__ __forceinline__ float sum2_swap16(float a, float b) { auto r = __builtin_amdgcn_permlane16_swap(__builtin_bit_cast(unsigned, a), __builtin_bit_cast(unsigned, b), false, false); return __builtin_bit_cast(float, (unsigned)r[0]) + __builtin_bit_cast(float, (unsigned)r[1]); }
__device__ __forceinline__ float reduce48(const float (&v)[48], int lane) {
    float w[32];
#pragma unroll
    for (int i = 0; i < 32; ++i) w[i] = sum2_swap32(v[i], i + 32 < 48 ? v[i + 32] : 0.f);
    float x[16];
#pragma unroll
    for (int i = 0; i < 16; ++i) x[i] = sum2_swap16(w[i], w[i + 16]);
    float y[8]; const bool b8 = (lane & 8) != 0;
#pragma unroll
    for (int i = 0; i < 8; ++i) { const float keep = b8 ? x[i + 8] : x[i], send = b8 ? x[i] : x[i + 8]; y[i] = keep + swz_xor<8>(send); }
    float z[4]; const bool b4 = (lane & 4) != 0;
#pragma unroll
    for (int i = 0; i < 4; ++i) { const float keep = b4 ? y[i + 4] : y[i], send = b4 ? y[i] : y[i + 4]; z[i] = keep + swz_xor<4>(send); }
    float q[2]; const bool b2 = (lane & 2) != 0;
#pragma unroll
    for (int i = 0; i < 2; ++i) { const float keep = b2 ? z[i + 2] : z[i], send = b2 ? z[i] : z[i + 2]; q[i] = keep + swz_xor<2>(send); }
    const bool b1 = (lane & 1) != 0; const float keep = b1 ? q[1] : q[0], send = b1 ? q[0] : q[1];
    return keep + swz_xor<1>(send);
}

constexpr size_t MiB = 1u << 20;
constexpr size_t ACT_BYTES = (size_t)MPAD * D * 2;
constexpr size_t WS_CTL = 0, CTL_ZERO_BYTES = 1 * MiB;
constexpr size_t WS_XCCTAB = 32 * 1024;
constexpr size_t WS_SKFLAG = 64 * 1024;
static_assert(WS_SKFLAG + (size_t)10 * 256 * 256 <= CTL_ZERO_BYTES, "ctl map");
constexpr size_t SSQ_ONE = (size_t)16 * MPAD * 4;
constexpr size_t WS_SSQ = 1 * MiB;
constexpr size_t WS_HALOA = WS_SSQ + 5 * SSQ_ONE;
constexpr size_t WS_HALOB = WS_HALOA + (size_t)2 * NSTREAM * 30 * D * 2;
constexpr size_t WS_W0 = 10 * MiB;
constexpr size_t W_IN_B = (size_t)NIN * D * 2, W_AB_B = (size_t)2 * D * D * 2, W_O_B = (size_t)D * D * 2, W_GU_B = (size_t)NGU * D * 2, W_D_B = (size_t)D * DH * 2;
constexpr size_t WS_W0_IN = WS_W0, WS_W0_AB = WS_W0_IN + W_IN_B, WS_W0_O = WS_W0_AB + W_AB_B, WS_W0_GU = WS_W0_O + W_O_B, WS_W0_D = WS_W0_GU + W_GU_B, WS_W0_END = WS_W0_D + W_D_B;
constexpr size_t WS_W1_AB = WS_W0_END, WS_W1_O = WS_W1_AB + W_AB_B, WS_W1_END = WS_W1_O + W_O_B;
constexpr size_t WS_H = 53 * MiB;
constexpr size_t WS_UA = 86 * MiB, WS_ZB = WS_UA + ACT_BYTES, WS_BB = WS_ZB + ACT_BYTES, WS_SGA = WS_BB + ACT_BYTES, WS_SGB = WS_SGA + ACT_BYTES, WS_END = WS_SGB + ACT_BYTES;
constexpr size_t WS_F = WS_UA;
static_assert(WS_HALOB + (size_t)2 * NSTREAM * 2 * D * 2 <= WS_W0, "ws map: small buffers");
static_assert(WS_W1_END <= WS_H && WS_H + ACT_BYTES <= WS_UA && WS_END + SSQ_ONE <= 256 * MiB, "ws map (a dummy ssq set for timing probes sits at WS_END)");
static_assert(WS_F + (size_t)MPAD * DH * 2 <= WS_SGA, "F overlay");
constexpr size_t DO_CA = 0, DO_W1_IN = ACT_BYTES, DO_W1_GU = DO_W1_IN + W_IN_B, DO_W1_D = DO_W1_GU + W_GU_B, DO_END = DO_W1_D + W_D_B;
static_assert(DO_END <= (size_t)NPROMPT * 2048 * D * 4, "d_out scratch must stay inside the y_prompt region");
constexpr size_t OUT_YP = 0, OUT_YS = OUT_YP + (size_t)NPROMPT * 2048 * D, OUT_NAP = OUT_YS + (size_t)NSAMP * TS * D, OUT_NBP = OUT_NAP + (size_t)2 * NPROMPT * 30 * D,
                 OUT_NAS = OUT_NBP + (size_t)2 * NPROMPT * 2 * D, OUT_NBS = OUT_NAS + (size_t)2 * NSAMP * 30 * D, OUT_TOTAL = OUT_NBS + (size_t)2 * NSAMP * 2 * D;

constexpr int RING_BYTES = 131072, RSTD_OFF = RING_BYTES, RSTD_PITCH = 1040  , LDSCTL_OFF = RSTD_OFF + 16 * RSTD_PITCH, LDS_BYTES = 149504;

#define XB_TMO      128
#define XB_XCNT(j)  (256  + 64 * (j))
#define XB_XSUB(j)  (1280 + 64 * (j))
#define XB_XGEN(j)  (2304 + 64 * (j))
#define XB_TOP      3328
#define XB_TOPGEN   3392
#define XCD_BAR_WORDS 3456
#define XB_SPIN_CAP (1u << 18)
__device__ __forceinline__ unsigned xb_ld(unsigned* p)              { return __hip_atomic_load(p, __ATOMIC_RELAXED, __HIP_MEMORY_SCOPE_AGENT); }
__device__ __forceinline__ unsigned xb_add(unsigned* p, unsigned v) { return __hip_atomic_fetch_add(p, v, __ATOMIC_RELAXED, __HIP_MEMORY_SCOPE_AGENT); }
__device__ __forceinline__ unsigned xb_xcc_id() { return (unsigned)__builtin_amdgcn_s_getreg((3 << 11) | 20) & 0xFu; }
#define XB_SPIN(cond, bar) do { unsigned _sp = 0; while (cond) { __builtin_amdgcn_s_sleep(1); \
    if ((++_sp & 255u) == 0u) { if (xb_ld(&(bar)[XB_TMO])) break; if (_sp > XB_SPIN_CAP) { atomicAdd(&(bar)[XB_TMO], 1u); break; } } } } while (0)
struct XcdBarrier { unsigned* bar; unsigned x; volatile LAS unsigned* st; };
__device__ __forceinline__ XcdBarrier xcd_barrier_post(unsigned* bar, volatile LAS unsigned* st) {
    XcdBarrier b; b.bar = bar; b.x = xb_xcc_id(); b.st = st;
    if (threadIdx.x == 0) { const unsigned old = xb_add(&bar[XB_XCNT(b.x)], 1u); st[2] = (old == 0u) ? 1u : 0u; }
    return b;
}
__device__ __forceinline__ void xcd_barrier_complete(unsigned* bar, unsigned x, unsigned& nloc, unsigned& nx) {
    const unsigned G = gridDim.x * gridDim.y * gridDim.z;
    unsigned sum, cnt, mine, sp = 0u;
    for (;;) {
        sum = 0u; cnt = 0u; mine = 0u;
#pragma unroll
        for (unsigned j = 0; j < 16; ++j) { const unsigned c = xb_ld(&bar[XB_XCNT(j)]); sum += c; cnt += (c > 0u) ? 1u : 0u; mine = (j == x) ? c : mine; }
        if (sum == G) break;
        __builtin_amdgcn_s_sleep(1);
        if ((++sp & 255u) == 0u) { if (xb_ld(&bar[XB_TMO])) break; if (sp > XB_SPIN_CAP) { atomicAdd(&bar[XB_TMO], 1u); break; } }
    }
    nloc = mine > 0u ? mine : 1u; nx = cnt > 0u ? cnt : 1u;
}
__device__ __forceinline__ void xcd_barrier(const XcdBarrier& b, const int wave) {
    asm volatile("s_waitcnt vmcnt(0)" ::: "memory");
    __syncthreads();
    if (wave == 0 && lane_id() == 0) {
        unsigned* bar = b.bar;
        __builtin_amdgcn_s_waitcnt(0);
        unsigned nloc = b.st[0], nx = b.st[1];
        if (nloc == 0u) { xcd_barrier_complete(bar, b.x, nloc, nx); b.st[0] = nloc; b.st[1] = nx; }
        const unsigned k = b.st[3] + 1u; b.st[3] = k;
        __builtin_amdgcn_fence(__ATOMIC_ACQUIRE, "agent");
        asm volatile("s_waitcnt vmcnt(0)" ::: "memory");
        if (b.st[2] == 0u) {
            (void)__hip_atomic_fetch_add(&bar[XB_XSUB(b.x)], 1u, __ATOMIC_RELAXED, __HIP_MEMORY_SCOPE_AGENT);
        } else {
            const unsigned want = (nloc - 1u) * k;
            XB_SPIN(xb_ld(&bar[XB_XSUB(b.x)]) < want, bar);
            __builtin_amdgcn_fence(__ATOMIC_RELEASE, "agent");
            asm volatile("s_waitcnt vmcnt(0)" ::: "memory");
            (void)__hip_atomic_fetch_add(&bar[XB_TOP], 1u, __ATOMIC_RELAXED, __HIP_MEMORY_SCOPE_AGENT);
        }
        const unsigned want_top = nx * k;
        XB_SPIN(xb_ld(&bar[XB_TOP]) < want_top, bar);
        asm volatile("s_waitcnt vmcnt(0)" ::: "memory");
    }
    __syncthreads();
}


__device__ __forceinline__ void sigmoid8(const float (&x)[8], float (&s)[8]) {
    float e[8];
#pragma unroll
    for (int k = 0; k < 8; ++k) e[k] = __builtin_amdgcn_exp2f(-1.4426950408889634f * x[k]);
#pragma unroll
    for (int k = 0; k < 8; ++k) e[k] = 1.0f + e[k];
#pragma unroll
    for (int k = 0; k < 8; ++k) s[k] = __builtin_amdgcn_rcpf(e[k]);
}
__device__ __forceinline__ void load_rstd(const LAS unsigned char* rl, int wr, int fr, int fq, float (&rs)[2][4]) {
    const LAS float* p = (const LAS float*)(rl + fq * 4 * RSTD_PITCH) + wr * 64 + fr;
#pragma unroll
    for (int ai = 0; ai < 2; ++ai)
#pragma unroll
        for (int m = 0; m < 4; ++m) {
            float s = 0.f;
#pragma unroll
            for (int j = 0; j < 4; ++j) s += p[j * (RSTD_PITCH / 4) + ai * 128 + m * 16];
            s = sum_fq(s);
            rs[ai][m] = 1.0f / sqrtf(s * (1.0f / D) + RMS_EPS);
        }
}
struct RstdPrefetch {
    static constexpr bool NEED_RSTD = true;
    const float* ssq; LAS unsigned char* rl;
    __device__ __forceinline__ void prefetch(const Unit& u, int wid) const {
        const unsigned lo = (unsigned)lane_id() * 16u;
#pragma unroll
        for (int i = 0; i < 2; ++i) { const int j = wid * 2 + i;
            __builtin_amdgcn_global_load_lds((const unsigned*)((const char*)ssq + ((size_t)j * MPAD + (size_t)u.pm * 256) * 4 + lo), (LAS unsigned*)(rl + j * RSTD_PITCH), 16, 0, 0); }
    }
};
struct Epi1 : RstdPrefetch {
    static constexpr int KSPLIT = 0;
    bf16_t* ACT5;
    __device__ __forceinline__ void operator()(const f32x4 (&acc)[2][2][4][2], const Unit& u, int wr, int wc, int fr, int fq) const {
        asm volatile("" : "+v"(fr), "+v"(fq));
        const int row0 = u.pm * 256 + wr * 64 + fr;
        float rs[2][4]; load_rstd(rl, wr, fr, fq, rs);
        const int pn = u.pn;
        if (pn < 16) {
            bf16_t* O = ACT5 + (size_t)(pn >> 3) * ((size_t)MPAD * D) + (pn & 7) * 128 + wc * 32 + 8 * fq;
            if (pn < 8) {
#pragma unroll
                for (int ai = 0; ai < 2; ++ai)
#pragma unroll
                    for (int m = 0; m < 4; ++m) { const float r = rs[ai][m]; float o[8];
                        float gb[8], sg[8];
#pragma unroll
                        for (int n = 0; n < 2; ++n)
#pragma unroll
                            for (int j = 0; j < 4; ++j) gb[n * 4 + j] = acc[ai][1][m][n][j] * r;
                        sigmoid8(gb, sg);
#pragma unroll
                        for (int n = 0; n < 2; ++n)
#pragma unroll
                            for (int j = 0; j < 4; ++j) o[n * 4 + j] = acc[ai][0][m][n][j] * r * sg[n * 4 + j];
                        u32x4 w; w.x = cvt_pk_bf16(o[0], o[1]); w.y = cvt_pk_bf16(o[2], o[3]); w.z = cvt_pk_bf16(o[4], o[5]); w.w = cvt_pk_bf16(o[6], o[7]);
                        *(u32x4*)(O + (size_t)(row0 + ai * 128 + m * 16) * D) = w; }
            } else {
#pragma unroll
                for (int ai = 0; ai < 2; ++ai)
#pragma unroll
                    for (int m = 0; m < 4; ++m) { const float r2 = rs[ai][m] * rs[ai][m]; float o[8];
#pragma unroll
                        for (int n = 0; n < 2; ++n)
#pragma unroll
                            for (int j = 0; j < 4; ++j) o[n * 4 + j] = acc[ai][0][m][n][j] * acc[ai][1][m][n][j] * r2;
                        u32x4 w; w.x = cvt_pk_bf16(o[0], o[1]); w.y = cvt_pk_bf16(o[2], o[3]); w.z = cvt_pk_bf16(o[4], o[5]); w.w = cvt_pk_bf16(o[6], o[7]);
                        *(u32x4*)(O + (size_t)(row0 + ai * 128 + m * 16) * D) = w; }
            }
        } else if (pn < 20) {
            bf16_t* O = ACT5 + (size_t)2 * ((size_t)MPAD * D) + (pn - 16) * 256 + wc * 32 + 8 * fq;
#pragma unroll
            for (int ai = 0; ai < 2; ++ai)
#pragma unroll
                for (int m = 0; m < 4; ++m) { const float r = rs[ai][m];
#pragma unroll
                    for (int bj = 0; bj < 2; ++bj) { float o[8];
#pragma unroll
                        for (int n = 0; n < 2; ++n)
#pragma unroll
                            for (int j = 0; j < 4; ++j) o[n * 4 + j] = acc[ai][bj][m][n][j] * r;
                        u32x4 w; w.x = cvt_pk_bf16(o[0], o[1]); w.y = cvt_pk_bf16(o[2], o[3]); w.z = cvt_pk_bf16(o[4], o[5]); w.w = cvt_pk_bf16(o[6], o[7]);
                        *(u32x4*)(O + (size_t)(row0 + ai * 128 + m * 16) * D + bj * 128) = w; } }
        } else {
            bf16_t* O = ACT5 + (size_t)3 * ((size_t)MPAD * D) + (pn - 20) * 128 + wc * 32 + 8 * fq;
#pragma unroll
            for (int ai = 0; ai < 2; ++ai)
#pragma unroll
                for (int m = 0; m < 4; ++m) { const float r = rs[ai][m]; float o[8], s[8];
                    float ga[8], sa[8], eb[8];
#pragma unroll
                    for (int n = 0; n < 2; ++n)
#pragma unroll
                        for (int j = 0; j < 4; ++j) { ga[n * 4 + j] = acc[ai][0][m][n][j] * r; eb[n * 4 + j] = __builtin_amdgcn_exp2f(-1.4426950408889634f * (acc[ai][1][m][n][j] * r)); }
                    sigmoid8(ga, sa);
#pragma unroll
                    for (int k = 0; k < 8; ++k) eb[k] = 1.0f + fminf(eb[k], 1e30f);
#pragma unroll
                    for (int k = 0; k < 8; ++k) { o[k] = sa[k] * eb[k]; s[k] = __builtin_amdgcn_rcpf(eb[k]); }
                    u32x4 w; w.x = cvt_pk_bf16(o[0], o[1]); w.y = cvt_pk_bf16(o[2], o[3]); w.z = cvt_pk_bf16(o[4], o[5]); w.w = cvt_pk_bf16(o[6], o[7]);
                    *(u32x4*)(O + (size_t)(row0 + ai * 128 + m * 16) * D) = w;
                    w.x = cvt_pk_bf16(s[0], s[1]); w.y = cvt_pk_bf16(s[2], s[3]); w.z = cvt_pk_bf16(s[4], s[5]); w.w = cvt_pk_bf16(s[6], s[7]);
                    *(u32x4*)(O + (size_t)MPAD * D + (size_t)(row0 + ai * 128 + m * 16) * D) = w; }
        }
    }
};
struct Epi2 {
    static constexpr int KSPLIT = 16; static constexpr bool NEED_RSTD = false;
    bf16_t* RT; const bf16_t* SGB; bf16_t* OUT;
    __device__ __forceinline__ void mid(f32x4 (&acc)[2][2][4][2], const Unit& u, int wr, int wc, int fr, int fq) const {
        const int row0 = u.pm * 256 + wr * 64 + fr; const size_t col0 = (size_t)u.pn * 256 + wc * 32 + 8 * fq;
#pragma unroll
        for (int ai = 0; ai < 2; ++ai)
#pragma unroll
            for (int m = 0; m < 4; ++m)
#pragma unroll
                for (int bj = 0; bj < 2; ++bj) { const u32x4 t = *(const u32x4*)(RT + (size_t)(row0 + ai * 128 + m * 16) * D + col0 + bj * 128);
#pragma unroll
                    for (int q = 0; q < 4; ++q) { acc[ai][bj][m][q >> 1][(2 * q) & 3] *= bf_lo(t[q]); acc[ai][bj][m][q >> 1][(2 * q + 1) & 3] *= bf_hi(t[q]); } }
    }
    __device__ __forceinline__ void operator()(const f32x4 (&acc)[2][2][4][2], const Unit& u, int wr, int wc, int fr, int fq) const {
        const int row0 = u.pm * 256 + wr * 64 + fr; const size_t col0 = (size_t)u.pn * 256 + wc * 32 + 8 * fq;
#pragma unroll
        for (int ai = 0; ai < 2; ++ai)
#pragma unroll
            for (int m = 0; m < 4; ++m)
#pragma unroll
                for (int bj = 0; bj < 2; ++bj) { const size_t off = (size_t)(row0 + ai * 128 + m * 16) * D + col0 + bj * 128;
                    const u32x4 s = *(const u32x4*)(SGB + off); float o[8];
#pragma unroll
                    for (int q = 0; q < 4; ++q) { o[2 * q] = bf_lo(s[q]) * acc[ai][bj][m][q >> 1][(2 * q) & 3]; o[2 * q + 1] = bf_hi(s[q]) * acc[ai][bj][m][q >> 1][(2 * q + 1) & 3]; }
                    u32x4 w; w.x = cvt_pk_bf16(o[0], o[1]); w.y = cvt_pk_bf16(o[2], o[3]); w.z = cvt_pk_bf16(o[4], o[5]); w.w = cvt_pk_bf16(o[6], o[7]);
                    *(u32x4*)(OUT + off) = w; }
    }
};
struct EpiRes {
    static constexpr int KSPLIT = 0; static constexpr bool NEED_RSTD = false;
    bf16_t* H; float* ssq_out; bf16_t* OUT;
    __device__ __forceinline__ void operator()(const f32x4 (&acc)[2][2][4][2], const Unit& u, int wr, int wc, int fr, int fq) const {
        const int row0 = u.pm * 256 + wr * 64 + fr; const size_t col0 = (size_t)u.pn * 256 + wc * 32 + 8 * fq;
#pragma unroll
        for (int ai = 0; ai < 2; ++ai)
#pragma unroll
            for (int m = 0; m < 4; ++m) { const int row = row0 + ai * 128 + m * 16; float sq = 0.f;
#pragma unroll
                for (int bj = 0; bj < 2; ++bj) { const size_t off = (size_t)row * D + col0 + bj * 128;
                    const u32x4 t = *(const u32x4*)(H + off); float o[8];
#pragma unroll
                    for (int q = 0; q < 4; ++q) { o[2 * q] = bf_lo(t[q]) + acc[ai][bj][m][q >> 1][(2 * q) & 3]; o[2 * q + 1] = bf_hi(t[q]) + acc[ai][bj][m][q >> 1][(2 * q + 1) & 3]; }
#pragma unroll
                    for (int q = 0; q < 8; ++q) sq += o[q] * o[q];
                    u32x4 w; w.x = cvt_pk_bf16(o[0], o[1]); w.y = cvt_pk_bf16(o[2], o[3]); w.z = cvt_pk_bf16(o[4], o[5]); w.w = cvt_pk_bf16(o[6], o[7]);
                    *(u32x4*)(OUT + off) = w; }
                sq = sum_fq(sq);
                if (fq == 0) ssq_out[(size_t)(u.pn * 4 + wc) * MPAD + row] = sq; }
    }
};
struct Epi4 : RstdPrefetch {
    static constexpr int KSPLIT = 0;
    bf16_t* F;
    __device__ __forceinline__ void operator()(const f32x4 (&acc)[2][2][4][2], const Unit& u, int wr, int wc, int fr, int fq) const {
        asm volatile("" : "+v"(fr), "+v"(fq));
        const int row0 = u.pm * 256 + wr * 64 + fr;
        float rs[2][4]; load_rstd(rl, wr, fr, fq, rs);
        bf16_t* O = F + u.pn * 128 + wc * 32 + 8 * fq;
#pragma unroll
        for (int ai = 0; ai < 2; ++ai)
#pragma unroll
            for (int m = 0; m < 4; ++m) {
                const float r = rs[ai][m], rn = r * -1.4426950408889634f, r2 = r * r;
                f32x2 e[4], p[4];
#pragma unroll
                for (int q = 0; q < 4; ++q) { const f32x2 g = {acc[ai][0][m][q >> 1][(2 * q) & 3], acc[ai][0][m][q >> 1][(2 * q + 1) & 3]}, up = {acc[ai][1][m][q >> 1][(2 * q) & 3], acc[ai][1][m][q >> 1][(2 * q + 1) & 3]};
                    const f32x2 t = g * rn; e[q] = (f32x2){__builtin_amdgcn_exp2f(t.x), __builtin_amdgcn_exp2f(t.y)}; p[q] = (g * up) * r2; }
                unsigned wq[4];
#pragma unroll
                for (int q = 0; q < 4; ++q) { const f32x2 d = e[q] + 1.0f; const f32x2 s = {__builtin_amdgcn_rcpf(d.x), __builtin_amdgcn_rcpf(d.y)}; const f32x2 o = p[q] * s; wq[q] = cvt_pk_bf16(o.x, o.y); }
                u32x4 w; w.x = wq[0]; w.y = wq[1]; w.z = wq[2]; w.w = wq[3];
                *(u32x4*)(O + (size_t)(row0 + ai * 128 + m * 16) * DH) = w; }
    }
};

struct Args { const float* in[20]; float* out; unsigned char* ws; int ph_lo, ph_hi; };
#define KAS __attribute__((address_space(4)))
typedef const KAS Args* KArgs;
__device__ __forceinline__ KArgs fresh(KArgs p) { asm volatile("" : "+s"(p)); return p; }

__device__ __forceinline__ unsigned f2bf(float f) { unsigned u = __builtin_bit_cast(unsigned, f); return (u + 0x7fffu + ((u >> 16) & 1u)) >> 16; }
__device__ __forceinline__ unsigned pk2(float lo, float hi) { return pg8::cvt_pk_bf16(lo, hi); }
constexpr int P0_SCR = 64 * 65 * 4;
struct WItem { const float* W; int K, N; bf16_t* WT; int dest_row0; const float* gk; int kb, nb; };
template <bool NT = false> __device__ __forceinline__ void p0_item_load(const WItem& d, int lane, f32x4 (&v)[16]) {
    const float* src = d.W + (size_t)(64 * d.kb + (lane >> 4)) * d.N + 64 * d.nb + 4 * (lane & 15);
#pragma unroll
    for (int i = 0; i < 16; ++i) { if constexpr (NT) v[i] = __builtin_nontemporal_load((const f32x4*)(src + (size_t)(4 * i) * d.N)); else v[i] = *(const f32x4*)(src + (size_t)(4 * i) * d.N); }
}
template <bool NT = false> __device__ __forceinline__ void p0_item_finish(const WItem& d, LAS float* scr, int lane, const f32x4 (&v)[16]) {
    const int k0 = 64 * d.kb, K = d.K;
    const int c = lane & 7;
    f32x4 g0 = (f32x4){1.f, 1.f, 1.f, 1.f}, g1 = g0;
    if (d.gk) { g0 = *(const f32x4*)(d.gk + k0 + 8 * c); g1 = *(const f32x4*)(d.gk + k0 + 8 * c + 4); }
#pragma unroll
    for (int i = 0; i < 16; ++i) { LAS float* q = scr + (4 * i + (lane >> 4)) * 65 + 4 * (lane & 15); q[0] = v[i][0]; q[1] = v[i][1]; q[2] = v[i][2]; q[3] = v[i][3]; }
    LDS_WAIT(); asm volatile("" ::: "memory");
#pragma unroll
    for (int j = 0; j < 8; ++j) { const int n = (lane >> 3) + 8 * j; const LAS float* s = scr + (8 * c) * 65 + n;
        u32x4 o; o.x = pk2(s[0 * 65] * g0[0], s[1 * 65] * g0[1]); o.y = pk2(s[2 * 65] * g0[2], s[3 * 65] * g0[3]); o.z = pk2(s[4 * 65] * g1[0], s[5 * 65] * g1[1]); o.w = pk2(s[6 * 65] * g1[2], s[7 * 65] * g1[3]);
        if constexpr (NT) __builtin_nontemporal_store(o, (u32x4*)(d.WT + (size_t)(d.dest_row0 + n) * K + k0 + 8 * c)); else *(u32x4*)(d.WT + (size_t)(d.dest_row0 + n) * K + k0 + 8 * c) = o; }
    LDS_WAIT(); asm volatile("" ::: "memory");
}
__device__ __forceinline__ void p0_transpose_item(const float* W, int K, int N, bf16_t* WT, int dest_row0, const float* gk, LAS float* scr, int kb, int nb, int lane) {
    const WItem d{W, K, N, WT, dest_row0, gk, kb, nb}; f32x4 v[16]; p0_item_load<true>(d, lane, v); p0_item_finish(d, scr, lane, v);
}
__device__ __forceinline__ int win_map(int n0) {
    const int seg = n0 >> 10, off = n0 & 1023, p = off >> 7, j = off & 127;
    switch (seg) { case 0: return 256 * p + j; case 1: return 256 * p + 128 + j; case 2: return 4096 + off; case 3: return 2048 + 256 * p + j; case 4: return 2048 + 256 * p + 128 + j; case 5: return 5120 + 256 * p + j; default: return 5120 + 256 * p + 128 + j; }
}
constexpr int I_IN = (D / 64) * (NIN / 64), I_SQ = (D / 64) * (D / 64), I_GU = (D / 64) * (DH / 64), I_DN = (DH / 64) * (D / 64), I_LAYER = I_IN + 3 * I_SQ + 2 * I_GU + I_DN;
__device__ __forceinline__ void p0_weight_item(KArgs ap, int l, int r, LAS float* scr, int lane) {
    struct { const float* in[20]; float* out; unsigned char* ws; } a; a.ws = ap->ws; a.out = ap->out;
#pragma unroll
    for (int i = 0; i < 19; ++i) a.in[i] = ap->in[i];
    unsigned char* ws = a.ws; unsigned char* dob = (unsigned char*)a.out;
    bf16_t* w_in_t = (bf16_t*)(l ? dob + DO_W1_IN : ws + WS_W0_IN); bf16_t* w_ab_t = (bf16_t*)(ws + (l ? WS_W1_AB : WS_W0_AB)); bf16_t* w_o_t = (bf16_t*)(ws + (l ? WS_W1_O : WS_W0_O));
    bf16_t* w_gu_t = (bf16_t*)(l ? dob + DO_W1_GU : ws + WS_W0_GU); bf16_t* w_d_t = (bf16_t*)(l ? dob + DO_W1_D : ws + WS_W0_D);
    if (r < I_IN) { const int nblk = NIN / 64, kb = r / nblk, nb = r % nblk; p0_transpose_item(a.in[6] + (size_t)l * D * NIN, D, NIN, w_in_t, win_map(64 * nb), a.in[5] + l * D, scr, kb, nb, lane); return; } r -= I_IN;
    if (r < I_SQ) { const int nblk = D / 64, kb = r / nblk, nb = r % nblk; p0_transpose_item(a.in[11] + (size_t)l * D * D, D, D, w_ab_t, 64 * nb, nullptr, scr, kb, nb, lane); return; } r -= I_SQ;
    if (r < I_SQ) { const int nblk = D / 64, kb = r / nblk, nb = r % nblk; p0_transpose_item(a.in[13] + (size_t)l * D * D, D, D, w_ab_t, D + 64 * nb, nullptr, scr, kb, nb, lane); return; } r -= I_SQ;
    if (r < I_SQ) { const int nblk = D / 64, kb = r / nblk, nb = r % nblk; p0_transpose_item(a.in[14] + (size_t)l * D * D, D, D, w_o_t, 64 * nb, nullptr, scr, kb, nb, lane); return; } r -= I_SQ;
    if (r < I_GU) { const int nblk = DH / 64, kb = r / nblk, nb = r % nblk, n0 = 64 * nb; p0_transpose_item(a.in[16] + (size_t)l * D * DH, D, DH, w_gu_t, 256 * (n0 >> 7) + (n0 & 127), a.in[15] + l * D, scr, kb, nb, lane); return; } r -= I_GU;
    if (r < I_GU) { const int nblk = DH / 64, kb = r / nblk, nb = r % nblk, n0 = 64 * nb; p0_transpose_item(a.in[17] + (size_t)l * D * DH, D, DH, w_gu_t, 256 * (n0 >> 7) + 128 + (n0 & 127), a.in[15] + l * D, scr, kb, nb, lane); return; } r -= I_GU;
    { const int nblk = D / 64, kb = r / nblk, nb = r % nblk; p0_transpose_item(a.in[18] + (size_t)l * DH * D, DH, D, w_d_t, 64 * nb, nullptr, scr, kb, nb, lane); }
}
__device__ __forceinline__ WItem p0_weight_desc(KArgs ap, int l, int r) {
    struct { const float* in[20]; float* out; unsigned char* ws; } a; a.ws = ap->ws; a.out = ap->out;
#pragma unroll
    for (int i = 0; i < 19; ++i) a.in[i] = ap->in[i];
    unsigned char* ws = a.ws; unsigned char* dob = (unsigned char*)a.out;
    bf16_t* w_in_t = (bf16_t*)(l ? dob + DO_W1_IN : ws + WS_W0_IN); bf16_t* w_ab_t = (bf16_t*)(ws + (l ? WS_W1_AB : WS_W0_AB)); bf16_t* w_o_t = (bf16_t*)(ws + (l ? WS_W1_O : WS_W0_O));
    bf16_t* w_gu_t = (bf16_t*)(l ? dob + DO_W1_GU : ws + WS_W0_GU); bf16_t* w_d_t = (bf16_t*)(l ? dob + DO_W1_D : ws + WS_W0_D);
    if (r < I_IN) { const int nblk = NIN / 64, kb = r / nblk, nb = r % nblk; return WItem{a.in[6] + (size_t)l * D * NIN, D, NIN, w_in_t, win_map(64 * nb), a.in[5] + l * D, kb, nb}; } r -= I_IN;
    if (r < I_SQ) { const int nblk = D / 64, kb = r / nblk, nb = r % nblk; return WItem{a.in[11] + (size_t)l * D * D, D, D, w_ab_t, 64 * nb, nullptr, kb, nb}; } r -= I_SQ;
    if (r < I_SQ) { const int nblk = D / 64, kb = r / nblk, nb = r % nblk; return WItem{a.in[13] + (size_t)l * D * D, D, D, w_ab_t, D + 64 * nb, nullptr, kb, nb}; } r -= I_SQ;
    if (r < I_SQ) { const int nblk = D / 64, kb = r / nblk, nb = r % nblk; return WItem{a.in[14] + (size_t)l * D * D, D, D, w_o_t, 64 * nb, nullptr, kb, nb}; } r -= I_SQ;
    if (r < I_GU) { const int nblk = DH / 64, kb = r / nblk, nb = r % nblk, n0 = 64 * nb; return WItem{a.in[16] + (size_t)l * D * DH, D, DH, w_gu_t, 256 * (n0 >> 7) + (n0 & 127), a.in[15] + l * D, kb, nb}; } r -= I_GU;
    if (r < I_GU) { const int nblk = DH / 64, kb = r / nblk, nb = r % nblk, n0 = 64 * nb; return WItem{a.in[17] + (size_t)l * D * DH, D, DH, w_gu_t, 256 * (n0 >> 7) + 128 + (n0 & 127), a.in[15] + l * D, kb, nb}; } r -= I_GU;
    { const int nblk = D / 64, kb = r / nblk, nb = r % nblk; return WItem{a.in[18] + (size_t)l * DH * D, DH, D, w_d_t, 64 * nb, nullptr, kb, nb}; }
}
constexpr int NW_G1 = 231  , NW_G4 = 242  , N_HELPERS = 256 - NW_G1, BG_ITEMS = (I_LAYER - I_IN) + I_LAYER, BG_A = I_LAYER - I_IN, BG_B = BG_A + I_IN, BG_C = BG_ITEMS - I_DN;
struct WgRole { bool compute; int cc, h, vnext; };
__device__ __forceinline__ WgRole wg_role(int vcu, int NW) {
    const int idle = 256 - NW, base = idle >> 3, extra = idle & 7, xq = vcu >> 5, xr = vcu & 31, hx = base + (xq < extra ? 1 : 0), before = base * xq + (xq < extra ? xq : extra);
    WgRole r; r.compute = xr < 32 - hx; r.cc = vcu - before; r.h = before + (xr - (32 - hx)); r.vnext = (xr + 1 < 32 - hx) ? vcu + 1 : (xq + 1) * 32; return r;
}
__device__ __forceinline__ void p0_background(KArgs ap, LAS unsigned char* lds, int h, int nh, int lo, int hi, int wave, int lane) {
    LAS float* scr = (LAS float*)(lds + wave * P0_SCR);
    int it = lo + h * 8 + wave; if (it >= hi) return;
    WItem cur = (it < I_LAYER - I_IN) ? p0_weight_desc(ap, 0, I_IN + it) : p0_weight_desc(ap, 1, it - (I_LAYER - I_IN));
    f32x4 va[16]; p0_item_load<true>(cur, lane, va);
    for (;;) {
        const int nit = it + nh * 8; const bool more = nit < hi;
        const int nr = more ? nit : it;
        const WItem nxt = (nr < I_LAYER - I_IN) ? p0_weight_desc(ap, 0, I_IN + nr) : p0_weight_desc(ap, 1, nr - (I_LAYER - I_IN));
        f32x4 vb[16];
        if (more) p0_item_load<true>(nxt, lane, vb);
        p0_item_finish<true>(cur, scr, lane, va);
        if (!more) break;
#pragma unroll
        for (int i = 0; i < 16; ++i) va[i] = vb[i];
        cur = nxt; it = nit;
    }
}
__device__ __forceinline__ void p0_prologue(KArgs ap, LAS unsigned char* lds, int gw, int NGW, int wave, int lane) {
    struct { const float* in[20]; float* out; unsigned char* ws; } a; a.ws = ap->ws; a.out = ap->out;
#pragma unroll
    for (int i = 0; i < 19; ++i) a.in[i] = ap->in[i];
    LAS float* scr = (LAS float*)(lds + wave * P0_SCR);
    unsigned char* ws = a.ws;
    for (int it = gw; it < (MK_N_LAUNCHES == 1 ? I_IN : 2 * I_LAYER); it += NGW) p0_weight_item(ap, it / I_LAYER, it % I_LAYER, scr, lane);
    bf16_t* H = (bf16_t*)(ws + WS_H); float* ssq0 = (float*)(ws + WS_SSQ);
    for (int row = gw; row < MPAD; row += NGW) {
        const float* src = nullptr;
        if (row < ROW_S0) { const int b = row / TP, t = row % TP; src = t < 16 ? a.in[4] + (size_t)t * D : a.in[0] + ((size_t)b * 2048 + (t - 16)) * D; }
        else if (row < MREAL) src = a.in[1] + (size_t)(row - ROW_S0) * D;
        float s = 0.f;
#pragma unroll
        for (int j = 0; j < 4; ++j) { f32x4 v = src ? __builtin_nontemporal_load((const f32x4*)(src + 256 * j + 4 * lane)) : (f32x4){0.f, 0.f, 0.f, 0.f};
            s += (v[0] * v[0] + v[1] * v[1]) + (v[2] * v[2] + v[3] * v[3]);
            u32x2 o; o.x = pk2(v[0], v[1]); o.y = pk2(v[2], v[3]); *(u32x2*)(H + (size_t)row * D + 256 * j + 4 * lane) = o; }
        s = wave_sum(s);
        if (lane < 16) ssq0[(size_t)lane * MPAD + row] = lane == 0 ? s : 0.f;
    }
    bf16_t* haloA = (bf16_t*)(ws + WS_HALOA); bf16_t* haloB = (bf16_t*)(ws + WS_HALOB);
    for (int it = gw; it < 2 * NSTREAM * 32; it += NGW) {
        const int l = it / (NSTREAM * 32), S = (it / 32) % NSTREAM, p = it % 32;
        const float* src = nullptr; bf16_t* dst;
        if (p < 30) { dst = haloA + ((size_t)(l * NSTREAM + S) * 30 + p) * D; if (S >= NPROMPT) src = a.in[2] + ((size_t)(l * NSAMP + (S - NPROMPT)) * 30 + p) * D; }
        else { dst = haloB + ((size_t)(l * NSTREAM + S) * 2 + (p - 30)) * D; if (S >= NPROMPT) src = a.in[3] + ((size_t)(l * NSAMP + (S - NPROMPT)) * 2 + (p - 30)) * D; }
#pragma unroll
        for (int j = 0; j < 4; ++j) { f32x4 v = src ? *(const f32x4*)(src + 256 * j + 4 * lane) : (f32x4){0.f, 0.f, 0.f, 0.f};
            u32x2 o; o.x = pk2(v[0], v[1]); o.y = pk2(v[2], v[3]); *(u32x2*)(dst + 256 * j + 4 * lane) = o; }
    }
}

static_assert(true, "");
constexpr int CR = 24, N_CONV_ITEMS = NPROMPT * (TP / CR) + NSAMP;
static_assert(TP % CR == 0, "conv chunking");
constexpr int CONV_STAGE_BYTES = (CR + 30) * 2048;
static_assert(CONV_STAGE_BYTES + 8 * CR * 2 * 4 + CR * 2 * 4 <= RING_BYTES, "conv LDS");
static_assert(8 * P0_SCR <= LDSCTL_OFF, "prologue LDS");
struct ConvItem { int S, t0, nrows; size_t rowS; };
__device__ __forceinline__ ConvItem conv_item(int it) {
    ConvItem ci;
    if (it < NPROMPT * (TP / CR)) { ci.S = it / (TP / CR); ci.t0 = (it % (TP / CR)) * CR; ci.nrows = CR; ci.rowS = (size_t)ci.S * TP; }
    else { ci.S = NPROMPT + (it - NPROMPT * (TP / CR)); ci.t0 = 0; ci.nrows = TS; ci.rowS = (size_t)ROW_S0 + (size_t)(ci.S - NPROMPT) * TS; }
    return ci;
}
__device__ __forceinline__ void conv_stage_a(LAS unsigned char* lds, const bf16_t* UA, const bf16_t* haloA_l, const ConvItem& ci, int wave, int lane) {
    const bf16_t* hA = haloA_l + (size_t)ci.S * 30 * D; const bf16_t* uS = UA + ci.rowS * D;
    for (int p = wave; p < 2 * (CR + 30); p += 8) { const int r = p >> 1, h = p & 1, tp = ci.t0 - 30 + r;
        const bf16_t* src = tp >= 0 ? uS + (size_t)tp * D : hA + (size_t)(30 + tp) * D;
        __builtin_amdgcn_global_load_lds((const unsigned*)((const char*)src + h * 1024 + lane * 16), (LAS unsigned*)(lds + r * 2048 + h * 1024), 16, 0, 2  ); }
}
__device__ __forceinline__ void conv_load_b(u32x4 (&zb)[8], u32x4 (&bb)[6], const bf16_t* ZB, const bf16_t* BB, const bf16_t* haloB_l, const ConvItem& ci, int cg, int rg) {
    const bf16_t* hB = haloB_l + (size_t)ci.S * 2 * D; const bf16_t* zS = ZB + ci.rowS * D; const int r0 = ci.t0 + 6 * rg;
    const bf16_t* z0p = r0 == 0 ? hB : zS + (size_t)(r0 - 2) * D; const bf16_t* z1p = r0 == 0 ? hB + D : zS + (size_t)(r0 - 1) * D;
    zb[0] = *(const u32x4*)(z0p + 8 * cg); zb[1] = *(const u32x4*)(z1p + 8 * cg);
    const bf16_t* zp = zS + (size_t)r0 * D + 8 * cg;
#pragma unroll
    for (int i = 0; i < 6; ++i) { zb[2 + i] = __builtin_nontemporal_load((const u32x4*)zp); zp += D; asm volatile("" : "+v"(zp)); }
    const bf16_t* bp = BB + (ci.rowS + r0) * D + 8 * cg;
#pragma unroll
    for (int i = 0; i < 6; ++i) { bb[i] = __builtin_nontemporal_load((const u32x4*)bp); bp += D; asm volatile("" : "+v"(bp)); }
}
__device__ __forceinline__ void conv_phase(KArgs ap, int l, LAS unsigned char* lds, int tid, int wave, int lane) {
    struct { const float* in[20]; float* out; unsigned char* ws; } a; a.ws = ap->ws; a.out = ap->out; a.in[2] = ap->in[2]; a.in[7] = ap->in[7]; a.in[8] = ap->in[8]; a.in[9] = ap->in[9]; a.in[10] = ap->in[10]; a.in[12] = ap->in[12];
    unsigned char* ws = a.ws;
    const bf16_t* UA = (const bf16_t*)(ws + WS_UA); const bf16_t* ZB = (const bf16_t*)(ws + WS_ZB); bf16_t* BB = (bf16_t*)(ws + WS_BB); bf16_t* CA = (bf16_t*)((unsigned char*)a.out + DO_CA);
    const bf16_t* haloA = (const bf16_t*)(ws + WS_HALOA) + (size_t)l * NSTREAM * 30 * D; const bf16_t* haloB = (const bf16_t*)(ws + WS_HALOB) + (size_t)l * NSTREAM * 2 * D;
    LAS float* red = (LAS float*)(lds + CONV_STAGE_BYTES);
    LAS float* fin = red + 8 * CR * 2;
    const LAS unsigned char* xl = lds + tid * 4;
    const int c0 = 2 * tid;
    const int cg = tid & 127, rg = tid >> 7;
    const float* cbw = a.in[12] + (size_t)l * 3 * D + 8 * cg;
    const f32x2 bias = *(const f32x2*)(a.in[8] + l * D + c0), lng = *(const f32x2*)(a.in[9] + l * D + c0), lnb = *(const f32x2*)(a.in[10] + l * D + c0);
    f32x4 wb[3][2];
#pragma unroll
    for (int k = 0; k < 3; ++k) { wb[k][0] = *(const f32x4*)(cbw + k * D); wb[k][1] = *(const f32x4*)(cbw + k * D + 4); }
    f32x2 w[31];
#define CONV_LOAD_TAPS() do { const float* wp = a.in[7] + (size_t)l * 31 * D + c0; asm volatile("" : "+v"(wp)); \
        _Pragma("unroll") for (int k = 0; k < 31; ++k) { w[k] = *(const f32x2*)wp; wp += D; asm volatile("" : "+v"(wp)); } } while (0)
    CONV_LOAD_TAPS();
    u32x4 zb[8], bb[6];
    int it = blockIdx.x; ConvItem ci = conv_item(it < N_CONV_ITEMS ? it : 0);
    __syncthreads();
    if (it < N_CONV_ITEMS) { conv_stage_a(lds, UA, haloA, ci, wave, lane); conv_load_b(zb, bb, ZB, BB, haloB, ci, cg, rg); }
    for (; it < N_CONV_ITEMS; it += gridDim.x) {
        VM_WAIT(); __syncthreads();
        f32x2 acc[CR];
#pragma unroll
        for (int i = 0; i < CR; ++i) acc[i] = bias;
#pragma unroll
        for (int j = 0; j < CR + 30; ++j) {
            const unsigned xw = *(const LAS unsigned*)(xl + j * 2048); const f32x2 xv = {bf_lo(xw), bf_hi(xw)};
#pragma unroll
            for (int i = (j - 30 > 0 ? j - 30 : 0); i <= (j < CR - 1 ? j : CR - 1); ++i) acc[i] = __builtin_elementwise_fma(w[j - i], xv, acc[i]);
            if ((j & 7) == 7) {
#pragma unroll
                for (int i = 0; i < CR; i += 4) asm volatile("" : "+v"(acc[i].x), "+v"(acc[i].y), "+v"(acc[i + 1].x), "+v"(acc[i + 1].y), "+v"(acc[i + 2].x), "+v"(acc[i + 2].y), "+v"(acc[i + 3].x), "+v"(acc[i + 3].y) :: "memory");
            }
        }
        { float pv[2 * CR];
#pragma unroll
          for (int i = 0; i < CR; ++i) { pv[2 * i] = acc[i].x + acc[i].y; pv[2 * i + 1] = acc[i].x * acc[i].x + acc[i].y * acc[i].y; }
          const float tot = reduce48(pv, lane);
          if (lane < 2 * CR) red[wave * 2 * CR + lane] = tot; }
#pragma unroll
        for (int j = 0; j < 6; ++j) if (6 * rg + j < ci.nrows) {
            unsigned o[4];
#pragma unroll
            for (int q = 0; q < 4; ++q) {
                const float c0v = wb[0][q >> 1][(2 * q) & 3] * bf_lo(zb[j][q]) + wb[1][q >> 1][(2 * q) & 3] * bf_lo(zb[j + 1][q]) + wb[2][q >> 1][(2 * q) & 3] * bf_lo(zb[j + 2][q]);
                const float c1v = wb[0][q >> 1][(2 * q + 1) & 3] * bf_hi(zb[j][q]) + wb[1][q >> 1][(2 * q + 1) & 3] * bf_hi(zb[j + 1][q]) + wb[2][q >> 1][(2 * q + 1) & 3] * bf_hi(zb[j + 2][q]);
                o[q] = cvt_pk_bf16_pin(bf_lo(bb[j][q]) * c0v, bf_hi(bb[j][q]) * c1v); }
            u32x4 w4; w4.x = o[0]; w4.y = o[1]; w4.z = o[2]; w4.w = o[3];
            __builtin_nontemporal_store(w4, (u32x4*)(BB + (ci.rowS + ci.t0 + 6 * rg + j) * D + 8 * cg)); }
        LDS_WAIT(); __syncthreads();
        const int nit = it + gridDim.x; const bool more = nit < N_CONV_ITEMS; const ConvItem cn = conv_item(more ? nit : it);
        if (more) conv_stage_a(lds, UA, haloA, cn, wave, lane);
        if (tid < CR) { float s1 = 0.f, s2 = 0.f;
#pragma unroll
            for (int wv = 0; wv < 8; ++wv) { s1 += red[(wv * CR + tid) * 2]; s2 += red[(wv * CR + tid) * 2 + 1]; }
            const float mean = s1 * (1.0f / D); float var = s2 * (1.0f / D) - mean * mean; var = var > 0.f ? var : 0.f;
            fin[tid * 2] = mean; fin[tid * 2 + 1] = 1.0f / sqrtf(var + LN_EPS); }
        LDS_WAIT(); __syncthreads();
#pragma unroll
        for (int i = 0; i < CR; ++i) if (i < ci.nrows) {
            const float mean = fin[i * 2], rstd = fin[i * 2 + 1];
            const float y0 = (acc[i].x - mean) * rstd * lng.x + lnb.x, y1 = (acc[i].y - mean) * rstd * lng.y + lnb.y;
            __builtin_nontemporal_store(cvt_pk_bf16_pin(y0 * sigmoid_fast(y0), y1 * sigmoid_fast(y1)), (unsigned*)(CA + (ci.rowS + ci.t0 + i) * D + c0)); }
        if (more) { conv_load_b(zb, bb, ZB, BB, haloB, cn, cg, rg); CONV_LOAD_TAPS(); }
        ci = cn;
    }
    VM_WAIT(); __syncthreads();
    for (int it = blockIdx.x; it < NSTREAM * 32; it += gridDim.x) {
        const int S = it / 32, p = it % 32; float* dst; f32x2 v;
        if (p < 30) {
            if (S < NPROMPT) { dst = a.out + OUT_NAP + ((size_t)(l * NPROMPT + S) * 30 + p) * D; const unsigned xw = *(const unsigned*)(UA + ((size_t)S * TP + (TP - 30) + p) * D + c0); v = (f32x2){bf_lo(xw), bf_hi(xw)}; }
            else { const int s = S - NPROMPT; dst = a.out + OUT_NAS + ((size_t)(l * NSAMP + s) * 30 + p) * D;
                if (p < 30 - TS) v = *(const f32x2*)(a.in[2] + ((size_t)(l * NSAMP + s) * 30 + TS + p) * D + c0);
                else { const unsigned xw = *(const unsigned*)(UA + ((size_t)ROW_S0 + (size_t)s * TS + (p - (30 - TS))) * D + c0); v = (f32x2){bf_lo(xw), bf_hi(xw)}; } }
        } else { const int q = p - 30;
            if (S < NPROMPT) { dst = a.out + OUT_NBP + ((size_t)(l * NPROMPT + S) * 2 + q) * D; const unsigned xw = *(const unsigned*)(ZB + ((size_t)S * TP + (TP - 2) + q) * D + c0); v = (f32x2){bf_lo(xw), bf_hi(xw)}; }
            else { const int s = S - NPROMPT; dst = a.out + OUT_NBS + ((size_t)(l * NSAMP + s) * 2 + q) * D; const unsigned xw = *(const unsigned*)(ZB + ((size_t)ROW_S0 + (size_t)s * TS + (TS - 2) + q) * D + c0); v = (f32x2){bf_lo(xw), bf_hi(xw)}; } }
        *(f32x2*)(dst + c0) = v;
    }
}

__device__ __forceinline__ void final_phase(KArgs ap, int gw, int NGW, int lane) {
    struct { const float* in[20]; float* out; unsigned char* ws; } a; a.ws = ap->ws; a.out = ap->out; a.in[19] = ap->in[19];
    const bf16_t* H = (const bf16_t*)(a.ws + WS_H); const float* ssq = (const float*)(a.ws + WS_SSQ + 4 * SSQ_ONE); const float* g = a.in[19];
    for (int row = gw; row < MREAL; row += NGW) {
        float* dst;
        if (row < ROW_S0) { const int b = row / TP, t = row % TP; if (t < 16) continue; dst = a.out + OUT_YP + ((size_t)b * 2048 + (t - 16)) * D; }
        else dst = a.out + OUT_YS + (size_t)(row - ROW_S0) * D;
        float s = lane < 16 ? ssq[(size_t)lane * MPAD + row] : 0.f; s = wave_sum(s);
        const float r = 1.0f / sqrtf(s * (1.0f / D) + RMS_EPS);
#pragma unroll
        for (int j = 0; j < 2; ++j) { const int c = 512 * j + 8 * lane; const u32x4 h = __builtin_nontemporal_load((const u32x4*)(H + (size_t)row * D + c));
            const f32x4 g0 = *(const f32x4*)(g + c), g1 = *(const f32x4*)(g + c + 4);
            f32x4 o0, o1; o0[0] = bf_lo(h.x) * r * g0[0]; o0[1] = bf_hi(h.x) * r * g0[1]; o0[2] = bf_lo(h.y) * r * g0[2]; o0[3] = bf_hi(h.y) * r * g0[3];
            o1[0] = bf_lo(h.z) * r * g1[0]; o1[1] = bf_hi(h.z) * r * g1[1]; o1[2] = bf_lo(h.w) * r * g1[2]; o1[3] = bf_hi(h.w) * r * g1[3];
            __builtin_nontemporal_store(o0, (f32x4*)(dst + c)); __builtin_nontemporal_store(o1, (f32x4*)(dst + c + 4)); }
    }
}

__global__ void __launch_bounds__(512, 2) mega_fwd(Args a_unused) {
    extern __shared__ __attribute__((aligned(16))) unsigned char lds_raw[];
    LAS unsigned char* lds = (LAS unsigned char*)lds_raw;
    const KArgs kp = (KArgs)__builtin_amdgcn_kernarg_segment_ptr();
    const int wave = __builtin_amdgcn_readfirstlane(threadIdx.x >> 6);
    const int G = gridDim.x, bx = blockIdx.x, vcu = (G % 8 == 0) ? (bx % 8) * (G / 8) + bx / 8 : bx;
    const int gw = vcu * 8 + wave, NGW = G * 8;
    volatile LAS unsigned* ctl = (volatile LAS unsigned*)(lds + LDSCTL_OFF);
    if (threadIdx.x < 64) ctl[threadIdx.x] = 0u;
    __syncthreads();
    XcdBarrier bar; bar.bar = (unsigned*)(kp->ws + WS_CTL); bar.x = 0; bar.st = nullptr;
    if (MK_N_LAUNCHES == 1) bar = xcd_barrier_post((unsigned*)(kp->ws + WS_CTL), ctl + 8);
    const unsigned my_xcc = xb_xcc_id();
    if (threadIdx.x == 0) __hip_atomic_store((unsigned*)(kp->ws + WS_XCCTAB) + vcu, my_xcc + 1u, __ATOMIC_RELAXED, __HIP_MEMORY_SCOPE_AGENT);
    const int lo = kp->ph_lo, hi = kp->ph_hi;
#define IN(k) (lo <= (k) && (k) < hi)
#define SEAM(k) do { if (IN(k) && IN((k) + 1)) xcd_barrier(bar, wave); } while (0)

    if (IN(0)) { for (int rep = 0; rep < REP_P0; ++rep) { p0_prologue(fresh(kp), lds, gw, NGW, wave, lane_id()); __syncthreads(); } SEAM(0); }

    const int same_next = (MK_N_LAUNCHES == 1 && vcu + 1 < G) ? (__builtin_amdgcn_readfirstlane(__hip_atomic_load((unsigned*)(kp->ws + WS_XCCTAB) + vcu + 1, __ATOMIC_RELAXED, __HIP_MEMORY_SCOPE_AGENT)) == my_xcc + 1u) : 0;
#pragma unroll 1
    for (int l = 0; l < 2; ++l) {
        const int pb = 1 + 6 * l;
        if (IN(pb + 0)) {
            const KArgs ap = fresh(kp); unsigned char* ws = ap->ws; unsigned char* dob = (unsigned char*)ap->out;
            const bf16_t* H = (const bf16_t*)(ws + WS_H); const bf16_t* w_in_t = (const bf16_t*)(l ? dob + DO_W1_IN : ws + WS_W0_IN);
            pg8::Gemm g{H, w_in_t, H, w_in_t}; pg8::StreamK<NIN / 256, D / 128, 0> S; S.init(vcu);
            Epi1 E{{(const float*)(ws + WS_SSQ + (size_t)(2 * l) * SSQ_ONE), lds + RSTD_OFF}, (bf16_t*)(ws + WS_UA)}; pg8::SlotIO io{dob + DO_CA, (unsigned*)(ws + WS_SKFLAG) + (size_t)(5 * l + 0) * 256 * 64, vcu, same_next};
            if (MK_N_LAUNCHES == 1) {
                const WgRole wr = wg_role(vcu, NW_G1);
                if (!wr.compute) p0_background(fresh(kp), lds, wr.h, N_HELPERS, l ? BG_B : 0, l ? BG_C : BG_A, wave, lane_id());
                else {
                    const KArgs ap2 = fresh(kp); unsigned char* ws2 = ap2->ws; unsigned char* dob2 = (unsigned char*)ap2->out;
                    const bf16_t* H2 = (const bf16_t*)(ws2 + WS_H); const bf16_t* w2 = (const bf16_t*)(l ? dob2 + DO_W1_IN : ws2 + WS_W0_IN);
                    const pg8::Gemm g2{H2, w2, H2, w2}; pg8::StreamK<NIN / 256, D / 128, 0, NW_G1> S2; S2.init(opaque_s(wr.cc));
                    const Epi1 E2{{(const float*)(ws2 + WS_SSQ + (size_t)(2 * l) * SSQ_ONE), lds + RSTD_OFF}, (bf16_t*)(ws2 + WS_UA)}; const pg8::SlotIO io2{dob2 + DO_CA, (unsigned*)(ws2 + WS_SKFLAG) + (size_t)(5 * l + 0) * 256 * 64, opaque_s(wr.cc), 0};
                    pg8::gemm_phase<Epi1, pg8::StreamK<NIN / 256, D / 128, 0, NW_G1>, D, 1 << 20>(lds, g2, S2, E2, io2, wave);
                }
            } else
            for (int rep = 0; rep < REP_G1; ++rep) pg8::gemm_phase<Epi1, pg8::StreamK<NIN / 256, D / 128, 0>, D, 1 << 20>(lds, g, S, E, io, wave);
            SEAM(pb + 0);
        }
        if (IN(pb + 1)) { const int l_ = lane_id(); conv_phase(fresh(kp), l, lds, wave * 64 + l_, wave, l_); SEAM(pb + 1); }
        if (IN(pb + 2)) {
            const KArgs ap = fresh(kp); unsigned char* ws = ap->ws; unsigned char* dob = (unsigned char*)ap->out;
            const bf16_t* w_ab_t = (const bf16_t*)(ws + (l ? WS_W1_AB : WS_W0_AB));
            pg8::Gemm g{(const bf16_t*)(dob + DO_CA), w_ab_t, (const bf16_t*)(ws + WS_BB), w_ab_t + (size_t)D * D}; pg8::StreamK<D / 256, 2 * D / 128, 16> S; S.init(vcu);
            Epi2 E{(bf16_t*)(ws + WS_SGA), (const bf16_t*)(ws + WS_SGB), (bf16_t*)(ws + WS_SGA)}; pg8::SlotIO io{ws + WS_UA, (unsigned*)(ws + WS_SKFLAG) + (size_t)(5 * l + 1) * 256 * 64, vcu, same_next};
            pg8::gemm_phase<Epi2, pg8::StreamK<D / 256, 2 * D / 128, 16>, D, 16>(lds, g, S, E, io, wave);
            SEAM(pb + 2);
        }
        if (IN(pb + 3)) {
            const KArgs ap = fresh(kp); unsigned char* ws = ap->ws;
            const bf16_t* MG = (const bf16_t*)(ws + WS_SGA); const bf16_t* w_o_t = (const bf16_t*)(ws + (l ? WS_W1_O : WS_W0_O));
            pg8::Gemm g{MG, w_o_t, MG, w_o_t}; pg8::StreamK<D / 256, D / 128, 0> S; S.init(vcu);
            EpiRes E{(bf16_t*)(ws + WS_H), (float*)(ws + WS_SSQ + (size_t)(2 * l + 1) * SSQ_ONE), (bf16_t*)(ws + WS_H)}; pg8::SlotIO io{ws + WS_UA, (unsigned*)(ws + WS_SKFLAG) + (size_t)(5 * l + 2) * 256 * 64, vcu, same_next};
            pg8::gemm_phase<EpiRes, pg8::StreamK<D / 256, D / 128, 0>, D, 1 << 20>(lds, g, S, E, io, wave);
            SEAM(pb + 3);
        }
        if (IN(pb + 4)) {
            const KArgs ap = fresh(kp); unsigned char* ws = ap->ws; unsigned char* dob = (unsigned char*)ap->out;
            const bf16_t* H = (const bf16_t*)(ws + WS_H); const bf16_t* w_gu_t = (const bf16_t*)(l ? dob + DO_W1_GU : ws + WS_W0_GU);
            pg8::Gemm g{H, w_gu_t, H, w_gu_t}; pg8::StreamK<NGU / 256, D / 128, 0> S; S.init(vcu);
            Epi4 E{{(const float*)(ws + WS_SSQ + (size_t)(2 * l + 1) * SSQ_ONE), lds + RSTD_OFF}, (bf16_t*)(ws + WS_F)}; pg8::SlotIO io{ws + WS_SGB, (unsigned*)(ws + WS_SKFLAG) + (size_t)(5 * l + 3) * 256 * 64, vcu, same_next};
            if (MK_N_LAUNCHES == 1) {
                const WgRole wr = wg_role(vcu, NW_G4);
                if (!wr.compute) p0_background(fresh(kp), lds, wr.h, 256 - NW_G4, l ? BG_C : BG_A, l ? BG_ITEMS : BG_B, wave, lane_id());
                else {
                    const KArgs ap2 = fresh(kp); unsigned char* ws2 = ap2->ws; unsigned char* dob2 = (unsigned char*)ap2->out;
                    const bf16_t* H2 = (const bf16_t*)(ws2 + WS_H); const bf16_t* w2 = (const bf16_t*)(l ? dob2 + DO_W1_GU : ws2 + WS_W0_GU);
                    const pg8::Gemm g2{H2, w2, H2, w2}; pg8::StreamK<NGU / 256, D / 128, 0, NW_G4> S2; S2.init(opaque_s(wr.cc));
                    const Epi4 E2{{(const float*)(ws2 + WS_SSQ + (size_t)(2 * l + 1) * SSQ_ONE), lds + RSTD_OFF}, (bf16_t*)(ws2 + WS_F)}; const pg8::SlotIO io2{ws2 + WS_SGB, (unsigned*)(ws2 + WS_SKFLAG) + (size_t)(5 * l + 3) * 256 * 64, opaque_s(wr.cc), 0};
                    pg8::gemm_phase<Epi4, pg8::StreamK<NGU / 256, D / 128, 0, NW_G4>, D, 1 << 20>(lds, g2, S2, E2, io2, wave);
                }
            } else
            for (int rep = 0; rep < REP_G4; ++rep) pg8::gemm_phase<Epi4, pg8::StreamK<NGU / 256, D / 128, 0>, D, 1 << 20>(lds, g, S, E, io, wave);
            SEAM(pb + 4);
        }
        if (IN(pb + 5)) {
            const KArgs ap = fresh(kp); unsigned char* ws = ap->ws; unsigned char* dob = (unsigned char*)ap->out;
            const bf16_t* F = (const bf16_t*)(ws + WS_F); const bf16_t* w_d_t = (const bf16_t*)(l ? dob + DO_W1_D : ws + WS_W0_D);
            pg8::Gemm g{F, w_d_t, F, w_d_t}; pg8::StreamK<D / 256, DH / 128, 0> S; S.init(vcu);
            EpiRes E{(bf16_t*)(ws + WS_H), (float*)(ws + WS_SSQ + (size_t)(2 * l + 2) * SSQ_ONE), (bf16_t*)(ws + WS_H)}; pg8::SlotIO io{ws + WS_SGB, (unsigned*)(ws + WS_SKFLAG) + (size_t)(5 * l + 4) * 256 * 64, vcu, same_next};
            pg8::gemm_phase<EpiRes, pg8::StreamK<D / 256, DH / 128, 0>, DH, 1 << 20>(lds, g, S, E, io, wave);
            SEAM(pb + 5);
        }
    }
    if (IN(13)) for (int rep = 0; rep < REP_FIN; ++rep) final_phase(fresh(kp), gw, NGW, lane_id());
#undef IN
#undef SEAM
}

extern "C" void kernel_launch(void* const* d_in, const int* in_sizes, int n_in, void* d_out, int out_size, void* d_ws, size_t ws_size, hipStream_t stream) {
    static int grid = 0;
    if (grid == 0) {
        if (n_in != 20 || (size_t)out_size != OUT_TOTAL || ws_size < WS_END) { fprintf(stderr, "kernel_launch: unexpected shapes (n_in %d, out %d, ws %zu); nothing launched\n", n_in, out_size, ws_size); grid = -1; return; }
        int dev = 0, cus = 0, per_cu = 0;
        if (hipGetDevice(&dev) != hipSuccess || hipDeviceGetAttribute(&cus, hipDeviceAttributeMultiprocessorCount, dev) != hipSuccess) { grid = -1; return; }
        if (hipFuncSetAttribute((const void*)mega_fwd, hipFuncAttributeMaxDynamicSharedMemorySize, LDS_BYTES) != hipSuccess) { fprintf(stderr, "kernel_launch: hipFuncSetAttribute failed\n"); grid = -1; return; }
        if (hipOccupancyMaxActiveBlocksPerMultiprocessor(&per_cu, (const void*)mega_fwd, 512, LDS_BYTES) != hipSuccess || per_cu < 1) { fprintf(stderr, "kernel_launch: occupancy query says %d blocks per CU\n", per_cu); per_cu = 1; }
        (void)hipGetLastError();
        if (cus != 256) { fprintf(stderr, "kernel_launch: built for a 256-CU device (got %d)\n", cus); grid = -1; return; }
        grid = cus;
    }
    if (grid < 0) return;
    if (hipMemsetAsync((char*)d_ws + WS_CTL, 0, CTL_ZERO_BYTES, stream) != hipSuccess) { fprintf(stderr, "kernel_launch: memset failed\n"); return; }
    Args a{};
    for (int i = 0; i < 20; ++i) a.in[i] = (const float*)d_in[i];
    a.out = (float*)d_out; a.ws = (unsigned char*)d_ws;
    for (int li = 0; li < MK_N_LAUNCHES; ++li) {
        a.ph_lo = (MK_N_LAUNCHES == 1) ? 0 : li; a.ph_hi = (MK_N_LAUNCHES == 1) ? NPHASE : li + 1;
        hipLaunchKernelGGL(mega_fwd, dim3(grid), dim3(512), LDS_BYTES, stream, a);
        const hipError_t le = hipPeekAtLastError();
        if (le != hipSuccess) { fprintf(stderr, "kernel_launch: launch %d failed: %s\n", li, hipGetErrorName(le)); break; }
    }
}
```

```cpp
#include <hip/hip_runtime.h>
#include <cstdio>
#include <cstdint>

#ifndef REP_P0
#define REP_P0 1
#endif
#ifndef REP_G1
#define REP_G1 1
#endif
#ifndef REP_G4
#define REP_G4 1
#endif
#ifndef REP_FIN
#define REP_FIN 1
#endif
#ifndef DRY_G2
#define DRY_G2 0
#endif
#ifndef DRY_G3
#define DRY_G3 0
#endif
#ifndef DRY_G5
#define DRY_G5 0
#endif
#ifndef MK_N_LAUNCHES
#define MK_N_LAUNCHES 1
#endif

constexpr int D = 1024, NIN = 7168, DH = 2816, NGU = 2 * DH;
constexpr int NPROMPT = 8, TP = 2064, NSAMP = 16, TS = 16, NSTREAM = NPROMPT + NSAMP;
constexpr int ROW_S0 = NPROMPT * TP;
constexpr int MREAL = ROW_S0 + NSAMP * TS;
constexpr int MPAD = 16896, NPAN = MPAD / 256;
static_assert(NPAN == 66, "StreamK assumes 66 row panels (a last group of two)");
constexpr float RMS_EPS = 1e-6f, LN_EPS = 1e-5f;
constexpr int NPHASE = 14;

__device__ __forceinline__ int opaque_v(int x) { asm volatile("" : "+v"(x)); return x; }
__device__ __forceinline__ int opaque_s(int x) { asm volatile("" : "+s"(x)); return x; }
__device__ __forceinline__ int lane_id() { int x; asm volatile("v_mbcnt_lo_u32_b32 %0, -1, 0\n\tv_mbcnt_hi_u32_b32 %0, -1, %0" : "=v"(x)); return x; }
namespace pg8 {
#define PG8_LAS __attribute__((address_space(3)))
typedef unsigned short bf16_t;
typedef short bf16x8 __attribute__((ext_vector_type(8)));
typedef float f32x4 __attribute__((ext_vector_type(4)));
typedef unsigned u32x4 __attribute__((ext_vector_type(4)));
constexpr int BM = 256, BK = 64, HALF = 128, HTB = HALF * BK * 2  , STAGE_BYTES = 8 * HTB, NXCD = 8, WGM = 8;

__host__ __device__ __forceinline__ int lds_byte(int r, int c) { const int st = (r >> 4) * 2 + (c >> 5), rr = r & 15, cc = c & 31, ob = rr * 64 + cc * 2; return st * 1024 + (ob ^ (((ob >> 9) & 1) << 5)); }
__host__ __device__ __forceinline__ void stage_rc(int b, int& R, int& C) { const int st = b / 1024, sb = b % 1024, swz = sb ^ (((sb >> 9) & 1) << 5); R = (st >> 1) * 16 + swz / 64; C = (st & 1) * 32 + (swz % 64) / 2; }
__host__ __device__ __forceinline__ int perm32(int rho) { const int n = rho >> 4, i = rho & 15; return 8 * (i >> 2) + 4 * n + (i & 3); }

struct Unit { int pm, pn, kb, nk, flags; };
struct Gemm { const bf16_t* A; const bf16_t* Bt; const bf16_t* A2; const bf16_t* Bt2; };
struct SlotIO { unsigned char* slots; unsigned* flags; int me; int same_next; };

template <int NN  , int P  , int KSPLIT  , int NW = 256  >
struct StreamK {
    static constexpr int nM = 66, nN = NN, NTILES = nM * nN, N_DP_ROUNDS = (NTILES / NW - 1) > 0 ? (NTILES / NW - 1) : 0, N_DP = NW * N_DP_ROUNDS;
    static constexpr bool WHOLE = (NTILES % NW == 0) && KSPLIT == 0;
    int c, t_first, o_s, t_last, o_e, has_head, has_tail, first_full, n_full;
    __device__ static int cut(int c) { return (int)((long)(NTILES - N_DP) * P * c / NW); }
    __device__ void init(int c_) {
        c = c_;
        const int s = cut(c), e = cut(c + 1);
        t_first = s / P; o_s = s % P; t_last = (e - 1) / P; o_e = e - t_last * P;
        has_tail = (o_s > 0 && e > s); has_head = (o_e < P && e > s && !(t_last == t_first && o_s > 0));
        first_full = has_tail ? t_first + 1 : t_first; const int last_full = has_head ? t_last - 1 : t_last; n_full = (e > s) ? last_full - first_full + 1 : 0; if (n_full < 0) n_full = 0;
    }
    __device__ static void tile_of(int t, Unit& u) { constexpr int nig = WGM * nN; const int gid = t / nig, fm = gid * WGM, r = t - gid * nig;
        if (nM - fm >= WGM) { u.pm = fm + (r & (WGM - 1)); u.pn = r / WGM; } else { u.pm = fm + (r & 1); u.pn = r >> 1; } }
    __device__ bool base(int i, Unit& u) const {
        if (has_head) { if (i == 0) { tile_of(N_DP + t_last, u); u.kb = 0; u.nk = 2 * o_e; u.flags = 2; return true; } --i; }
        if (i < N_DP_ROUNDS) { tile_of(NW * i + c, u); u.kb = 0; u.nk = 2 * P; u.flags = 0; return true; } i -= N_DP_ROUNDS;
        if (i < n_full) { tile_of(N_DP + first_full + i, u); u.kb = 0; u.nk = 2 * P; u.flags = 0; return true; } i -= n_full;
        if (has_tail && i == 0) { tile_of(N_DP + t_first, u); u.kb = 2 * o_s; u.nk = 2 * (P - o_s); u.flags = 1; return true; }
        return false;
    }
    mutable int it_i, it_second; mutable Unit it_u;
    __device__ void start() const { it_i = 0; it_second = 0; }
    __device__ bool advance(Unit& u) const {
        if constexpr (KSPLIT > 0) { if (it_second) { u = it_u; u.nk = it_u.kb + it_u.nk - KSPLIT; u.kb = KSPLIT; u.flags = 8 | (it_u.flags & 2); it_second = 0; return true; } }
        if (!base(it_i, u)) return false; ++it_i;
        if constexpr (KSPLIT > 0) {
            if (u.kb < KSPLIT && u.kb + u.nk > KSPLIT) { it_u = u; it_second = 1; u.nk = KSPLIT - u.kb; u.flags = (u.flags & 1) | 4; }
            else if (u.kb + u.nk == KSPLIT) u.flags |= 16;
        }
        return true;
    }
};

typedef __bf16 bf16x2_t __attribute__((ext_vector_type(2)));
typedef float f32x2_t __attribute__((ext_vector_type(2)));
__device__ __forceinline__ unsigned cvt_pk_bf16(float lo, float hi) { const f32x2_t v = {lo, hi}; const bf16x2_t r = __builtin_convertvector(v, bf16x2_t); return __builtin_bit_cast(unsigned, r); }

template <class Epi, class Sched, int KPITCH  , int KWRAP  >
__device__ __forceinline__ void gemm_phase(PG8_LAS unsigned char* lds, const Gemm g, const Sched& S, const Epi& E, const SlotIO io, const int wid_in  ) {
    const int wid = opaque_s(wid_in), lane = lane_id(), tid = wid * 64 + lane, wr = wid >> 2, wc = wid & 3, fr = lane & 15, fq = lane >> 4;
    constexpr int K = KPITCH;
    unsigned voffA[2], voffB[2];
#pragma unroll
    for (int i = 0; i < 2; ++i) { int R, C; stage_rc(tid * 16 + i * 8192, R, C); const int Rb = (R & ~31) + perm32(R & 31);
        voffA[i] = (unsigned)(R * K + C) * 2u; voffB[i] = (unsigned)(Rb * K + C) * 2u; }
    const size_t kstep = (size_t)(BK * 2);
    const size_t hstep = (size_t)HALF * K * 2;
    const size_t tstep = 2 * hstep;
    const unsigned ldsw = (unsigned)wid * 1024u;
    const int aoff = lds_byte(wr * 64 + fr, fq * 8), boff = lds_byte(wc * 32 + fr, fq * 8);
#define PG8_SA(b, h) (((b) * 2 + (h)) * HTB)
#define PG8_SB(b, h) ((4 + (b) * 2 + (h)) * HTB)
#define PG8_STAGE(bufoff, gbase, voff) do { _Pragma("unroll") for (int _i = 0; _i < 2; ++_i) \
        __builtin_amdgcn_global_load_lds((const unsigned*)((const char*)(gbase) + (voff)[_i]), (PG8_LAS unsigned*)(lds + (bufoff) + ldsw + _i * 8192), 16, 0, 0); } while (0)
#define PG8_LDA(dst, b, h) do { _Pragma("unroll") for (int m = 0; m < 4; ++m) _Pragma("unroll") for (int k = 0; k < 2; ++k) dst[m][k] = *(const PG8_LAS bf16x8*)(lds + PG8_SA(b, h) + aoff + m * 2048 + k * 1024); } while (0)
#define PG8_LDB(dst, b, h) do { _Pragma("unroll") for (int n = 0; n < 2; ++n) _Pragma("unroll") for (int k = 0; k < 2; ++k) dst[n][k] = *(const PG8_LAS bf16x8*)(lds + PG8_SB(b, h) + boff + n * 2048 + k * 1024); } while (0)
#define PG8_MMA(ai, bj, At, Bt) do { __builtin_amdgcn_s_setprio(1); _Pragma("unroll") for (int m = 0; m < 4; ++m) _Pragma("unroll") for (int n = 0; n < 2; ++n) _Pragma("unroll") for (int k = 0; k < 2; ++k) \
        acc[ai][bj][m][n] = __builtin_amdgcn_mfma_f32_16x16x32_bf16(Bt[n][k], At[m][k], acc[ai][bj][m][n], 0, 0, 0); __builtin_amdgcn_s_setprio(0); } while (0)
#define PG8_WAIT_V(n) asm volatile("s_waitcnt vmcnt(" #n ")" ::: "memory")
#define PG8_WAIT_L(n) asm volatile("s_waitcnt lgkmcnt(" #n ")" ::: "memory")
#define PG8_BAR __builtin_amdgcn_s_barrier()
#define PG8_SCHED __builtin_amdgcn_sched_barrier(0)
#define PG8_KA(u, T) ((const char*)(((T) < KWRAP) ? g.A : g.A2) + (size_t)(u).pm * tstep + (size_t)(((T) < KWRAP) ? (T) : (T) - KWRAP) * kstep)
#define PG8_KB(u, T) ((const char*)(((T) < KWRAP) ? g.Bt : g.Bt2) + (size_t)(u).pn * tstep + (size_t)(((T) < KWRAP) ? (T) : (T) - KWRAP) * kstep)
    Unit cur, nxt; int ui = 0;
    S.start();
    if (!S.advance(cur)) return;
    f32x4 acc[2][2][4][2];
    bf16x8 At[4][2], B0[2][2], B1[2][2];
    {   const char* cA = PG8_KA(cur, cur.kb); const char* cB = PG8_KB(cur, cur.kb);
        PG8_STAGE(PG8_SB(0, 0), cB, voffB); PG8_STAGE(PG8_SB(0, 1), cB + hstep, voffB); PG8_STAGE(PG8_SA(0, 0), cA, voffA); PG8_STAGE(PG8_SA(0, 1), cA + hstep, voffA);
        if (wr == 1) PG8_BAR;
        PG8_WAIT_V(2); PG8_BAR;
        PG8_STAGE(PG8_SB(1, 0), cB + kstep, voffB); PG8_STAGE(PG8_SA(1, 0), cA + kstep, voffA); PG8_STAGE(PG8_SB(1, 1), cB + hstep + kstep, voffB);
        PG8_WAIT_V(6); PG8_BAR; }
    for (;;) {
        const bool has_next = S.advance(nxt);
        if (!Sched::WHOLE && (cur.flags & 8)) {   }
        else if (!Sched::WHOLE && (cur.flags & 1)) {
            const __amdgpu_buffer_rsrc_t rs_in = __builtin_amdgcn_make_buffer_rsrc((void*)(io.slots + (size_t)(io.me - 1) * 131072), 0, 131072, 0x00020000);
            unsigned* fl = io.flags + (size_t)(io.me - 1) * 64; unsigned spins = 0;
            while ((unsigned)__builtin_amdgcn_readfirstlane(__hip_atomic_load(fl, __ATOMIC_RELAXED, __HIP_MEMORY_SCOPE_AGENT)) < 8u) { __builtin_amdgcn_s_sleep(2); if (++spins > (1u << 22)) break; }
            asm volatile("" ::: "memory");
#pragma unroll
            for (int q = 0; q < 16; ++q) { const u32x4 w = __builtin_amdgcn_raw_buffer_load_b128(rs_in, (q * 512 + tid) * 16, 0, 16);
                acc[q >> 3][(q >> 2) & 1][q & 3][0] = (f32x4){__builtin_bit_cast(float, w.x << 16), __builtin_bit_cast(float, w.x & 0xffff0000u), __builtin_bit_cast(float, w.y << 16), __builtin_bit_cast(float, w.y & 0xffff0000u)};
                acc[q >> 3][(q >> 2) & 1][q & 3][1] = (f32x4){__builtin_bit_cast(float, w.z << 16), __builtin_bit_cast(float, w.z & 0xffff0000u), __builtin_bit_cast(float, w.w << 16), __builtin_bit_cast(float, w.w & 0xffff0000u)}; }
        } else {
#pragma unroll
            for (int a = 0; a < 2; ++a)
#pragma unroll
                for (int b = 0; b < 2; ++b)
#pragma unroll
                    for (int m = 0; m < 4; ++m)
#pragma unroll
                        for (int n = 0; n < 2; ++n) acc[a][b][m][n] = (f32x4){0.f, 0.f, 0.f, 0.f};
        }
        const int nk = cur.nk, kb = cur.kb;
        for (int t = 0; t < nk; t += 2) {
            const bool last = (t == nk - 2); const int T = kb + t;
            const char* a1 = PG8_KA(cur, T) + kstep;
            const char* a2 = last ? (has_next ? PG8_KA(nxt, nxt.kb) : PG8_KA(cur, kb)) : PG8_KA(cur, T + 2);
            const char* b2 = last ? (has_next ? PG8_KB(nxt, nxt.kb) : PG8_KB(cur, kb)) : PG8_KB(cur, T + 2);
            const char* a3 = a2 + kstep; const char* b3 = b2 + kstep;
            PG8_LDB(B0, 0, 0); PG8_LDB(B1, 0, 1); PG8_SCHED; PG8_LDA(At, 0, 0); PG8_STAGE(PG8_SA(1, 1), a1 + hstep, voffA);
            PG8_WAIT_V(8); PG8_WAIT_L(0); PG8_BAR; PG8_MMA(0, 0, At, B0); PG8_MMA(0, 1, At, B1); PG8_BAR; PG8_SCHED;
            if constexpr (Epi::NEED_RSTD) { if (t == 0) { E.prefetch(cur, wid); PG8_SCHED; } }
            PG8_LDA(At, 0, 1); PG8_STAGE(PG8_SB(0, 0), b2, voffB); PG8_STAGE(PG8_SB(0, 1), b2 + hstep, voffB); PG8_STAGE(PG8_SA(0, 0), a2, voffA);
            PG8_WAIT_V(8); PG8_WAIT_L(0); PG8_BAR; PG8_MMA(1, 0, At, B0); PG8_MMA(1, 1, At, B1); PG8_BAR; PG8_SCHED;
            PG8_LDB(B0, 1, 0); PG8_LDB(B1, 1, 1); PG8_SCHED; PG8_LDA(At, 1, 0); PG8_STAGE(PG8_SA(0, 1), a2 + hstep, voffA);
            PG8_WAIT_V(8); PG8_WAIT_L(0); PG8_BAR; PG8_MMA(0, 0, At, B0); PG8_MMA(0, 1, At, B1); PG8_BAR; PG8_SCHED;
            PG8_LDA(At, 1, 1); PG8_STAGE(PG8_SB(1, 0), b3, voffB); PG8_STAGE(PG8_SB(1, 1), b3 + hstep, voffB); PG8_STAGE(PG8_SA(1, 0), a3, voffA);
            PG8_WAIT_V(8); PG8_WAIT_L(0); PG8_BAR; PG8_MMA(1, 0, At, B0); PG8_MMA(1, 1, At, B1); PG8_BAR; PG8_SCHED;
        }
        if (wr == 0) PG8_BAR;
        if constexpr (Epi::KSPLIT > 0) { if (cur.flags & (4 | 16)) E.mid(acc, cur, wr, wc, fr, fq); }
        if (!Sched::WHOLE && (cur.flags & 4)) {   }
        else if (!Sched::WHOLE && (cur.flags & 2)) {
            const __amdgpu_buffer_rsrc_t rs_out = __builtin_amdgcn_make_buffer_rsrc((void*)(io.slots + (size_t)io.me * 131072), 0, 131072, 0x00020000);
#pragma unroll
            for (int q = 0; q < 16; ++q) { const f32x4 v0 = acc[q >> 3][(q >> 2) & 1][q & 3][0], v1 = acc[q >> 3][(q >> 2) & 1][q & 3][1];
                u32x4 w; w.x = cvt_pk_bf16(v0[0], v0[1]); w.y = cvt_pk_bf16(v0[2], v0[3]); w.z = cvt_pk_bf16(v1[0], v1[1]); w.w = cvt_pk_bf16(v1[2], v1[3]);
                if (io.same_next) __builtin_amdgcn_raw_buffer_store_b128(w, rs_out, (q * 512 + tid) * 16, 0, 0);
                else __builtin_amdgcn_raw_buffer_store_b128(w, rs_out, (q * 512 + tid) * 16, 0, 16); }
            asm volatile("s_waitcnt vmcnt(0)" ::: "memory");
            if (lane == 0) __hip_atomic_fetch_add(io.flags + (size_t)io.me * 64, 1u, __ATOMIC_RELAXED, __HIP_MEMORY_SCOPE_AGENT);
        } else E(acc, cur, wr, wc, fr, fq);
        if (!has_next) break;
        cur = nxt; ++ui;
        if (wr == 1) PG8_BAR;
    }
    PG8_WAIT_V(0);
    PG8_BAR;
#undef PG8_SA
#undef PG8_SB
#undef PG8_STAGE
#undef PG8_LDA
#undef PG8_LDB
#undef PG8_MMA
#undef PG8_WAIT_V
#undef PG8_WAIT_L
#undef PG8_BAR
#undef PG8_SCHED
#undef PG8_KA
#undef PG8_KB
}
}

using pg8::bf16_t; using pg8::f32x4; using pg8::u32x4; using pg8::Unit; using pg8::cvt_pk_bf16;
__device__ __forceinline__ unsigned cvt_pk_bf16_pin(float lo, float hi) { unsigned r; asm volatile("v_cvt_pk_bf16_f32 %0, %1, %2" : "=v"(r) : "v"(lo), "v"(hi)); return r; }
#define GAS __attribute__((address_space(1)))
#define LAS __attribute__((address_space(3)))
typedef unsigned u32x2 __attribute__((ext_vector_type(2)));
typedef float f32x2 __attribute__((ext_vector_type(2)));
#define LDS_WAIT() asm volatile("s_waitcnt lgkmcnt(0)" ::: "memory")
#define VM_WAIT() asm volatile("s_waitcnt vmcnt(0)" ::: "memory")

__device__ __forceinline__ float bf_lo(unsigned w) { return __builtin_bit_cast(float, w << 16); }
__device__ __forceinline__ float bf_hi(unsigned w) { return __builtin_bit_cast(float, w & 0xffff0000u); }
__device__ __forceinline__ float sigmoid_fast(float x) { return __builtin_amdgcn_rcpf(1.0f + __builtin_amdgcn_exp2f(-1.4426950408889634f * x)); }
template <int M> __device__ __forceinline__ float swz_xor(float v) { return __builtin_bit_cast(float, __builtin_amdgcn_ds_swizzle(__builtin_bit_cast(int, v), 0x1f | (M << 10))); }
__device__ __forceinline__ float sum_xor32(float v) { const unsigned b = __builtin_bit_cast(unsigned, v); auto r = __builtin_amdgcn_permlane32_swap(b, b, false, false); return __builtin_bit_cast(float, (unsigned)r[0]) + __builtin_bit_cast(float, (unsigned)r[1]); }
__device__ __forceinline__ float sum_fq(float v) { v += swz_xor<16>(v); return sum_xor32(v); }
__device__ __forceinline__ float wave_sum(float v) { v += swz_xor<1>(v); v += swz_xor<2>(v); v += swz_xor<4>(v); v += swz_xor<8>(v); v += swz_xor<16>(v); return sum_xor32(v); }

__device__ __forceinline__ float sum2_swap32(float a, float b) { auto r = __builtin_amdgcn_permlane32_swap(__builtin_bit_cast(unsigned, a), __builtin_bit_cast(unsigned, b), false, false); return __builtin_bit_cast(float, (unsigned)r[0]) + __builtin_bit_cast(float, (unsigned)r[1]); }
__device__ __forceinline__ float sum2_swap16(float a, float b) { auto r = __builtin_amdgcn_permlane16_swap(__builtin_bit_cast(unsigned, a), __builtin_bit_cast(unsigned, b), false, false); return __builtin_bit_cast(float, (unsigned)r[0]) + __builtin_bit_cast(float, (unsigned)r[1]); }
__device__ __forceinline__ float reduce48(const float (&v)[48], int lane) {
    float w[32];
#pragma unroll
    for (int i = 0; i < 32; ++i) w[i] = sum2_swap32(v[i], i + 32 < 48 ? v[i + 32] : 0.f);
    float x[16];
#pragma unroll
    for (int i = 0; i < 16; ++i) x[i] = sum2_swap16(w[i], w[i + 16]);
    float y[8]; const bool b8 = (lane & 8) != 0;
#pragma unroll
    for (int i = 0; i < 8; ++i) { const float keep = b8 ? x[i + 8] : x[i], send = b8 ? x[i] : x[i + 8]; y[i] = keep + swz_xor<8>(send); }
    float z[4]; const bool b4 = (lane & 4) != 0;
#pragma unroll
    for (int i = 0; i < 4; ++i) { const float keep = b4 ? y[i + 4] : y[i], send = b4 ? y[i] : y[i + 4]; z[i] = keep + swz_xor<4>(send); }
    float q[2]; const bool b2 = (lane & 2) != 0;
#pragma unroll
    for (int i = 0; i < 2; ++i) { const float keep = b2 ? z[i + 2] : z[i], send = b2 ? z[i] : z[i + 2]; q[i] = keep + swz_xor<2>(send); }
    const bool b1 = (lane & 1) != 0; const float keep = b1 ? q[1] : q[0], send = b1 ? q[0] : q[1];
    return keep + swz_xor<1>(send);
}

constexpr size_t MiB = 1u << 20;
constexpr size_t ACT_BYTES = (size_t)MPAD * D * 2;
constexpr size_t WS_CTL = 0, CTL_ZERO_BYTES = 1 * MiB;
constexpr size_t WS_XCCTAB = 32 * 1024;
constexpr size_t WS_SKFLAG = 64 * 1024;
static_assert(WS_SKFLAG + (size_t)10 * 256 * 256 <= CTL_ZERO_BYTES, "ctl map");
constexpr size_t SSQ_ONE = (size_t)16 * MPAD * 4;
constexpr size_t WS_SSQ = 1 * MiB;
constexpr size_t WS_HALOA = WS_SSQ + 5 * SSQ_ONE;
constexpr size_t WS_HALOB = WS_HALOA + (size_t)2 * NSTREAM * 30 * D * 2;
constexpr size_t WS_W0 = 10 * MiB;
constexpr size_t W_IN_B = (size_t)NIN * D * 2, W_AB_B = (size_t)2 * D * D * 2, W_O_B = (size_t)D * D * 2, W_GU_B = (size_t)NGU * D * 2, W_D_B = (size_t)D * DH * 2;
constexpr size_t WS_W0_IN = WS_W0, WS_W0_AB = WS_W0_IN + W_IN_B, WS_W0_O = WS_W0_AB + W_AB_B, WS_W0_GU = WS_W0_O + W_O_B, WS_W0_D = WS_W0_GU + W_GU_B, WS_W0_END = WS_W0_D + W_D_B;
constexpr size_t WS_W1_AB = WS_W0_END, WS_W1_O = WS_W1_AB + W_AB_B, WS_W1_END = WS_W1_O + W_O_B;
constexpr size_t WS_H = 53 * MiB;
constexpr size_t WS_UA = 86 * MiB, WS_ZB = WS_UA + ACT_BYTES, WS_BB = WS_ZB + ACT_BYTES, WS_SGA = WS_BB + ACT_BYTES, WS_SGB = WS_SGA + ACT_BYTES, WS_END = WS_SGB + ACT_BYTES;
constexpr size_t WS_F = WS_UA;
static_assert(WS_HALOB + (size_t)2 * NSTREAM * 2 * D * 2 <= WS_W0, "ws map: small buffers");
static_assert(WS_W1_END <= WS_H && WS_H + ACT_BYTES <= WS_UA && WS_END + SSQ_ONE <= 256 * MiB, "ws map (a dummy ssq set for timing probes sits at WS_END)");
static_assert(WS_F + (size_t)MPAD * DH * 2 <= WS_SGA, "F overlay");
constexpr size_t DO_CA = 0, DO_W1_IN = ACT_BYTES, DO_W1_GU = DO_W1_IN + W_IN_B, DO_W1_D = DO_W1_GU + W_GU_B, DO_END = DO_W1_D + W_D_B;
static_assert(DO_END <= (size_t)NPROMPT * 2048 * D * 4, "d_out scratch must stay inside the y_prompt region");
constexpr size_t OUT_YP = 0, OUT_YS = OUT_YP + (size_t)NPROMPT * 2048 * D, OUT_NAP = OUT_YS + (size_t)NSAMP * TS * D, OUT_NBP = OUT_NAP + (size_t)2 * NPROMPT * 30 * D,
                 OUT_NAS = OUT_NBP + (size_t)2 * NPROMPT * 2 * D, OUT_NBS = OUT_NAS + (size_t)2 * NSAMP * 30 * D, OUT_TOTAL = OUT_NBS + (size_t)2 * NSAMP * 2 * D;

constexpr int RING_BYTES = 131072, RSTD_OFF = RING_BYTES, RSTD_PITCH = 1040  , LDSCTL_OFF = RSTD_OFF + 16 * RSTD_PITCH, LDS_BYTES = 149504;

#define XB_TMO      128
#define XB_XCNT(j)  (256  + 64 * (j))
#define XB_XSUB(j)  (1280 + 64 * (j))
#define XB_XGEN(j)  (2304 + 64 * (j))
#define XB_TOP      3328
#define XB_TOPGEN   3392
#define XCD_BAR_WORDS 3456
#define XB_SPIN_CAP (1u << 18)
__device__ __forceinline__ unsigned xb_ld(unsigned* p)              { return __hip_atomic_load(p, __ATOMIC_RELAXED, __HIP_MEMORY_SCOPE_AGENT); }
__device__ __forceinline__ unsigned xb_add(unsigned* p, unsigned v) { return __hip_atomic_fetch_add(p, v, __ATOMIC_RELAXED, __HIP_MEMORY_SCOPE_AGENT); }
__device__ __forceinline__ unsigned xb_xcc_id() { return (unsigned)__builtin_amdgcn_s_getreg((3 << 11) | 20) & 0xFu; }
#define XB_SPIN(cond, bar) do { unsigned _sp = 0; while (cond) { __builtin_amdgcn_s_sleep(1); \
    if ((++_sp & 255u) == 0u) { if (xb_ld(&(bar)[XB_TMO])) break; if (_sp > XB_SPIN_CAP) { atomicAdd(&(bar)[XB_TMO], 1u); break; } } } } while (0)
struct XcdBarrier { unsigned* bar; unsigned x; volatile LAS unsigned* st; };
__device__ __forceinline__ XcdBarrier xcd_barrier_post(unsigned* bar, volatile LAS unsigned* st) {
    XcdBarrier b; b.bar = bar; b.x = xb_xcc_id(); b.st = st;
    if (threadIdx.x == 0) { const unsigned old = xb_add(&bar[XB_XCNT(b.x)], 1u); st[2] = (old == 0u) ? 1u : 0u; }
    return b;
}
__device__ __forceinline__ void xcd_barrier_complete(unsigned* bar, unsigned x, unsigned& nloc, unsigned& nx) {
    const unsigned G = gridDim.x * gridDim.y * gridDim.z;
    unsigned sum, cnt, mine, sp = 0u;
    for (;;) {
        sum = 0u; cnt = 0u; mine = 0u;
#pragma unroll
        for (unsigned j = 0; j < 16; ++j) { const unsigned c = xb_ld(&bar[XB_XCNT(j)]); sum += c; cnt += (c > 0u) ? 1u : 0u; mine = (j == x) ? c : mine; }
        if (sum == G) break;
        __builtin_amdgcn_s_sleep(1);
        if ((++sp & 255u) == 0u) { if (xb_ld(&bar[XB_TMO])) break; if (sp > XB_SPIN_CAP) { atomicAdd(&bar[XB_TMO], 1u); break; } }
    }
    nloc = mine > 0u ? mine : 1u; nx = cnt > 0u ? cnt : 1u;
}
__device__ __forceinline__ void xcd_barrier(const XcdBarrier& b, const int wave) {
    asm volatile("s_waitcnt vmcnt(0)" ::: "memory");
    __syncthreads();
    if (wave == 0 && lane_id() == 0) {
        unsigned* bar = b.bar;
        __builtin_amdgcn_s_waitcnt(0);
        unsigned nloc = b.st[0], nx = b.st[1];
        if (nloc == 0u) { xcd_barrier_complete(bar, b.x, nloc, nx); b.st[0] = nloc; b.st[1] = nx; }
        const unsigned k = b.st[3] + 1u; b.st[3] = k;
        __builtin_amdgcn_fence(__ATOMIC_ACQUIRE, "agent");
        asm volatile("s_waitcnt vmcnt(0)" ::: "memory");
        if (b.st[2] == 0u) {
            (void)__hip_atomic_fetch_add(&bar[XB_XSUB(b.x)], 1u, __ATOMIC_RELAXED, __HIP_MEMORY_SCOPE_AGENT);
        } else {
            const unsigned want = (nloc - 1u) * k;
            XB_SPIN(xb_ld(&bar[XB_XSUB(b.x)]) < want, bar);
            __builtin_amdgcn_fence(__ATOMIC_RELEASE, "agent");
            asm volatile("s_waitcnt vmcnt(0)" ::: "memory");
            (void)__hip_atomic_fetch_add(&bar[XB_TOP], 1u, __ATOMIC_RELAXED, __HIP_MEMORY_SCOPE_AGENT);
        }
        const unsigned want_top = nx * k;
        XB_SPIN(xb_ld(&bar[XB_TOP]) < want_top, bar);
        asm volatile("s_waitcnt vmcnt(0)" ::: "memory");
    }
    __syncthreads();
}


__device__ __forceinline__ void sigmoid8(const float (&x)[8], float (&s)[8]) {
    float e[8];
#pragma unroll
    for (int k = 0; k < 8; ++k) e[k] = __builtin_amdgcn_exp2f(-1.4426950408889634f * x[k]);
#pragma unroll
    for (int k = 0; k < 8; ++k) e[k] = 1.0f + e[k];
#pragma unroll
    for (int k = 0; k < 8; ++k) s[k] = __builtin_amdgcn_rcpf(e[k]);
}
__device__ __forceinline__ void load_rstd(const LAS unsigned char* rl, int wr, int fr, int fq, float (&rs)[2][4]) {
    const LAS float* p = (const LAS float*)(rl + fq * 4 * RSTD_PITCH) + wr * 64 + fr;
#pragma unroll
    for (int ai = 0; ai < 2; ++ai)
#pragma unroll
        for (int m = 0; m < 4; ++m) {
            float s = 0.f;
#pragma unroll
            for (int j = 0; j < 4; ++j) s += p[j * (RSTD_PITCH / 4) + ai * 128 + m * 16];
            s = sum_fq(s);
            rs[ai][m] = 1.0f / sqrtf(s * (1.0f / D) + RMS_EPS);
        }
}
struct RstdPrefetch {
    static constexpr bool NEED_RSTD = true;
    const float* ssq; LAS unsigned char* rl;
    __device__ __forceinline__ void prefetch(const Unit& u, int wid) const {
        const unsigned lo = (unsigned)lane_id() * 16u;
#pragma unroll
        for (int i = 0; i < 2; ++i) { const int j = wid * 2 + i;
            __builtin_amdgcn_global_load_lds((const unsigned*)((const char*)ssq + ((size_t)j * MPAD + (size_t)u.pm * 256) * 4 + lo), (LAS unsigned*)(rl + j * RSTD_PITCH), 16, 0, 0); }
    }
};
struct Epi1 : RstdPrefetch {
    static constexpr int KSPLIT = 0;
    bf16_t* ACT5;
    static __device__ __forceinline__ f32x2 pr(const f32x4 (&acc)[2][2][4][2], int ai, int bj, int m, int q) { return (f32x2){acc[ai][bj][m][q >> 1][(2 * q) & 3], acc[ai][bj][m][q >> 1][(2 * q + 1) & 3]}; }
    __device__ __forceinline__ void operator()(const f32x4 (&acc)[2][2][4][2], const Unit& u, int wr, int wc, int fr, int fq) const {
        asm volatile("" : "+v"(fr), "+v"(fq));
        const int row0 = u.pm * 256 + wr * 64 + fr;
        float rs[2][4]; load_rstd(rl, wr, fr, fq, rs);
        const int pn = u.pn;
        if (pn < 16) {
            bf16_t* O = ACT5 + (size_t)(pn >> 3) * ((size_t)MPAD * D) + (pn & 7) * 128 + wc * 32 + 8 * fq;
            if (pn < 8) {
#pragma unroll
                for (int ai = 0; ai < 2; ++ai)
#pragma unroll
                    for (int m = 0; m < 4; ++m) { const float r = rs[ai][m], rn = r * -1.4426950408889634f;
                        f32x2 e[4]; unsigned wq[4];
#pragma unroll
                        for (int q = 0; q < 4; ++q) { const f32x2 t = pr(acc, ai, 1, m, q) * rn; e[q] = (f32x2){__builtin_amdgcn_exp2f(t.x), __builtin_amdgcn_exp2f(t.y)}; }
#pragma unroll
                        for (int q = 0; q < 4; ++q) { const f32x2 d = e[q] + 1.0f; const f32x2 s = {__builtin_amdgcn_rcpf(d.x), __builtin_amdgcn_rcpf(d.y)}; const f32x2 o = (pr(acc, ai, 0, m, q) * r) * s; wq[q] = cvt_pk_bf16(o.x, o.y); }
                        u32x4 w; w.x = wq[0]; w.y = wq[1]; w.z = wq[2]; w.w = wq[3];
                        *(u32x4*)(O + (size_t)(row0 + ai * 128 + m * 16) * D) = w; }
            } else {
#pragma unroll
                for (int ai = 0; ai < 2; ++ai)
#pragma unroll
                    for (int m = 0; m < 4; ++m) { const float r2 = rs[ai][m] * rs[ai][m]; unsigned wq[4];
#pragma unroll
                        for (int q = 0; q < 4; ++q) { const f32x2 o = (pr(acc, ai, 0, m, q) * pr(acc, ai, 1, m, q)) * r2; wq[q] = cvt_pk_bf16(o.x, o.y); }
                        u32x4 w; w.x = wq[0]; w.y = wq[1]; w.z = wq[2]; w.w = wq[3];
                        *(u32x4*)(O + (size_t)(row0 + ai * 128 + m * 16) * D) = w; }
            }
        } else if (pn < 20) {
            bf16_t* O = ACT5 + (size_t)2 * ((size_t)MPAD * D) + (pn - 16) * 256 + wc * 32 + 8 * fq;
#pragma unroll
            for (int ai = 0; ai < 2; ++ai)
#pragma unroll
                for (int m = 0; m < 4; ++m) { const float r = rs[ai][m];
#pragma unroll
                    for (int bj = 0; bj < 2; ++bj) { unsigned wq[4];
#pragma unroll
                        for (int q = 0; q < 4; ++q) { const f32x2 o = pr(acc, ai, bj, m, q) * r; wq[q] = cvt_pk_bf16(o.x, o.y); }
                        u32x4 w; w.x = wq[0]; w.y = wq[1]; w.z = wq[2]; w.w = wq[3];
                        *(u32x4*)(O + (size_t)(row0 + ai * 128 + m * 16) * D + bj * 128) = w; } }
        } else {
            bf16_t* O = ACT5 + (size_t)3 * ((size_t)MPAD * D) + (pn - 20) * 128 + wc * 32 + 8 * fq;
#pragma unroll
            for (int ai = 0; ai < 2; ++ai)
#pragma unroll
                for (int m = 0; m < 4; ++m) { const float rn = rs[ai][m] * -1.4426950408889634f;
                    f32x2 ea[4], eb[4]; unsigned wo[4], ws_[4];
#pragma unroll
                    for (int q = 0; q < 4; ++q) { const f32x2 ta = pr(acc, ai, 0, m, q) * rn, tb = pr(acc, ai, 1, m, q) * rn;
                        ea[q] = (f32x2){__builtin_amdgcn_exp2f(ta.x), __builtin_amdgcn_exp2f(ta.y)}; eb[q] = (f32x2){fminf(__builtin_amdgcn_exp2f(tb.x), 1e30f), fminf(__builtin_amdgcn_exp2f(tb.y), 1e30f)}; }
#pragma unroll
                    for (int q = 0; q < 4; ++q) { const f32x2 da = ea[q] + 1.0f, db = eb[q] + 1.0f;
                        const f32x2 sa = {__builtin_amdgcn_rcpf(da.x), __builtin_amdgcn_rcpf(da.y)}, sb = {__builtin_amdgcn_rcpf(db.x), __builtin_amdgcn_rcpf(db.y)};
                        const f32x2 o = sa * db; wo[q] = cvt_pk_bf16(o.x, o.y); ws_[q] = cvt_pk_bf16(sb.x, sb.y); }
                    u32x4 w; w.x = wo[0]; w.y = wo[1]; w.z = wo[2]; w.w = wo[3];
                    *(u32x4*)(O + (size_t)(row0 + ai * 128 + m * 16) * D) = w;
                    w.x = ws_[0]; w.y = ws_[1]; w.z = ws_[2]; w.w = ws_[3];
                    *(u32x4*)(O + (size_t)MPAD * D + (size_t)(row0 + ai * 128 + m * 16) * D) = w; }
        }
    }
};
struct Epi2 {
    static constexpr int KSPLIT = 16; static constexpr bool NEED_RSTD = false;
    bf16_t* RT; const bf16_t* SGB; bf16_t* OUT;
    __device__ __forceinline__ void mid(f32x4 (&acc)[2][2][4][2], const Unit& u, int wr, int wc, int fr, int fq) const {
        const int row0 = u.pm * 256 + wr * 64 + fr; const size_t col0 = (size_t)u.pn * 256 + wc * 32 + 8 * fq;
#pragma unroll
        for (int ai = 0; ai < 2; ++ai)
#pragma unroll
            for (int m = 0; m < 4; ++m)
#pragma unroll
                for (int bj = 0; bj < 2; ++bj) { const u32x4 t = *(const u32x4*)(RT + (size_t)(row0 + ai * 128 + m * 16) * D + col0 + bj * 128);
#pragma unroll
                    for (int q = 0; q < 4; ++q) { acc[ai][bj][m][q >> 1][(2 * q) & 3] *= bf_lo(t[q]); acc[ai][bj][m][q >> 1][(2 * q + 1) & 3] *= bf_hi(t[q]); } }
    }
    __device__ __forceinline__ void operator()(const f32x4 (&acc)[2][2][4][2], const Unit& u, int wr, int wc, int fr, int fq) const {
        const int row0 = u.pm * 256 + wr * 64 + fr; const size_t col0 = (size_t)u.pn * 256 + wc * 32 + 8 * fq;
#pragma unroll
        for (int ai = 0; ai < 2; ++ai)
#pragma unroll
            for (int m = 0; m < 4; ++m)
#pragma unroll
                for (int bj = 0; bj < 2; ++bj) { const size_t off = (size_t)(row0 + ai * 128 + m * 16) * D + col0 + bj * 128;
                    const u32x4 s = *(const u32x4*)(SGB + off); float o[8];
#pragma unroll
                    for (int q = 0; q < 4; ++q) { o[2 * q] = bf_lo(s[q]) * acc[ai][bj][m][q >> 1][(2 * q) & 3]; o[2 * q + 1] = bf_hi(s[q]) * acc[ai][bj][m][q >> 1][(2 * q + 1) & 3]; }
                    u32x4 w; w.x = cvt_pk_bf16(o[0], o[1]); w.y = cvt_pk_bf16(o[2], o[3]); w.z = cvt_pk_bf16(o[4], o[5]); w.w = cvt_pk_bf16(o[6], o[7]);
                    *(u32x4*)(OUT + off) = w; }
    }
};
struct EpiRes {
    static constexpr int KSPLIT = 0; static constexpr bool NEED_RSTD = false;
    bf16_t* H; float* ssq_out; bf16_t* OUT;
    __device__ __forceinline__ void operator()(const f32x4 (&acc)[2][2][4][2], const Unit& u, int wr, int wc, int fr, int fq) const {
        const int row0 = u.pm * 256 + wr * 64 + fr; const size_t col0 = (size_t)u.pn * 256 + wc * 32 + 8 * fq;
#pragma unroll
        for (int ai = 0; ai < 2; ++ai)
#pragma unroll
            for (int m = 0; m < 4; ++m) { const int row = row0 + ai * 128 + m * 16; float sq = 0.f;
#pragma unroll
                for (int bj = 0; bj < 2; ++bj) { const size_t off = (size_t)row * D + col0 + bj * 128;
                    const u32x4 t = *(const u32x4*)(H + off); float o[8];
#pragma unroll
                    for (int q = 0; q < 4; ++q) { o[2 * q] = bf_lo(t[q]) + acc[ai][bj][m][q >> 1][(2 * q) & 3]; o[2 * q + 1] = bf_hi(t[q]) + acc[ai][bj][m][q >> 1][(2 * q + 1) & 3]; }
#pragma unroll
                    for (int q = 0; q < 8; ++q) sq += o[q] * o[q];
                    u32x4 w; w.x = cvt_pk_bf16(o[0], o[1]); w.y = cvt_pk_bf16(o[2], o[3]); w.z = cvt_pk_bf16(o[4], o[5]); w.w = cvt_pk_bf16(o[6], o[7]);
                    *(u32x4*)(OUT + off) = w; }
                sq = sum_fq(sq);
                if (fq == 0) ssq_out[(size_t)(u.pn * 4 + wc) * MPAD + row] = sq; }
    }
};
struct Epi4 : RstdPrefetch {
    static constexpr int KSPLIT = 0;
    bf16_t* F;
    __device__ __forceinline__ void operator()(const f32x4 (&acc)[2][2][4][2], const Unit& u, int wr, int wc, int fr, int fq) const {
        asm volatile("" : "+v"(fr), "+v"(fq));
        const int row0 = u.pm * 256 + wr * 64 + fr;
        float rs[2][4]; load_rstd(rl, wr, fr, fq, rs);
        bf16_t* O = F + u.pn * 128 + wc * 32 + 8 * fq;
#pragma unroll
        for (int ai = 0; ai < 2; ++ai)
#pragma unroll
            for (int m = 0; m < 4; ++m) {
                const float r = rs[ai][m], rn = r * -1.4426950408889634f, r2 = r * r;
                f32x2 e[4], p[4];
#pragma unroll
                for (int q = 0; q < 4; ++q) { const f32x2 g = {acc[ai][0][m][q >> 1][(2 * q) & 3], acc[ai][0][m][q >> 1][(2 * q + 1) & 3]}, up = {acc[ai][1][m][q >> 1][(2 * q) & 3], acc[ai][1][m][q >> 1][(2 * q + 1) & 3]};
                    const f32x2 t = g * rn; e[q] = (f32x2){__builtin_amdgcn_exp2f(t.x), __builtin_amdgcn_exp2f(t.y)}; p[q] = (g * up) * r2; }
                unsigned wq[4];
#pragma unroll
                for (int q = 0; q < 4; ++q) { const f32x2 d = e[q] + 1.0f; const f32x2 s = {__builtin_amdgcn_rcpf(d.x), __builtin_amdgcn_rcpf(d.y)}; const f32x2 o = p[q] * s; wq[q] = cvt_pk_bf16(o.x, o.y); }
                u32x4 w; w.x = wq[0]; w.y = wq[1]; w.z = wq[2]; w.w = wq[3];
                *(u32x4*)(O + (size_t)(row0 + ai * 128 + m * 16) * DH) = w; }
    }
};

struct Args { const float* in[20]; float* out; unsigned char* ws; int ph_lo, ph_hi; };
#define KAS __attribute__((address_space(4)))
typedef const KAS Args* KArgs;
__device__ __forceinline__ KArgs fresh(KArgs p) { asm volatile("" : "+s"(p)); return p; }

__device__ __forceinline__ unsigned f2bf(float f) { unsigned u = __builtin_bit_cast(unsigned, f); return (u + 0x7fffu + ((u >> 16) & 1u)) >> 16; }
__device__ __forceinline__ unsigned pk2(float lo, float hi) { return pg8::cvt_pk_bf16(lo, hi); }
constexpr int P0_SCR = 64 * 65 * 4;
struct WItem { const float* W; int K, N; bf16_t* WT; int dest_row0; const float* gk; int kb, nb; };
template <bool NT = false> __device__ __forceinline__ void p0_item_load(const WItem& d, int lane, f32x4 (&v)[16]) {
    const float* src = d.W + (size_t)(64 * d.kb + (lane >> 4)) * d.N + 64 * d.nb + 4 * (lane & 15);
#pragma unroll
    for (int i = 0; i < 16; ++i) { if constexpr (NT) v[i] = __builtin_nontemporal_load((const f32x4*)(src + (size_t)(4 * i) * d.N)); else v[i] = *(const f32x4*)(src + (size_t)(4 * i) * d.N); }
}
template <bool NT = false> __device__ __forceinline__ void p0_item_finish(const WItem& d, LAS float* scr, int lane, const f32x4 (&v)[16]) {
    const int k0 = 64 * d.kb, K = d.K;
    const int c = lane & 7;
    f32x4 g0 = (f32x4){1.f, 1.f, 1.f, 1.f}, g1 = g0;
    if (d.gk) { g0 = *(const f32x4*)(d.gk + k0 + 8 * c); g1 = *(const f32x4*)(d.gk + k0 + 8 * c + 4); }
#pragma unroll
    for (int i = 0; i < 16; ++i) { LAS float* q = scr + (4 * i + (lane >> 4)) * 65 + 4 * (lane & 15); q[0] = v[i][0]; q[1] = v[i][1]; q[2] = v[i][2]; q[3] = v[i][3]; }
    LDS_WAIT(); asm volatile("" ::: "memory");
#pragma unroll
    for (int j = 0; j < 8; ++j) { const int n = (lane >> 3) + 8 * j; const LAS float* s = scr + (8 * c) * 65 + n;
        u32x4 o; o.x = pk2(s[0 * 65] * g0[0], s[1 * 65] * g0[1]); o.y = pk2(s[2 * 65] * g0[2], s[3 * 65] * g0[3]); o.z = pk2(s[4 * 65] * g1[0], s[5 * 65] * g1[1]); o.w = pk2(s[6 * 65] * g1[2], s[7 * 65] * g1[3]);
        if constexpr (NT) __builtin_nontemporal_store(o, (u32x4*)(d.WT + (size_t)(d.dest_row0 + n) * K + k0 + 8 * c)); else *(u32x4*)(d.WT + (size_t)(d.dest_row0 + n) * K + k0 + 8 * c) = o; }
    LDS_WAIT(); asm volatile("" ::: "memory");
}
__device__ __forceinline__ void p0_transpose_item(const float* W, int K, int N, bf16_t* WT, int dest_row0, const float* gk, LAS float* scr, int kb, int nb, int lane) {
    const WItem d{W, K, N, WT, dest_row0, gk, kb, nb}; f32x4 v[16]; p0_item_load<true>(d, lane, v); p0_item_finish(d, scr, lane, v);
}
__device__ __forceinline__ int win_map(int n0) {
    const int seg = n0 >> 10, off = n0 & 1023, p = off >> 7, j = off & 127;
    switch (seg) { case 0: return 256 * p + j; case 1: return 256 * p + 128 + j; case 2: return 4096 + off; case 3: return 2048 + 256 * p + j; case 4: return 2048 + 256 * p + 128 + j; case 5: return 5120 + 256 * p + j; default: return 5120 + 256 * p + 128 + j; }
}
constexpr int I_IN = (D / 64) * (NIN / 64), I_SQ = (D / 64) * (D / 64), I_GU = (D / 64) * (DH / 64), I_DN = (DH / 64) * (D / 64), I_LAYER = I_IN + 3 * I_SQ + 2 * I_GU + I_DN;
__device__ __forceinline__ void p0_weight_item(KArgs ap, int l, int r, LAS float* scr, int lane) {
    struct { const float* in[20]; float* out; unsigned char* ws; } a; a.ws = ap->ws; a.out = ap->out;
#pragma unroll
    for (int i = 0; i < 19; ++i) a.in[i] = ap->in[i];
    unsigned char* ws = a.ws; unsigned char* dob = (unsigned char*)a.out;
    bf16_t* w_in_t = (bf16_t*)(l ? dob + DO_W1_IN : ws + WS_W0_IN); bf16_t* w_ab_t = (bf16_t*)(ws + (l ? WS_W1_AB : WS_W0_AB)); bf16_t* w_o_t = (bf16_t*)(ws + (l ? WS_W1_O : WS_W0_O));
    bf16_t* w_gu_t = (bf16_t*)(l ? dob + DO_W1_GU : ws + WS_W0_GU); bf16_t* w_d_t = (bf16_t*)(l ? dob + DO_W1_D : ws + WS_W0_D);
    if (r < I_IN) { const int nblk = NIN / 64, kb = r / nblk, nb = r % nblk; p0_transpose_item(a.in[6] + (size_t)l * D * NIN, D, NIN, w_in_t, win_map(64 * nb), a.in[5] + l * D, scr, kb, nb, lane); return; } r -= I_IN;
    if (r < I_SQ) { const int nblk = D / 64, kb = r / nblk, nb = r % nblk; p0_transpose_item(a.in[11] + (size_t)l * D * D, D, D, w_ab_t, 64 * nb, nullptr, scr, kb, nb, lane); return; } r -= I_SQ;
    if (r < I_SQ) { const int nblk = D / 64, kb = r / nblk, nb = r % nblk; p0_transpose_item(a.in[13] + (size_t)l * D * D, D, D, w_ab_t, D + 64 * nb, nullptr, scr, kb, nb, lane); return; } r -= I_SQ;
    if (r < I_SQ) { const int nblk = D / 64, kb = r / nblk, nb = r % nblk; p0_transpose_item(a.in[14] + (size_t)l * D * D, D, D, w_o_t, 64 * nb, nullptr, scr, kb, nb, lane); return; } r -= I_SQ;
    if (r < I_GU) { const int nblk = DH / 64, kb = r / nblk, nb = r % nblk, n0 = 64 * nb; p0_transpose_item(a.in[16] + (size_t)l * D * DH, D, DH, w_gu_t, 256 * (n0 >> 7) + (n0 & 127), a.in[15] + l * D, scr, kb, nb, lane); return; } r -= I_GU;
    if (r < I_GU) { const int nblk = DH / 64, kb = r / nblk, nb = r % nblk, n0 = 64 * nb; p0_transpose_item(a.in[17] + (size_t)l * D * DH, D, DH, w_gu_t, 256 * (n0 >> 7) + 128 + (n0 & 127), a.in[15] + l * D, scr, kb, nb, lane); return; } r -= I_GU;
    { const int nblk = D / 64, kb = r / nblk, nb = r % nblk; p0_transpose_item(a.in[18] + (size_t)l * DH * D, DH, D, w_d_t, 64 * nb, nullptr, scr, kb, nb, lane); }
}
__device__ __forceinline__ WItem p0_weight_desc(KArgs ap, int l, int r) {
    struct { const float* in[20]; float* out; unsigned char* ws; } a; a.ws = ap->ws; a.out = ap->out;
#pragma unroll
    for (int i = 0; i < 19; ++i) a.in[i] = ap->in[i];
    unsigned char* ws = a.ws; unsigned char* dob = (unsigned char*)a.out;
    bf16_t* w_in_t = (bf16_t*)(l ? dob + DO_W1_IN : ws + WS_W0_IN); bf16_t* w_ab_t = (bf16_t*)(ws + (l ? WS_W1_AB : WS_W0_AB)); bf16_t* w_o_t = (bf16_t*)(ws + (l ? WS_W1_O : WS_W0_O));
    bf16_t* w_gu_t = (bf16_t*)(l ? dob + DO_W1_GU : ws + WS_W0_GU); bf16_t* w_d_t = (bf16_t*)(l ? dob + DO_W1_D : ws + WS_W0_D);
    if (r < I_IN) { const int nblk = NIN / 64, kb = r / nblk, nb = r % nblk; return WItem{a.in[6] + (size_t)l * D * NIN, D, NIN, w_in_t, win_map(64 * nb), a.in[5] + l * D, kb, nb}; } r -= I_IN;
    if (r < I_SQ) { const int nblk = D / 64, kb = r / nblk, nb = r % nblk; return WItem{a.in[11] + (size_t)l * D * D, D, D, w_ab_t, 64 * nb, nullptr, kb, nb}; } r -= I_SQ;
    if (r < I_SQ) { const int nblk = D / 64, kb = r / nblk, nb = r % nblk; return WItem{a.in[13] + (size_t)l * D * D, D, D, w_ab_t, D + 64 * nb, nullptr, kb, nb}; } r -= I_SQ;
    if (r < I_SQ) { const int nblk = D / 64, kb = r / nblk, nb = r % nblk; return WItem{a.in[14] + (size_t)l * D * D, D, D, w_o_t, 64 * nb, nullptr, kb, nb}; } r -= I_SQ;
    if (r < I_GU) { const int nblk = DH / 64, kb = r / nblk, nb = r % nblk, n0 = 64 * nb; return WItem{a.in[16] + (size_t)l * D * DH, D, DH, w_gu_t, 256 * (n0 >> 7) + (n0 & 127), a.in[15] + l * D, kb, nb}; } r -= I_GU;
    if (r < I_GU) { const int nblk = DH / 64, kb = r / nblk, nb = r % nblk, n0 = 64 * nb; return WItem{a.in[17] + (size_t)l * D * DH, D, DH, w_gu_t, 256 * (n0 >> 7) + 128 + (n0 & 127), a.in[15] + l * D, kb, nb}; } r -= I_GU;
    { const int nblk = D / 64, kb = r / nblk, nb = r % nblk; return WItem{a.in[18] + (size_t)l * DH * D, DH, D, w_d_t, 64 * nb, nullptr, kb, nb}; }
}
constexpr int NW_G1 = 231  , NW_G4 = 242  , N_HELPERS = 256 - NW_G1, BG_ITEMS = (I_LAYER - I_IN) + I_LAYER, BG_A = I_LAYER - I_IN, BG_B = BG_A + I_IN, BG_C = BG_ITEMS - I_DN;
struct WgRole { bool compute; int cc, h, vnext; };
__device__ __forceinline__ WgRole wg_role(int vcu, int NW) {
    const int idle = 256 - NW, base = idle >> 3, extra = idle & 7, xq = vcu >> 5, xr = vcu & 31, hx = base + (xq < extra ? 1 : 0), before = base * xq + (xq < extra ? xq : extra);
    WgRole r; r.compute = xr < 32 - hx; r.cc = vcu - before; r.h = before + (xr - (32 - hx)); r.vnext = (xr + 1 < 32 - hx) ? vcu + 1 : (xq + 1) * 32; return r;
}
__device__ __forceinline__ void p0_background(KArgs ap, LAS unsigned char* lds, int h, int nh, int lo, int hi, int wave, int lane) {
    LAS float* scr = (LAS float*)(lds + wave * P0_SCR);
    int it = lo + h * 8 + wave; if (it >= hi) return;
    WItem cur = (it < I_LAYER - I_IN) ? p0_weight_desc(ap, 0, I_IN + it) : p0_weight_desc(ap, 1, it - (I_LAYER - I_IN));
    f32x4 va[16]; p0_item_load<true>(cur, lane, va);
    for (;;) {
        const int nit = it + nh * 8; const bool more = nit < hi;
        const int nr = more ? nit : it;
        const WItem nxt = (nr < I_LAYER - I_IN) ? p0_weight_desc(ap, 0, I_IN + nr) : p0_weight_desc(ap, 1, nr - (I_LAYER - I_IN));
        f32x4 vb[16];
        if (more) p0_item_load<true>(nxt, lane, vb);
        p0_item_finish<true>(cur, scr, lane, va);
        if (!more) break;
#pragma unroll
        for (int i = 0; i < 16; ++i) va[i] = vb[i];
        cur = nxt; it = nit;
    }
}
__device__ __forceinline__ void p0_prologue(KArgs ap, LAS unsigned char* lds, int gw, int NGW, int wave, int lane) {
    struct { const float* in[20]; float* out; unsigned char* ws; } a; a.ws = ap->ws; a.out = ap->out;
#pragma unroll
    for (int i = 0; i < 19; ++i) a.in[i] = ap->in[i];
    LAS float* scr = (LAS float*)(lds + wave * P0_SCR);
    unsigned char* ws = a.ws;
    for (int it = gw; it < (MK_N_LAUNCHES == 1 ? I_IN : 2 * I_LAYER); it += NGW) p0_weight_item(ap, it / I_LAYER, it % I_LAYER, scr, lane);
    bf16_t* H = (bf16_t*)(ws + WS_H); float* ssq0 = (float*)(ws + WS_SSQ);
    for (int row = gw; row < MPAD; row += NGW) {
        const float* src = nullptr;
        if (row < ROW_S0) { const int b = row / TP, t = row % TP; src = t < 16 ? a.in[4] + (size_t)t * D : a.in[0] + ((size_t)b * 2048 + (t - 16)) * D; }
        else if (row < MREAL) src = a.in[1] + (size_t)(row - ROW_S0) * D;
        float s = 0.f;
#pragma unroll
        for (int j = 0; j < 4; ++j) { f32x4 v = src ? __builtin_nontemporal_load((const f32x4*)(src + 256 * j + 4 * lane)) : (f32x4){0.f, 0.f, 0.f, 0.f};
            s += (v[0] * v[0] + v[1] * v[1]) + (v[2] * v[2] + v[3] * v[3]);
            u32x2 o; o.x = pk2(v[0], v[1]); o.y = pk2(v[2], v[3]); *(u32x2*)(H + (size_t)row * D + 256 * j + 4 * lane) = o; }
        s = wave_sum(s);
        if (lane < 16) ssq0[(size_t)lane * MPAD + row] = lane == 0 ? s : 0.f;
    }
    bf16_t* haloA = (bf16_t*)(ws + WS_HALOA); bf16_t* haloB = (bf16_t*)(ws + WS_HALOB);
    for (int it = gw; it < 2 * NSTREAM * 32; it += NGW) {
        const int l = it / (NSTREAM * 32), S = (it / 32) % NSTREAM, p = it % 32;
        const float* src = nullptr; bf16_t* dst;
        if (p < 30) { dst = haloA + ((size_t)(l * NSTREAM + S) * 30 + p) * D; if (S >= NPROMPT) src = a.in[2] + ((size_t)(l * NSAMP + (S - NPROMPT)) * 30 + p) * D; }
        else { dst = haloB + ((size_t)(l * NSTREAM + S) * 2 + (p - 30)) * D; if (S >= NPROMPT) src = a.in[3] + ((size_t)(l * NSAMP + (S - NPROMPT)) * 2 + (p - 30)) * D; }
#pragma unroll
        for (int j = 0; j < 4; ++j) { f32x4 v = src ? *(const f32x4*)(src + 256 * j + 4 * lane) : (f32x4){0.f, 0.f, 0.f, 0.f};
            u32x2 o; o.x = pk2(v[0], v[1]); o.y = pk2(v[2], v[3]); *(u32x2*)(dst + 256 * j + 4 * lane) = o; }
    }
}

static_assert(true, "");
constexpr int CR = 24, N_CONV_ITEMS = NPROMPT * (TP / CR) + NSAMP;
static_assert(TP % CR == 0, "conv chunking");
constexpr int CONV_STAGE_BYTES = (CR + 30) * 2048;
static_assert(CONV_STAGE_BYTES + 8 * CR * 2 * 4 + CR * 2 * 4 <= RING_BYTES, "conv LDS");
static_assert(8 * P0_SCR <= LDSCTL_OFF, "prologue LDS");
struct ConvItem { int S, t0, nrows; size_t rowS; };
__device__ __forceinline__ ConvItem conv_item(int it) {
    ConvItem ci;
    if (it < NPROMPT * (TP / CR)) { ci.S = it / (TP / CR); ci.t0 = (it % (TP / CR)) * CR; ci.nrows = CR; ci.rowS = (size_t)ci.S * TP; }
    else { ci.S = NPROMPT + (it - NPROMPT * (TP / CR)); ci.t0 = 0; ci.nrows = TS; ci.rowS = (size_t)ROW_S0 + (size_t)(ci.S - NPROMPT) * TS; }
    return ci;
}
__device__ __forceinline__ void conv_stage_a(LAS unsigned char* lds, const bf16_t* UA, const bf16_t* haloA_l, const ConvItem& ci, int wave, int lane) {
    const bf16_t* hA = haloA_l + (size_t)ci.S * 30 * D; const bf16_t* uS = UA + ci.rowS * D;
    for (int p = wave; p < 2 * (CR + 30); p += 8) { const int r = p >> 1, h = p & 1, tp = ci.t0 - 30 + r;
        const bf16_t* src = tp >= 0 ? uS + (size_t)tp * D : hA + (size_t)(30 + tp) * D;
        __builtin_amdgcn_global_load_lds((const unsigned*)((const char*)src + h * 1024 + lane * 16), (LAS unsigned*)(lds + r * 2048 + h * 1024), 16, 0, 2  ); }
}
__device__ __forceinline__ void conv_load_b(u32x4 (&zb)[8], u32x4 (&bb)[6], const bf16_t* ZB, const bf16_t* BB, const bf16_t* haloB_l, const ConvItem& ci, int cg, int rg) {
    const bf16_t* hB = haloB_l + (size_t)ci.S * 2 * D; const bf16_t* zS = ZB + ci.rowS * D; const int r0 = ci.t0 + 6 * rg;
    const bf16_t* z0p = r0 == 0 ? hB : zS + (size_t)(r0 - 2) * D; const bf16_t* z1p = r0 == 0 ? hB + D : zS + (size_t)(r0 - 1) * D;
    zb[0] = *(const u32x4*)(z0p + 8 * cg); zb[1] = *(const u32x4*)(z1p + 8 * cg);
    const bf16_t* zp = zS + (size_t)r0 * D + 8 * cg;
#pragma unroll
    for (int i = 0; i < 6; ++i) { zb[2 + i] = __builtin_nontemporal_load((const u32x4*)zp); zp += D; asm volatile("" : "+v"(zp)); }
    const bf16_t* bp = BB + (ci.rowS + r0) * D + 8 * cg;
#pragma unroll
    for (int i = 0; i < 6; ++i) { bb[i] = __builtin_nontemporal_load((const u32x4*)bp); bp += D; asm volatile("" : "+v"(bp)); }
}
__device__ __forceinline__ void conv_phase(KArgs ap, int l, LAS unsigned char* lds, int tid, int wave, int lane) {
    struct { const float* in[20]; float* out; unsigned char* ws; } a; a.ws = ap->ws; a.out = ap->out; a.in[2] = ap->in[2]; a.in[7] = ap->in[7]; a.in[8] = ap->in[8]; a.in[9] = ap->in[9]; a.in[10] = ap->in[10]; a.in[12] = ap->in[12];
    unsigned char* ws = a.ws;
    const bf16_t* UA = (const bf16_t*)(ws + WS_UA); const bf16_t* ZB = (const bf16_t*)(ws + WS_ZB); bf16_t* BB = (bf16_t*)(ws + WS_BB); bf16_t* CA = (bf16_t*)((unsigned char*)a.out + DO_CA);
    const bf16_t* haloA = (const bf16_t*)(ws + WS_HALOA) + (size_t)l * NSTREAM * 30 * D; const bf16_t* haloB = (const bf16_t*)(ws + WS_HALOB) + (size_t)l * NSTREAM * 2 * D;
    LAS float* red = (LAS float*)(lds + CONV_STAGE_BYTES);
    LAS float* fin = red + 8 * CR * 2;
    const LAS unsigned char* xl = lds + tid * 4;
    const int c0 = 2 * tid;
    const int cg = tid & 127, rg = tid >> 7;
    const float* cbw = a.in[12] + (size_t)l * 3 * D + 8 * cg;
    const f32x2 bias = *(const f32x2*)(a.in[8] + l * D + c0), lng = *(const f32x2*)(a.in[9] + l * D + c0), lnb = *(const f32x2*)(a.in[10] + l * D + c0);
    f32x4 wb[3][2];
#pragma unroll
    for (int k = 0; k < 3; ++k) { wb[k][0] = *(const f32x4*)(cbw + k * D); wb[k][1] = *(const f32x4*)(cbw + k * D + 4); }
    f32x2 w[31];
#define CONV_LOAD_TAPS() do { const float* wp = a.in[7] + (size_t)l * 31 * D + c0; asm volatile("" : "+v"(wp)); \
        _Pragma("unroll") for (int k = 0; k < 31; ++k) { w[k] = *(const f32x2*)wp; wp += D; asm volatile("" : "+v"(wp)); } } while (0)
    CONV_LOAD_TAPS();
    u32x4 zb[8], bb[6];
    int it = blockIdx.x; ConvItem ci = conv_item(it < N_CONV_ITEMS ? it : 0);
    __syncthreads();
    if (it < N_CONV_ITEMS) { conv_stage_a(lds, UA, haloA, ci, wave, lane); conv_load_b(zb, bb, ZB, BB, haloB, ci, cg, rg); }
    for (; it < N_CONV_ITEMS; it += gridDim.x) {
        VM_WAIT(); __syncthreads();
        f32x2 acc[CR];
#pragma unroll
        for (int i = 0; i < CR; ++i) acc[i] = bias;
#pragma unroll
        for (int j = 0; j < CR + 30; ++j) {
            const unsigned xw = *(const LAS unsigned*)(xl + j * 2048); const f32x2 xv = {bf_lo(xw), bf_hi(xw)};
#pragma unroll
            for (int i = (j - 30 > 0 ? j - 30 : 0); i <= (j < CR - 1 ? j : CR - 1); ++i) acc[i] = __builtin_elementwise_fma(w[j - i], xv, acc[i]);
            if ((j & 7) == 7) {
#pragma unroll
                for (int i = 0; i < CR; i += 4) asm volatile("" : "+v"(acc[i].x), "+v"(acc[i].y), "+v"(acc[i + 1].x), "+v"(acc[i + 1].y), "+v"(acc[i + 2].x), "+v"(acc[i + 2].y), "+v"(acc[i + 3].x), "+v"(acc[i + 3].y) :: "memory");
            }
        }
        { float pv[2 * CR];
#pragma unroll
          for (int i = 0; i < CR; ++i) { pv[2 * i] = acc[i].x + acc[i].y; pv[2 * i + 1] = acc[i].x * acc[i].x + acc[i].y * acc[i].y; }
          const float tot = reduce48(pv, lane);
          if (lane < 2 * CR) red[wave * 2 * CR + lane] = tot; }
#pragma unroll
        for (int j = 0; j < 6; ++j) if (6 * rg + j < ci.nrows) {
            unsigned o[4];
#pragma unroll
            for (int q = 0; q < 4; ++q) {
                const float c0v = wb[0][q >> 1][(2 * q) & 3] * bf_lo(zb[j][q]) + wb[1][q >> 1][(2 * q) & 3] * bf_lo(zb[j + 1][q]) + wb[2][q >> 1][(2 * q) & 3] * bf_lo(zb[j + 2][q]);
                const float c1v = wb[0][q >> 1][(2 * q + 1) & 3] * bf_hi(zb[j][q]) + wb[1][q >> 1][(2 * q + 1) & 3] * bf_hi(zb[j + 1][q]) + wb[2][q >> 1][(2 * q + 1) & 3] * bf_hi(zb[j + 2][q]);
                o[q] = cvt_pk_bf16_pin(bf_lo(bb[j][q]) * c0v, bf_hi(bb[j][q]) * c1v); }
            u32x4 w4; w4.x = o[0]; w4.y = o[1]; w4.z = o[2]; w4.w = o[3];
            __builtin_nontemporal_store(w4, (u32x4*)(BB + (ci.rowS + ci.t0 + 6 * rg + j) * D + 8 * cg)); }
        LDS_WAIT(); __syncthreads();
        const int nit = it + gridDim.x; const bool more = nit < N_CONV_ITEMS; const ConvItem cn = conv_item(more ? nit : it);
        if (more) conv_stage_a(lds, UA, haloA, cn, wave, lane);
        if (tid < CR) { float s1 = 0.f, s2 = 0.f;
#pragma unroll
            for (int wv = 0; wv < 8; ++wv) { s1 += red[(wv * CR + tid) * 2]; s2 += red[(wv * CR + tid) * 2 + 1]; }
            const float mean = s1 * (1.0f / D); float var = s2 * (1.0f / D) - mean * mean; var = var > 0.f ? var : 0.f;
            fin[tid * 2] = mean; fin[tid * 2 + 1] = 1.0f / sqrtf(var + LN_EPS); }
        LDS_WAIT(); __syncthreads();
#pragma unroll
        for (int i = 0; i < CR; ++i) if (i < ci.nrows) {
            const float mean = fin[i * 2], rstd = fin[i * 2 + 1];
            const float y0 = (acc[i].x - mean) * rstd * lng.x + lnb.x, y1 = (acc[i].y - mean) * rstd * lng.y + lnb.y;
            __builtin_nontemporal_store(cvt_pk_bf16_pin(y0 * sigmoid_fast(y0), y1 * sigmoid_fast(y1)), (unsigned*)(CA + (ci.rowS + ci.t0 + i) * D + c0)); }
        if (more) { conv_load_b(zb, bb, ZB, BB, haloB, cn, cg, rg); CONV_LOAD_TAPS(); }
        ci = cn;
    }
    VM_WAIT(); __syncthreads();
    for (int it = blockIdx.x; it < NSTREAM * 32; it += gridDim.x) {
        const int S = it / 32, p = it % 32; float* dst; f32x2 v;
        if (p < 30) {
            if (S < NPROMPT) { dst = a.out + OUT_NAP + ((size_t)(l * NPROMPT + S) * 30 + p) * D; const unsigned xw = *(const unsigned*)(UA + ((size_t)S * TP + (TP - 30) + p) * D + c0); v = (f32x2){bf_lo(xw), bf_hi(xw)}; }
            else { const int s = S - NPROMPT; dst = a.out + OUT_NAS + ((size_t)(l * NSAMP + s) * 30 + p) * D;
                if (p < 30 - TS) v = *(const f32x2*)(a.in[2] + ((size_t)(l * NSAMP + s) * 30 + TS + p) * D + c0);
                else { const unsigned xw = *(const unsigned*)(UA + ((size_t)ROW_S0 + (size_t)s * TS + (p - (30 - TS))) * D + c0); v = (f32x2){bf_lo(xw), bf_hi(xw)}; } }
        } else { const int q = p - 30;
            if (S < NPROMPT) { dst = a.out + OUT_NBP + ((size_t)(l * NPROMPT + S) * 2 + q) * D; const unsigned xw = *(const unsigned*)(ZB + ((size_t)S * TP + (TP - 2) + q) * D + c0); v = (f32x2){bf_lo(xw), bf_hi(xw)}; }
            else { const int s = S - NPROMPT; dst = a.out + OUT_NBS + ((size_t)(l * NSAMP + s) * 2 + q) * D; const unsigned xw = *(const unsigned*)(ZB + ((size_t)ROW_S0 + (size_t)s * TS + (TS - 2) + q) * D + c0); v = (f32x2){bf_lo(xw), bf_hi(xw)}; } }
        *(f32x2*)(dst + c0) = v;
    }
}

__device__ __forceinline__ void final_phase(KArgs ap, int gw, int NGW, int lane) {
    struct { const float* in[20]; float* out; unsigned char* ws; } a; a.ws = ap->ws; a.out = ap->out; a.in[19] = ap->in[19];
    const bf16_t* H = (const bf16_t*)(a.ws + WS_H); const float* ssq = (const float*)(a.ws + WS_SSQ + 4 * SSQ_ONE); const float* g = a.in[19];
    for (int row = gw; row < MREAL; row += NGW) {
        float* dst;
        if (row < ROW_S0) { const int b = row / TP, t = row % TP; if (t < 16) continue; dst = a.out + OUT_YP + ((size_t)b * 2048 + (t - 16)) * D; }
        else dst = a.out + OUT_YS + (size_t)(row - ROW_S0) * D;
        float s = lane < 16 ? ssq[(size_t)lane * MPAD + row] : 0.f; s = wave_sum(s);
        const float r = 1.0f / sqrtf(s * (1.0f / D) + RMS_EPS);
#pragma unroll
        for (int j = 0; j < 2; ++j) { const int c = 512 * j + 8 * lane; const u32x4 h = __builtin_nontemporal_load((const u32x4*)(H + (size_t)row * D + c));
            const f32x4 g0 = *(const f32x4*)(g + c), g1 = *(const f32x4*)(g + c + 4);
            f32x4 o0, o1; o0[0] = bf_lo(h.x) * r * g0[0]; o0[1] = bf_hi(h.x) * r * g0[1]; o0[2] = bf_lo(h.y) * r * g0[2]; o0[3] = bf_hi(h.y) * r * g0[3];
            o1[0] = bf_lo(h.z) * r * g1[0]; o1[1] = bf_hi(h.z) * r * g1[1]; o1[2] = bf_lo(h.w) * r * g1[2]; o1[3] = bf_hi(h.w) * r * g1[3];
            __builtin_nontemporal_store(o0, (f32x4*)(dst + c)); __builtin_nontemporal_store(o1, (f32x4*)(dst + c + 4)); }
    }
}

__global__ void __launch_bounds__(512, 2) mega_fwd(Args a_unused) {
    extern __shared__ __attribute__((aligned(16))) unsigned char lds_raw[];
    LAS unsigned char* lds = (LAS unsigned char*)lds_raw;
    const KArgs kp = (KArgs)__builtin_amdgcn_kernarg_segment_ptr();
    const int wave = __builtin_amdgcn_readfirstlane(threadIdx.x >> 6);
    const int G = gridDim.x, bx = blockIdx.x, vcu = (G % 8 == 0) ? (bx % 8) * (G / 8) + bx / 8 : bx;
    const int gw = vcu * 8 + wave, NGW = G * 8;
    volatile LAS unsigned* ctl = (volatile LAS unsigned*)(lds + LDSCTL_OFF);
    if (threadIdx.x < 64) ctl[threadIdx.x] = 0u;
    __syncthreads();
    XcdBarrier bar; bar.bar = (unsigned*)(kp->ws + WS_CTL); bar.x = 0; bar.st = nullptr;
    if (MK_N_LAUNCHES == 1) bar = xcd_barrier_post((unsigned*)(kp->ws + WS_CTL), ctl + 8);
    const unsigned my_xcc = xb_xcc_id();
    if (threadIdx.x == 0) __hip_atomic_store((unsigned*)(kp->ws + WS_XCCTAB) + vcu, my_xcc + 1u, __ATOMIC_RELAXED, __HIP_MEMORY_SCOPE_AGENT);
    const int lo = kp->ph_lo, hi = kp->ph_hi;
#define IN(k) (lo <= (k) && (k) < hi)
#define SEAM(k) do { if (IN(k) && IN((k) + 1)) xcd_barrier(bar, wave); } while (0)

    if (IN(0)) { for (int rep = 0; rep < REP_P0; ++rep) { p0_prologue(fresh(kp), lds, gw, NGW, wave, lane_id()); __syncthreads(); } SEAM(0); }

    const int same_next = (MK_N_LAUNCHES == 1 && vcu + 1 < G) ? (__builtin_amdgcn_readfirstlane(__hip_atomic_load((unsigned*)(kp->ws + WS_XCCTAB) + vcu + 1, __ATOMIC_RELAXED, __HIP_MEMORY_SCOPE_AGENT)) == my_xcc + 1u) : 0;
#pragma unroll 1
    for (int l = 0; l < 2; ++l) {
        const int pb = 1 + 6 * l;
        if (IN(pb + 0)) {
            const KArgs ap = fresh(kp); unsigned char* ws = ap->ws; unsigned char* dob = (unsigned char*)ap->out;
            const bf16_t* H = (const bf16_t*)(ws + WS_H); const bf16_t* w_in_t = (const bf16_t*)(l ? dob + DO_W1_IN : ws + WS_W0_IN);
            pg8::Gemm g{H, w_in_t, H, w_in_t}; pg8::StreamK<NIN / 256, D / 128, 0> S; S.init(vcu);
            Epi1 E{{(const float*)(ws + WS_SSQ + (size_t)(2 * l) * SSQ_ONE), lds + RSTD_OFF}, (bf16_t*)(ws + WS_UA)}; pg8::SlotIO io{dob + DO_CA, (unsigned*)(ws + WS_SKFLAG) + (size_t)(5 * l + 0) * 256 * 64, vcu, same_next};
            if (MK_N_LAUNCHES == 1) {
                const WgRole wr = wg_role(vcu, NW_G1);
                if (!wr.compute) p0_background(fresh(kp), lds, wr.h, N_HELPERS, l ? BG_B : 0, l ? BG_C : BG_A, wave, lane_id());
                else {
                    const KArgs ap2 = fresh(kp); unsigned char* ws2 = ap2->ws; unsigned char* dob2 = (unsigned char*)ap2->out;
                    const bf16_t* H2 = (const bf16_t*)(ws2 + WS_H); const bf16_t* w2 = (const bf16_t*)(l ? dob2 + DO_W1_IN : ws2 + WS_W0_IN);
                    const pg8::Gemm g2{H2, w2, H2, w2}; pg8::StreamK<NIN / 256, D / 128, 0, NW_G1> S2; S2.init(opaque_s(wr.cc));
                    const Epi1 E2{{(const float*)(ws2 + WS_SSQ + (size_t)(2 * l) * SSQ_ONE), lds + RSTD_OFF}, (bf16_t*)(ws2 + WS_UA)}; const pg8::SlotIO io2{dob2 + DO_CA, (unsigned*)(ws2 + WS_SKFLAG) + (size_t)(5 * l + 0) * 256 * 64, opaque_s(wr.cc), 0};
                    pg8::gemm_phase<Epi1, pg8::StreamK<NIN / 256, D / 128, 0, NW_G1>, D, 1 << 20>(lds, g2, S2, E2, io2, wave);
                }
            } else
            for (int rep = 0; rep < REP_G1; ++rep) pg8::gemm_phase<Epi1, pg8::StreamK<NIN / 256, D / 128, 0>, D, 1 << 20>(lds, g, S, E, io, wave);
            SEAM(pb + 0);
        }
        if (IN(pb + 1)) { const int l_ = lane_id(); conv_phase(fresh(kp), l, lds, wave * 64 + l_, wave, l_); SEAM(pb + 1); }
        if (IN(pb + 2)) {
            const KArgs ap = fresh(kp); unsigned char* ws = ap->ws; unsigned char* dob = (unsigned char*)ap->out;
            const bf16_t* w_ab_t = (const bf16_t*)(ws + (l ? WS_W1_AB : WS_W0_AB));
            pg8::Gemm g{(const bf16_t*)(dob + DO_CA), w_ab_t, (const bf16_t*)(ws + WS_BB), w_ab_t + (size_t)D * D}; pg8::StreamK<D / 256, 2 * D / 128, 16> S; S.init(vcu);
            Epi2 E{(bf16_t*)(ws + WS_SGA), (const bf16_t*)(ws + WS_SGB), (bf16_t*)(ws + WS_SGA)}; pg8::SlotIO io{ws + WS_UA, (unsigned*)(ws + WS_SKFLAG) + (size_t)(5 * l + 1) * 256 * 64, vcu, same_next};
            pg8::gemm_phase<Epi2, pg8::StreamK<D / 256, 2 * D / 128, 16>, D, 16>(lds, g, S, E, io, wave);
            SEAM(pb + 2);
        }
        if (IN(pb + 3)) {
            const KArgs ap = fresh(kp); unsigned char* ws = ap->ws;
            const bf16_t* MG = (const bf16_t*)(ws + WS_SGA); const bf16_t* w_o_t = (const bf16_t*)(ws + (l ? WS_W1_O : WS_W0_O));
            pg8::Gemm g{MG, w_o_t, MG, w_o_t}; pg8::StreamK<D / 256, D / 128, 0> S; S.init(vcu);
            EpiRes E{(bf16_t*)(ws + WS_H), (float*)(ws + WS_SSQ + (size_t)(2 * l + 1) * SSQ_ONE), (bf16_t*)(ws + WS_H)}; pg8::SlotIO io{ws + WS_UA, (unsigned*)(ws + WS_SKFLAG) + (size_t)(5 * l + 2) * 256 * 64, vcu, same_next};
            pg8::gemm_phase<EpiRes, pg8::StreamK<D / 256, D / 128, 0>, D, 1 << 20>(lds, g, S, E, io, wave);
            SEAM(pb + 3);
        }
        if (IN(pb + 4)) {
            const KArgs ap = fresh(kp); unsigned char* ws = ap->ws; unsigned char* dob = (unsigned char*)ap->out;
            const bf16_t* H = (const bf16_t*)(ws + WS_H); const bf16_t* w_gu_t = (const bf16_t*)(l ? dob + DO_W1_GU : ws + WS_W0_GU);
            pg8::Gemm g{H, w_gu_t, H, w_gu_t}; pg8::StreamK<NGU / 256, D / 128, 0> S; S.init(vcu);
            Epi4 E{{(const float*)(ws + WS_SSQ + (size_t)(2 * l + 1) * SSQ_ONE), lds + RSTD_OFF}, (bf16_t*)(ws + WS_F)}; pg8::SlotIO io{ws + WS_SGB, (unsigned*)(ws + WS_SKFLAG) + (size_t)(5 * l + 3) * 256 * 64, vcu, same_next};
            if (MK_N_LAUNCHES == 1) {
                const WgRole wr = wg_role(vcu, NW_G4);
                if (!wr.compute) p0_background(fresh(kp), lds, wr.h, 256 - NW_G4, l ? BG_C : BG_A, l ? BG_ITEMS : BG_B, wave, lane_id());
                else {
                    const KArgs ap2 = fresh(kp); unsigned char* ws2 = ap2->ws; unsigned char* dob2 = (unsigned char*)ap2->out;
                    const bf16_t* H2 = (const bf16_t*)(ws2 + WS_H); const bf16_t* w2 = (const bf16_t*)(l ? dob2 + DO_W1_GU : ws2 + WS_W0_GU);
                    const pg8::Gemm g2{H2, w2, H2, w2}; pg8::StreamK<NGU / 256, D / 128, 0, NW_G4> S2; S2.init(opaque_s(wr.cc));
                    const Epi4 E2{{(const float*)(ws2 + WS_SSQ + (size_t)(2 * l + 1) * SSQ_ONE), lds + RSTD_OFF}, (bf16_t*)(ws2 + WS_F)}; const pg8::SlotIO io2{ws2 + WS_SGB, (unsigned*)(ws2 + WS_SKFLAG) + (size_t)(5 * l + 3) * 256 * 64, opaque_s(wr.cc), 0};
                    pg8::gemm_phase<Epi4, pg8::StreamK<NGU / 256, D / 128, 0, NW_G4>, D, 1 << 20>(lds, g2, S2, E2, io2, wave);
                }
            } else
            for (int rep = 0; rep < REP_G4; ++rep) pg8::gemm_phase<Epi4, pg8::StreamK<NGU / 256, D / 128, 0>, D, 1 << 20>(lds, g, S, E, io, wave);
            SEAM(pb + 4);
        }
        if (IN(pb + 5)) {
            const KArgs ap = fresh(kp); unsigned char* ws = ap->ws; unsigned char* dob = (unsigned char*)ap->out;
            const bf16_t* F = (const bf16_t*)(ws + WS_F); const bf16_t* w_d_t = (const bf16_t*)(l ? dob + DO_W1_D : ws + WS_W0_D);
            pg8::Gemm g{F, w_d_t, F, w_d_t}; pg8::StreamK<D / 256, DH / 128, 0> S; S.init(vcu);
            EpiRes E{(bf16_t*)(ws + WS_H), (float*)(ws + WS_SSQ + (size_t)(2 * l + 2) * SSQ_ONE), (bf16_t*)(ws + WS_H)}; pg8::SlotIO io{ws + WS_SGB, (unsigned*)(ws + WS_SKFLAG) + (size_t)(5 * l + 4) * 256 * 64, vcu, same_next};
            pg8::gemm_phase<EpiRes, pg8::StreamK<D / 256, DH / 128, 0>, DH, 1 << 20>(lds, g, S, E, io, wave);
            SEAM(pb + 5);
        }
    }
    if (IN(13)) for (int rep = 0; rep < REP_FIN; ++rep) final_phase(fresh(kp), gw, NGW, lane_id());
#undef IN
#undef SEAM
}

extern "C" void kernel_launch(void* const* d_in, const int* in_sizes, int n_in, void* d_out, int out_size, void* d_ws, size_t ws_size, hipStream_t stream) {
    static int grid = 0;
    if (grid == 0) {
        if (n_in != 20 || (size_t)out_size != OUT_TOTAL || ws_size < WS_END) { fprintf(stderr, "kernel_launch: unexpected shapes (n_in %d, out %d, ws %zu); nothing launched\n", n_in, out_size, ws_size); grid = -1; return; }
        int dev = 0, cus = 0, per_cu = 0;
        if (hipGetDevice(&dev) != hipSuccess || hipDeviceGetAttribute(&cus, hipDeviceAttributeMultiprocessorCount, dev) != hipSuccess) { grid = -1; return; }
        if (hipFuncSetAttribute((const void*)mega_fwd, hipFuncAttributeMaxDynamicSharedMemorySize, LDS_BYTES) != hipSuccess) { fprintf(stderr, "kernel_launch: hipFuncSetAttribute failed\n"); grid = -1; return; }
        if (hipOccupancyMaxActiveBlocksPerMultiprocessor(&per_cu, (const void*)mega_fwd, 512, LDS_BYTES) != hipSuccess || per_cu < 1) { fprintf(stderr, "kernel_launch: occupancy query says %d blocks per CU\n", per_cu); per_cu = 1; }
        (void)hipGetLastError();
        if (cus != 256) { fprintf(stderr, "kernel_launch: built for a 256-CU device (got %d)\n", cus); grid = -1; return; }
        grid = cus;
    }
    if (grid < 0) return;
    if (hipMemsetAsync((char*)d_ws + WS_CTL, 0, CTL_ZERO_BYTES, stream) != hipSuccess) { fprintf(stderr, "kernel_launch: memset failed\n"); return; }
    Args a{};
    for (int i = 0; i < 20; ++i) a.in[i] = (const float*)d_in[i];
    a.out = (float*)d_out; a.ws = (unsigned char*)d_ws;
    for (int li = 0; li < MK_N_LAUNCHES; ++li) {
        a.ph_lo = (MK_N_LAUNCHES == 1) ? 0 : li; a.ph_hi = (MK_N_LAUNCHES == 1) ? NPHASE : li + 1;
        hipLaunchKernelGGL(mega_fwd, dim3(grid), dim3(512), LDS_BYTES, stream, a);
        const hipError_t le = hipPeekAtLastError();
        if (le != hipSuccess) { fprintf(stderr, "kernel_launch: launch %d failed: %s\n", li, hipGetErrorName(le)); break; }
    }
}
```

```cpp
#include <hip/hip_runtime.h>
#include <cstdio>
#include <cstdint>

#ifndef REP_P0
#define REP_P0 1
#endif
#ifndef REP_G1
#define REP_G1 1
#endif
#ifndef REP_G4
#define REP_G4 1
#endif
#ifndef REP_FIN
#define REP_FIN 1
#endif
#ifndef DRY_G2
#define DRY_G2 0
#endif
#ifndef DRY_G3
#define DRY_G3 0
#endif
#ifndef DRY_G5
#define DRY_G5 0
#endif
#ifndef MK_N_LAUNCHES
#define MK_N_LAUNCHES 1
#endif

constexpr int D = 1024, NIN = 7168, DH = 2816, NGU = 2 * DH;
constexpr int NPROMPT = 8, TP = 2064, NSAMP = 16, TS = 16, NSTREAM = NPROMPT + NSAMP;
constexpr int ROW_S0 = NPROMPT * TP;
constexpr int MREAL = ROW_S0 + NSAMP * TS;
constexpr int MPAD = 16896, NPAN = MPAD / 256;
static_assert(NPAN == 66, "StreamK assumes 66 row panels (a last group of two)");
constexpr float RMS_EPS = 1e-6f, LN_EPS = 1e-5f;
constexpr int NPHASE = 14;

__device__ __forceinline__ int opaque_v(int x) { asm volatile("" : "+v"(x)); return x; }
__device__ __forceinline__ int opaque_s(int x) { asm volatile("" : "+s"(x)); return x; }
__device__ __forceinline__ int lane_id() { int x; asm volatile("v_mbcnt_lo_u32_b32 %0, -1, 0\n\tv_mbcnt_hi_u32_b32 %0, -1, %0" : "=v"(x)); return x; }
namespace pg8 {
#define PG8_LAS __attribute__((address_space(3)))
typedef unsigned short bf16_t;
typedef short bf16x8 __attribute__((ext_vector_type(8)));
typedef float f32x4 __attribute__((ext_vector_type(4)));
typedef unsigned u32x4 __attribute__((ext_vector_type(4)));
constexpr int BM = 256, BK = 64, HALF = 128, HTB = HALF * BK * 2  , STAGE_BYTES = 8 * HTB, NXCD = 8, WGM = 8;

__host__ __device__ __forceinline__ int lds_byte(int r, int c) { const int st = (r >> 4) * 2 + (c >> 5), rr = r & 15, cc = c & 31, ob = rr * 64 + cc * 2; return st * 1024 + (ob ^ (((ob >> 9) & 1) << 5)); }
__host__ __device__ __forceinline__ void stage_rc(int b, int& R, int& C) { const int st = b / 1024, sb = b % 1024, swz = sb ^ (((sb >> 9) & 1) << 5); R = (st >> 1) * 16 + swz / 64; C = (st & 1) * 32 + (swz % 64) / 2; }
__host__ __device__ __forceinline__ int perm32(int rho) { const int n = rho >> 4, i = rho & 15; return 8 * (i >> 2) + 4 * n + (i & 3); }

struct Unit { int pm, pn, kb, nk, flags; };
struct Gemm { const bf16_t* A; const bf16_t* Bt; const bf16_t* A2; const bf16_t* Bt2; };
struct SlotIO { unsigned char* slots; unsigned* flags; int me; int same_next; };

template <int NN  , int P  , int KSPLIT  , int NW = 256  >
struct StreamK {
    static constexpr int nM = 66, nN = NN, NTILES = nM * nN, N_DP_ROUNDS = (NTILES / NW - 1) > 0 ? (NTILES / NW - 1) : 0, N_DP = NW * N_DP_ROUNDS;
    static constexpr bool WHOLE = (NTILES % NW == 0) && KSPLIT == 0;
    int c, t_first, o_s, t_last, o_e, has_head, has_tail, first_full, n_full;
    __device__ static int cut(int c) { return (int)((long)(NTILES - N_DP) * P * c / NW); }
    __device__ void init(int c_) {
        c = c_;
        const int s = cut(c), e = cut(c + 1);
        t_first = s / P; o_s = s % P; t_last = (e - 1) / P; o_e = e - t_last * P;
        has_tail = (o_s > 0 && e > s); has_head = (o_e < P && e > s && !(t_last == t_first && o_s > 0));
        first_full = has_tail ? t_first + 1 : t_first; const int last_full = has_head ? t_last - 1 : t_last; n_full = (e > s) ? last_full - first_full + 1 : 0; if (n_full < 0) n_full = 0;
    }
    __device__ static void tile_of(int t, Unit& u) { constexpr int nig = WGM * nN; const int gid = t / nig, fm = gid * WGM, r = t - gid * nig;
        if (nM - fm >= WGM) { u.pm = fm + (r & (WGM - 1)); u.pn = r / WGM; } else { u.pm = fm + (r & 1); u.pn = r >> 1; } }
    __device__ bool base(int i, Unit& u) const {
        if (has_head) { if (i == 0) { tile_of(N_DP + t_last, u); u.kb = 0; u.nk = 2 * o_e; u.flags = 2; return true; } --i; }
        if (i < N_DP_ROUNDS) { tile_of(NW * i + c, u); u.kb = 0; u.nk = 2 * P; u.flags = 0; return true; } i -= N_DP_ROUNDS;
        if (i < n_full) { tile_of(N_DP + first_full + i, u); u.kb = 0; u.nk = 2 * P; u.flags = 0; return true; } i -= n_full;
        if (has_tail && i == 0) { tile_of(N_DP + t_first, u); u.kb = 2 * o_s; u.nk = 2 * (P - o_s); u.flags = 1; return true; }
        return false;
    }
    mutable int it_i, it_second; mutable Unit it_u;
    __device__ void start() const { it_i = 0; it_second = 0; }
    __device__ bool advance(Unit& u) const {
        if constexpr (KSPLIT > 0) { if (it_second) { u = it_u; u.nk = it_u.kb + it_u.nk - KSPLIT; u.kb = KSPLIT; u.flags = 8 | (it_u.flags & 2); it_second = 0; return true; } }
        if (!base(it_i, u)) return false; ++it_i;
        if constexpr (KSPLIT > 0) {
            if (u.kb < KSPLIT && u.kb + u.nk > KSPLIT) { it_u = u; it_second = 1; u.nk = KSPLIT - u.kb; u.flags = (u.flags & 1) | 4; }
            else if (u.kb + u.nk == KSPLIT) u.flags |= 16;
        }
        return true;
    }
};

typedef __bf16 bf16x2_t __attribute__((ext_vector_type(2)));
typedef float f32x2_t __attribute__((ext_vector_type(2)));
__device__ __forceinline__ unsigned cvt_pk_bf16(float lo, float hi) { const f32x2_t v = {lo, hi}; const bf16x2_t r = __builtin_convertvector(v, bf16x2_t); return __builtin_bit_cast(unsigned, r); }

template <class Epi, class Sched, int KPITCH  , int KWRAP  >
__device__ __forceinline__ void gemm_phase(PG8_LAS unsigned char* lds, const Gemm g, const Sched& S, const Epi& E, const SlotIO io, const int wid_in  ) {
    const int wid = opaque_s(wid_in), lane = lane_id(), tid = wid * 64 + lane, wr = wid >> 2, wc = wid & 3, fr = lane & 15, fq = lane >> 4;
    constexpr int K = KPITCH;
    unsigned voffA[2], voffB[2];
#pragma unroll
    for (int i = 0; i < 2; ++i) { int R, C; stage_rc(tid * 16 + i * 8192, R, C); const int Rb = (R & ~31) + perm32(R & 31);
        voffA[i] = (unsigned)(R * K + C) * 2u; voffB[i] = (unsigned)(Rb * K + C) * 2u; }
    const size_t kstep = (size_t)(BK * 2);
    const size_t hstep = (size_t)HALF * K * 2;
    const size_t tstep = 2 * hstep;
    const unsigned ldsw = (unsigned)wid * 1024u;
    const int aoff = lds_byte(wr * 64 + fr, fq * 8), boff = lds_byte(wc * 32 + fr, fq * 8);
#define PG8_SA(b, h) (((b) * 2 + (h)) * HTB)
#define PG8_SB(b, h) ((4 + (b) * 2 + (h)) * HTB)
#define PG8_STAGE(bufoff, gbase, voff) do { _Pragma("unroll") for (int _i = 0; _i < 2; ++_i) \
        __builtin_amdgcn_global_load_lds((const unsigned*)((const char*)(gbase) + (voff)[_i]), (PG8_LAS unsigned*)(lds + (bufoff) + ldsw + _i * 8192), 16, 0, 0); } while (0)
#define PG8_LDA(dst, b, h) do { _Pragma("unroll") for (int m = 0; m < 4; ++m) _Pragma("unroll") for (int k = 0; k < 2; ++k) dst[m][k] = *(const PG8_LAS bf16x8*)(lds + PG8_SA(b, h) + aoff + m * 2048 + k * 1024); } while (0)
#define PG8_LDB(dst, b, h) do { _Pragma("unroll") for (int n = 0; n < 2; ++n) _Pragma("unroll") for (int k = 0; k < 2; ++k) dst[n][k] = *(const PG8_LAS bf16x8*)(lds + PG8_SB(b, h) + boff + n * 2048 + k * 1024); } while (0)
#define PG8_MMA(ai, bj, At, Bt) do { __builtin_amdgcn_s_setprio(1); _Pragma("unroll") for (int m = 0; m < 4; ++m) _Pragma("unroll") for (int n = 0; n < 2; ++n) _Pragma("unroll") for (int k = 0; k < 2; ++k) \
        acc[ai][bj][m][n] = __builtin_amdgcn_mfma_f32_16x16x32_bf16(Bt[n][k], At[m][k], acc[ai][bj][m][n], 0, 0, 0); __builtin_amdgcn_s_setprio(0); } while (0)
#define PG8_WAIT_V(n) asm volatile("s_waitcnt vmcnt(" #n ")" ::: "memory")
#define PG8_WAIT_L(n) asm volatile("s_waitcnt lgkmcnt(" #n ")" ::: "memory")
#define PG8_BAR __builtin_amdgcn_s_barrier()
#define PG8_SCHED __builtin_amdgcn_sched_barrier(0)
#define PG8_KA(u, T) ((const char*)(((T) < KWRAP) ? g.A : g.A2) + (size_t)(u).pm * tstep + (size_t)(((T) < KWRAP) ? (T) : (T) - KWRAP) * kstep)
#define PG8_KB(u, T) ((const char*)(((T) < KWRAP) ? g.Bt : g.Bt2) + (size_t)(u).pn * tstep + (size_t)(((T) < KWRAP) ? (T) : (T) - KWRAP) * kstep)
    Unit cur, nxt; int ui = 0;
    S.start();
    if (!S.advance(cur)) return;
    f32x4 acc[2][2][4][2];
    bf16x8 At[4][2], B0[2][2], B1[2][2];
    {   const char* cA = PG8_KA(cur, cur.kb); const char* cB = PG8_KB(cur, cur.kb);
        PG8_STAGE(PG8_SB(0, 0), cB, voffB); PG8_STAGE(PG8_SB(0, 1), cB + hstep, voffB); PG8_STAGE(PG8_SA(0, 0), cA, voffA); PG8_STAGE(PG8_SA(0, 1), cA + hstep, voffA);
        if (wr == 1) PG8_BAR;
        PG8_WAIT_V(2); PG8_BAR;
        PG8_STAGE(PG8_SB(1, 0), cB + kstep, voffB); PG8_STAGE(PG8_SA(1, 0), cA + kstep, voffA); PG8_STAGE(PG8_SB(1, 1), cB + hstep + kstep, voffB);
        PG8_WAIT_V(6); PG8_BAR; }
    for (;;) {
        const bool has_next = S.advance(nxt);
        if (!Sched::WHOLE && (cur.flags & 8)) {   }
        else if (!Sched::WHOLE && (cur.flags & 1)) {
            const __amdgpu_buffer_rsrc_t rs_in = __builtin_amdgcn_make_buffer_rsrc((void*)(io.slots + (size_t)(io.me - 1) * 131072), 0, 131072, 0x00020000);
            unsigned* fl = io.flags + (size_t)(io.me - 1) * 64; unsigned spins = 0;
            while ((unsigned)__builtin_amdgcn_readfirstlane(__hip_atomic_load(fl, __ATOMIC_RELAXED, __HIP_MEMORY_SCOPE_AGENT)) < 8u) { __builtin_amdgcn_s_sleep(2); if (++spins > (1u << 22)) break; }
            asm volatile("" ::: "memory");
#pragma unroll
            for (int q = 0; q < 16; ++q) { const u32x4 w = __builtin_amdgcn_raw_buffer_load_b128(rs_in, (q * 512 + tid) * 16, 0, 16);
                acc[q >> 3][(q >> 2) & 1][q & 3][0] = (f32x4){__builtin_bit_cast(float, w.x << 16), __builtin_bit_cast(float, w.x & 0xffff0000u), __builtin_bit_cast(float, w.y << 16), __builtin_bit_cast(float, w.y & 0xffff0000u)};
                acc[q >> 3][(q >> 2) & 1][q & 3][1] = (f32x4){__builtin_bit_cast(float, w.z << 16), __builtin_bit_cast(float, w.z & 0xffff0000u), __builtin_bit_cast(float, w.w << 16), __builtin_bit_cast(float, w.w & 0xffff0000u)}; }
        } else {
#pragma unroll
            for (int a = 0; a < 2; ++a)
#pragma unroll
                for (int b = 0; b < 2; ++b)
#pragma unroll
                    for (int m = 0; m < 4; ++m)
#pragma unroll
                        for (int n = 0; n < 2; ++n) acc[a][b][m][n] = (f32x4){0.f, 0.f, 0.f, 0.f};
        }
        const int nk = cur.nk, kb = cur.kb;
        for (int t = 0; t < nk; t += 2) {
            const bool last = (t == nk - 2); const int T = kb + t;
            const char* a1 = PG8_KA(cur, T) + kstep;
            const char* a2 = last ? (has_next ? PG8_KA(nxt, nxt.kb) : PG8_KA(cur, kb)) : PG8_KA(cur, T + 2);
            const char* b2 = last ? (has_next ? PG8_KB(nxt, nxt.kb) : PG8_KB(cur, kb)) : PG8_KB(cur, T + 2);
            const char* a3 = a2 + kstep; const char* b3 = b2 + kstep;
            PG8_LDB(B0, 0, 0); PG8_LDB(B1, 0, 1); PG8_SCHED; PG8_LDA(At, 0, 0); PG8_STAGE(PG8_SA(1, 1), a1 + hstep, voffA);
            PG8_WAIT_V(8); PG8_WAIT_L(0); PG8_BAR; PG8_MMA(0, 0, At, B0); PG8_MMA(0, 1, At, B1); PG8_BAR; PG8_SCHED;
            if constexpr (Epi::NEED_RSTD) { if (t == 0) { E.prefetch(cur, wid); PG8_SCHED; } }
            PG8_LDA(At, 0, 1); PG8_STAGE(PG8_SB(0, 0), b2, voffB); PG8_STAGE(PG8_SB(0, 1), b2 + hstep, voffB); PG8_STAGE(PG8_SA(0, 0), a2, voffA);
            PG8_WAIT_V(8); PG8_WAIT_L(0); PG8_BAR; PG8_MMA(1, 0, At, B0); PG8_MMA(1, 1, At, B1); PG8_BAR; PG8_SCHED;
            PG8_LDB(B0, 1, 0); PG8_LDB(B1, 1, 1); PG8_SCHED; PG8_LDA(At, 1, 0); PG8_STAGE(PG8_SA(0, 1), a2 + hstep, voffA);
            PG8_WAIT_V(8); PG8_WAIT_L(0); PG8_BAR; PG8_MMA(0, 0, At, B0); PG8_MMA(0, 1, At, B1); PG8_BAR; PG8_SCHED;
            PG8_LDA(At, 1, 1); PG8_STAGE(PG8_SB(1, 0), b3, voffB); PG8_STAGE(PG8_SB(1, 1), b3 + hstep, voffB); PG8_STAGE(PG8_SA(1, 0), a3, voffA);
            PG8_WAIT_V(8); PG8_WAIT_L(0); PG8_BAR; PG8_MMA(1, 0, At, B0); PG8_MMA(1, 1, At, B1); PG8_BAR; PG8_SCHED;
        }
        if (wr == 0) PG8_BAR;
        if constexpr (Epi::KSPLIT > 0) { if (cur.flags & (4 | 16)) E.mid(acc, cur, wr, wc, fr, fq); }
        if (!Sched::WHOLE && (cur.flags & 4)) {   }
        else if (!Sched::WHOLE && (cur.flags & 2)) {
            const __amdgpu_buffer_rsrc_t rs_out = __builtin_amdgcn_make_buffer_rsrc((void*)(io.slots + (size_t)io.me * 131072), 0, 131072, 0x00020000);
#pragma unroll
            for (int q = 0; q < 16; ++q) { const f32x4 v0 = acc[q >> 3][(q >> 2) & 1][q & 3][0], v1 = acc[q >> 3][(q >> 2) & 1][q & 3][1];
                u32x4 w; w.x = cvt_pk_bf16(v0[0], v0[1]); w.y = cvt_pk_bf16(v0[2], v0[3]); w.z = cvt_pk_bf16(v1[0], v1[1]); w.w = cvt_pk_bf16(v1[2], v1[3]);
                if (io.same_next) __builtin_amdgcn_raw_buffer_store_b128(w, rs_out, (q * 512 + tid) * 16, 0, 0);
                else __builtin_amdgcn_raw_buffer_store_b128(w, rs_out, (q * 512 + tid) * 16, 0, 16); }
            asm volatile("s_waitcnt vmcnt(0)" ::: "memory");
            if (lane == 0) __hip_atomic_fetch_add(io.flags + (size_t)io.me * 64, 1u, __ATOMIC_RELAXED, __HIP_MEMORY_SCOPE_AGENT);
        } else E(acc, cur, wr, wc, fr, fq);
        if (!has_next) break;
        cur = nxt; ++ui;
        if (wr == 1) PG8_BAR;
    }
    PG8_WAIT_V(0);
    PG8_BAR;
#undef PG8_SA
#undef PG8_SB
#undef PG8_STAGE
#undef PG8_LDA
#undef PG8_LDB
#undef PG8_MMA
#undef PG8_WAIT_V
#undef PG8_WAIT_L
#undef PG8_BAR
#undef PG8_SCHED
#undef PG8_KA
#undef PG8_KB
}
}

using pg8::bf16_t; using pg8::f32x4; using pg8::u32x4; using pg8::Unit; using pg8::cvt_pk_bf16;
__device__ __forceinline__ unsigned cvt_pk_bf16_pin(float lo, float hi) { unsigned r; asm volatile("v_cvt_pk_bf16_f32 %0, %1, %2" : "=v"(r) : "v"(lo), "v"(hi)); return r; }
#define GAS __attribute__((address_space(1)))
#define LAS __attribute__((address_space(3)))
typedef unsigned u32x2 __attribute__((ext_vector_type(2)));
typedef float f32x2 __attribute__((ext_vector_type(2)));
#define LDS_WAIT() asm volatile("s_waitcnt lgkmcnt(0)" ::: "memory")
#define VM_WAIT() asm volatile("s_waitcnt vmcnt(0)" ::: "memory")

__device__ __forceinline__ float bf_lo(unsigned w) { return __builtin_bit_cast(float, w << 16); }
__device__ __forceinline__ float bf_hi(unsigned w) { return __builtin_bit_cast(float, w & 0xffff0000u); }
__device__ __forceinline__ float sigmoid_fast(float x) { return __builtin_amdgcn_rcpf(1.0f + __builtin_amdgcn_exp2f(-1.4426950408889634f * x)); }
template <int M> __device__ __forceinline__ float swz_xor(float v) { return __builtin_bit_cast(float, __builtin_amdgcn_ds_swizzle(__builtin_bit_cast(int, v), 0x1f | (M << 10))); }
__device__ __forceinline__ float sum_xor32(float v) { const unsigned b = __builtin_bit_cast(unsigned, v); auto r = __builtin_amdgcn_permlane32_swap(b, b, false, false); return __builtin_bit_cast(float, (unsigned)r[0]) + __builtin_bit_cast(float, (unsigned)r[1]); }
__device__ __forceinline__ float sum_fq(float v) { v += swz_xor<16>(v); return sum_xor32(v); }
__device__ __forceinline__ float wave_sum(float v) { v += swz_xor<1>(v); v += swz_xor<2>(v); v += swz_xor<4>(v); v += swz_xor<8>(v); v += swz_xor<16>(v); return sum_xor32(v); }

__device__ __forceinline__ float sum2_swap32(float a, float b) { auto r = __builtin_amdgcn_permlane32_swap(__builtin_bit_cast(unsigned, a), __builtin_bit_cast(unsigned, b), false, false); return __builtin_bit_cast(float, (unsigned)r[0]) + __builtin_bit_cast(float, (unsigned)r[1]); }
__device__ __forceinline__ float sum2_swap16(float a, float b) { auto r = __builtin_amdgcn_permlane16_swap(__builtin_bit_cast(unsigned, a), __builtin_bit_cast(unsigned, b), false, false); return __builtin_bit_cast(float, (unsigned)r[0]) + __builtin_bit_cast(float, (unsigned)r[1]); }
__device__ __forceinline__ float reduce48(const float (&v)[48], int lane) {
    float w[32];
#pragma unroll
    for (int i = 0; i < 32; ++i) w[i] = sum2_swap32(v[i], i + 32 < 48 ? v[i + 32] : 0.f);
    float x[16];
#pragma unroll
    for (int i = 0; i < 16; ++i) x[i] = sum2_swap16(w[i], w[i + 16]);
    float y[8]; const bool b8 = (lane & 8) != 0;
#pragma unroll
    for (int i = 0; i < 8; ++i) { const float keep = b8 ? x[i + 8] : x[i], send = b8 ? x[i] : x[i + 8]; y[i] = keep + swz_xor<8>(send); }
    float z[4]; const bool b4 = (lane & 4) != 0;
#pragma unroll
    for (int i = 0; i < 4; ++i) { const float keep = b4 ? y[i + 4] : y[i], send = b4 ? y[i] : y[i + 4]; z[i] = keep + swz_xor<4>(send); }
    float q[2]; const bool b2 = (lane & 2) != 0;
#pragma unroll
    for (int i = 0; i < 2; ++i) { const float keep = b2 ? z[i + 2] : z[i], send = b2 ? z[i] : z[i + 2]; q[i] = keep + swz_xor<2>(send); }
    const bool b1 = (lane & 1) != 0; const float keep = b1 ? q[1] : q[0], send = b1 ? q[0] : q[1];
    return keep + swz_xor<1>(send);
}

constexpr size_t MiB = 1u << 20;
constexpr size_t ACT_BYTES = (size_t)MPAD * D * 2;
constexpr size_t WS_CTL = 0, CTL_ZERO_BYTES = 1 * MiB;
constexpr size_t WS_XCCTAB = 32 * 1024;
constexpr size_t WS_SKFLAG = 64 * 1024;
static_assert(WS_SKFLAG + (size_t)10 * 256 * 256 <= CTL_ZERO_BYTES, "ctl map");
constexpr size_t SSQ_ONE = (size_t)16 * MPAD * 4;
constexpr size_t WS_SSQ = 1 * MiB;
constexpr size_t WS_HALOA = WS_SSQ + 5 * SSQ_ONE;
constexpr size_t WS_HALOB = WS_HALOA + (size_t)2 * NSTREAM * 30 * D * 2;
constexpr size_t WS_W0 = 10 * MiB;
constexpr size_t W_IN_B = (size_t)NIN * D * 2, W_AB_B = (size_t)2 * D * D * 2, W_O_B = (size_t)D * D * 2, W_GU_B = (size_t)NGU * D * 2, W_D_B = (size_t)D * DH * 2;
constexpr size_t WS_W0_IN = WS_W0, WS_W0_AB = WS_W0_IN + W_IN_B, WS_W0_O = WS_W0_AB + W_AB_B, WS_W0_GU = WS_W0_O + W_O_B, WS_W0_D = WS_W0_GU + W_GU_B, WS_W0_END = WS_W0_D + W_D_B;
constexpr size_t WS_W1_AB = WS_W0_END, WS_W1_O = WS_W1_AB + W_AB_B, WS_W1_END = WS_W1_O + W_O_B;
constexpr size_t WS_H = 53 * MiB;
constexpr size_t WS_UA = 86 * MiB, WS_ZB = WS_UA + ACT_BYTES, WS_BB = WS_ZB + ACT_BYTES, WS_SGA = WS_BB + ACT_BYTES, WS_SGB = WS_SGA + ACT_BYTES, WS_END = WS_SGB + ACT_BYTES;
constexpr size_t WS_F = WS_UA;
static_assert(WS_HALOB + (size_t)2 * NSTREAM * 2 * D * 2 <= WS_W0, "ws map: small buffers");
static_assert(WS_W1_END <= WS_H && WS_H + ACT_BYTES <= WS_UA && WS_END + SSQ_ONE <= 256 * MiB, "ws map (a dummy ssq set for timing probes sits at WS_END)");
static_assert(WS_F + (size_t)MPAD * DH * 2 <= WS_SGA, "F overlay");
constexpr size_t DO_CA = 0, DO_W1_IN = ACT_BYTES, DO_W1_GU = DO_W1_IN + W_IN_B, DO_W1_D = DO_W1_GU + W_GU_B, DO_END = DO_W1_D + W_D_B;
static_assert(DO_END <= (size_t)NPROMPT * 2048 * D * 4, "d_out scratch must stay inside the y_prompt region");
constexpr size_t OUT_YP = 0, OUT_YS = OUT_YP + (size_t)NPROMPT * 2048 * D, OUT_NAP = OUT_YS + (size_t)NSAMP * TS * D, OUT_NBP = OUT_NAP + (size_t)2 * NPROMPT * 30 * D,
                 OUT_NAS = OUT_NBP + (size_t)2 * NPROMPT * 2 * D, OUT_NBS = OUT_NAS + (size_t)2 * NSAMP * 30 * D, OUT_TOTAL = OUT_NBS + (size_t)2 * NSAMP * 2 * D;

constexpr int RING_BYTES = 131072, RSTD_OFF = RING_BYTES, RSTD_PITCH = 1040  , LDSCTL_OFF = RSTD_OFF + 16 * RSTD_PITCH, LDS_BYTES = 149504;

#define XB_TMO      128
#define XB_XCNT(j)  (256  + 64 * (j))
#define XB_XSUB(j)  (1280 + 64 * (j))
#define XB_XGEN(j)  (2304 + 64 * (j))
#define XB_TOP      3328
#define XB_TOPGEN   3392
#define XCD_BAR_WORDS 3456
#define XB_SPIN_CAP (1u << 18)
__device__ __forceinline__ unsigned xb_ld(unsigned* p)              { return __hip_atomic_load(p, __ATOMIC_RELAXED, __HIP_MEMORY_SCOPE_AGENT); }
__device__ __forceinline__ unsigned xb_add(unsigned* p, unsigned v) { return __hip_atomic_fetch_add(p, v, __ATOMIC_RELAXED, __HIP_MEMORY_SCOPE_AGENT); }
__device__ __forceinline__ unsigned xb_xcc_id() { return (unsigned)__builtin_amdgcn_s_getreg((3 << 11) | 20) & 0xFu; }
#define XB_SPIN(cond, bar) do { unsigned _sp = 0; while (cond) { __builtin_amdgcn_s_sleep(1); \
    if ((++_sp & 255u) == 0u) { if (xb_ld(&(bar)[XB_TMO])) break; if (_sp > XB_SPIN_CAP) { atomicAdd(&(bar)[XB_TMO], 1u); break; } } } } while (0)
struct XcdBarrier { unsigned* bar; unsigned x; volatile LAS unsigned* st; };
__device__ __forceinline__ XcdBarrier xcd_barrier_post(unsigned* bar, volatile LAS unsigned* st) {
    XcdBarrier b; b.bar = bar; b.x = xb_xcc_id(); b.st = st;
    if (threadIdx.x == 0) { const unsigned old = xb_add(&bar[XB_XCNT(b.x)], 1u); st[2] = (old == 0u) ? 1u : 0u; }
    return b;
}
__device__ __forceinline__ void xcd_barrier_complete(unsigned* bar, unsigned x, unsigned& nloc, unsigned& nx) {
    const unsigned G = gridDim.x * gridDim.y * gridDim.z;
    unsigned sum, cnt, mine, sp = 0u;
    for (;;) {
        sum = 0u; cnt = 0u; mine = 0u;
#pragma unroll
        for (unsigned j = 0; j < 16; ++j) { const unsigned c = xb_ld(&bar[XB_XCNT(j)]); sum += c; cnt += (c > 0u) ? 1u : 0u; mine = (j == x) ? c : mine; }
        if (sum == G) break;
        __builtin_amdgcn_s_sleep(1);
        if ((++sp & 255u) == 0u) { if (xb_ld(&bar[XB_TMO])) break; if (sp > XB_SPIN_CAP) { atomicAdd(&bar[XB_TMO], 1u); break; } }
    }
    nloc = mine > 0u ? mine : 1u; nx = cnt > 0u ? cnt : 1u;
}
__device__ __forceinline__ void xcd_barrier(const XcdBarrier& b, const int wave) {
    asm volatile("s_waitcnt vmcnt(0)" ::: "memory");
    __syncthreads();
    if (wave == 0 && lane_id() == 0) {
        unsigned* bar = b.bar;
        __builtin_amdgcn_s_waitcnt(0);
        unsigned nloc = b.st[0], nx = b.st[1];
        if (nloc == 0u) { xcd_barrier_complete(bar, b.x, nloc, nx); b.st[0] = nloc; b.st[1] = nx; }
        const unsigned k = b.st[3] + 1u; b.st[3] = k;
        __builtin_amdgcn_fence(__ATOMIC_ACQUIRE, "agent");
        asm volatile("s_waitcnt vmcnt(0)" ::: "memory");
        if (b.st[2] == 0u) {
            (void)__hip_atomic_fetch_add(&bar[XB_XSUB(b.x)], 1u, __ATOMIC_RELAXED, __HIP_MEMORY_SCOPE_AGENT);
        } else {
            const unsigned want = (nloc - 1u) * k;
            XB_SPIN(xb_ld(&bar[XB_XSUB(b.x)]) < want, bar);
            __builtin_amdgcn_fence(__ATOMIC_RELEASE, "agent");
            asm volatile("s_waitcnt vmcnt(0)" ::: "memory");
            (void)__hip_atomic_fetch_add(&bar[XB_TOP], 1u, __ATOMIC_RELAXED, __HIP_MEMORY_SCOPE_AGENT);
        }
        const unsigned want_top = nx * k;
        XB_SPIN(xb_ld(&bar[XB_TOP]) < want_top, bar);
        asm volatile("s_waitcnt vmcnt(0)" ::: "memory");
    }
    __syncthreads();
}


__device__ __forceinline__ void sigmoid8(const float (&x)[8], float (&s)[8]) {
    float e[8];
#pragma unroll
    for (int k = 0; k < 8; ++k) e[k] = __builtin_amdgcn_exp2f(-1.4426950408889634f * x[k]);
#pragma unroll
    for (int k = 0; k < 8; ++k) e[k] = 1.0f + e[k];
#pragma unroll
    for (int k = 0; k < 8; ++k) s[k] = __builtin_amdgcn_rcpf(e[k]);
}
__device__ __forceinline__ void load_rstd(const LAS unsigned char* rl, int wr, int fr, int fq, float (&rs)[2][4]) {
    const LAS float* p = (const LAS float*)(rl + fq * 4 * RSTD_PITCH) + wr * 64 + fr;
#pragma unroll
    for (int ai = 0; ai < 2; ++ai)
#pragma unroll
        for (int m = 0; m < 4; ++m) {
            float s = 0.f;
#pragma unroll
            for (int j = 0; j < 4; ++j) s += p[j * (RSTD_PITCH / 4) + ai * 128 + m * 16];
            s = sum_fq(s);
            rs[ai][m] = __builtin_amdgcn_rsqf(s * (1.0f / D) + RMS_EPS);
        }
}
struct RstdPrefetch {
    static constexpr bool NEED_RSTD = true;
    const float* ssq; LAS unsigned char* rl;
    __device__ __forceinline__ void prefetch(const Unit& u, int wid) const {
        const unsigned lo = (unsigned)lane_id() * 16u;
#pragma unroll
        for (int i = 0; i < 2; ++i) { const int j = wid * 2 + i;
            __builtin_amdgcn_global_load_lds((const unsigned*)((const char*)ssq + ((size_t)j * MPAD + (size_t)u.pm * 256) * 4 + lo), (LAS unsigned*)(rl + j * RSTD_PITCH), 16, 0, 0); }
    }
};
struct Epi1 : RstdPrefetch {
    static constexpr int KSPLIT = 0;
    bf16_t* ACT5;
    static __device__ __forceinline__ f32x2 pr(const f32x4 (&acc)[2][2][4][2], int ai, int bj, int m, int q) { return (f32x2){acc[ai][bj][m][q >> 1][(2 * q) & 3], acc[ai][bj][m][q >> 1][(2 * q + 1) & 3]}; }
    __device__ __forceinline__ void operator()(const f32x4 (&acc)[2][2][4][2], const Unit& u, int wr, int wc, int fr, int fq) const {
        asm volatile("" : "+v"(fr), "+v"(fq));
        const int row0 = u.pm * 256 + wr * 64 + fr;
        float rs[2][4]; load_rstd(rl, wr, fr, fq, rs);
        const int pn = u.pn;
        if (pn < 16) {
            bf16_t* O = ACT5 + (size_t)(pn >> 3) * ((size_t)MPAD * D) + (pn & 7) * 128 + wc * 32 + 8 * fq;
            if (pn < 8) {
#pragma unroll
                for (int ai = 0; ai < 2; ++ai)
#pragma unroll
                    for (int m = 0; m < 4; ++m) { const float r = rs[ai][m], rn = r * -1.4426950408889634f;
                        f32x2 e[4]; unsigned wq[4];
#pragma unroll
                        for (int q = 0; q < 4; ++q) { const f32x2 t = pr(acc, ai, 1, m, q) * rn; e[q] = (f32x2){__builtin_amdgcn_exp2f(t.x), __builtin_amdgcn_exp2f(t.y)}; }
#pragma unroll
                        for (int q = 0; q < 4; ++q) { const f32x2 d = e[q] + 1.0f; const f32x2 s = {__builtin_amdgcn_rcpf(d.x), __builtin_amdgcn_rcpf(d.y)}; const f32x2 o = (pr(acc, ai, 0, m, q) * r) * s; wq[q] = cvt_pk_bf16(o.x, o.y); }
                        u32x4 w; w.x = wq[0]; w.y = wq[1]; w.z = wq[2]; w.w = wq[3];
                        *(u32x4*)(O + (size_t)(row0 + ai * 128 + m * 16) * D) = w; }
            } else {
#pragma unroll
                for (int ai = 0; ai < 2; ++ai)
#pragma unroll
                    for (int m = 0; m < 4; ++m) { const float r2 = rs[ai][m] * rs[ai][m]; unsigned wq[4];
#pragma unroll
                        for (int q = 0; q < 4; ++q) { const f32x2 o = (pr(acc, ai, 0, m, q) * pr(acc, ai, 1, m, q)) * r2; wq[q] = cvt_pk_bf16(o.x, o.y); }
                        u32x4 w; w.x = wq[0]; w.y = wq[1]; w.z = wq[2]; w.w = wq[3];
                        *(u32x4*)(O + (size_t)(row0 + ai * 128 + m * 16) * D) = w; }
            }
        } else if (pn < 20) {
            bf16_t* O = ACT5 + (size_t)2 * ((size_t)MPAD * D) + (pn - 16) * 256 + wc * 32 + 8 * fq;
#pragma unroll
            for (int ai = 0; ai < 2; ++ai)
#pragma unroll
                for (int m = 0; m < 4; ++m) { const float r = rs[ai][m];
#pragma unroll
                    for (int bj = 0; bj < 2; ++bj) { unsigned wq[4];
#pragma unroll
                        for (int q = 0; q < 4; ++q) { const f32x2 o = pr(acc, ai, bj, m, q) * r; wq[q] = cvt_pk_bf16(o.x, o.y); }
                        u32x4 w; w.x = wq[0]; w.y = wq[1]; w.z = wq[2]; w.w = wq[3];
                        *(u32x4*)(O + (size_t)(row0 + ai * 128 + m * 16) * D + bj * 128) = w; } }
        } else {
            bf16_t* O = ACT5 + (size_t)3 * ((size_t)MPAD * D) + (pn - 20) * 128 + wc * 32 + 8 * fq;
#pragma unroll
            for (int ai = 0; ai < 2; ++ai)
#pragma unroll
                for (int m = 0; m < 4; ++m) { const float rn = rs[ai][m] * -1.4426950408889634f;
                    f32x2 ea[4], eb[4]; unsigned wo[4], ws_[4];
#pragma unroll
                    for (int q = 0; q < 4; ++q) { const f32x2 ta = pr(acc, ai, 0, m, q) * rn, tb = pr(acc, ai, 1, m, q) * rn;
                        ea[q] = (f32x2){__builtin_amdgcn_exp2f(ta.x), __builtin_amdgcn_exp2f(ta.y)}; eb[q] = (f32x2){fminf(__builtin_amdgcn_exp2f(tb.x), 1e30f), fminf(__builtin_amdgcn_exp2f(tb.y), 1e30f)}; }
#pragma unroll
                    for (int q = 0; q < 4; ++q) { const f32x2 da = ea[q] + 1.0f, db = eb[q] + 1.0f;
                        const f32x2 sa = {__builtin_amdgcn_rcpf(da.x), __builtin_amdgcn_rcpf(da.y)}, sb = {__builtin_amdgcn_rcpf(db.x), __builtin_amdgcn_rcpf(db.y)};
                        const f32x2 o = sa * db; wo[q] = cvt_pk_bf16(o.x, o.y); ws_[q] = cvt_pk_bf16(sb.x, sb.y); }
                    u32x4 w; w.x = wo[0]; w.y = wo[1]; w.z = wo[2]; w.w = wo[3];
                    *(u32x4*)(O + (size_t)(row0 + ai * 128 + m * 16) * D) = w;
                    w.x = ws_[0]; w.y = ws_[1]; w.z = ws_[2]; w.w = ws_[3];
                    *(u32x4*)(O + (size_t)MPAD * D + (size_t)(row0 + ai * 128 + m * 16) * D) = w; }
        }
    }
};
struct Epi2 {
    static constexpr int KSPLIT = 16; static constexpr bool NEED_RSTD = false;
    bf16_t* RT; const bf16_t* SGB; bf16_t* OUT;
    __device__ __forceinline__ void mid(f32x4 (&acc)[2][2][4][2], const Unit& u, int wr, int wc, int fr, int fq) const {
        const int row0 = u.pm * 256 + wr * 64 + fr; const size_t col0 = (size_t)u.pn * 256 + wc * 32 + 8 * fq;
#pragma unroll
        for (int ai = 0; ai < 2; ++ai)
#pragma unroll
            for (int m = 0; m < 4; ++m)
#pragma unroll
                for (int bj = 0; bj < 2; ++bj) { const u32x4 t = *(const u32x4*)(RT + (size_t)(row0 + ai * 128 + m * 16) * D + col0 + bj * 128);
#pragma unroll
                    for (int q = 0; q < 4; ++q) { acc[ai][bj][m][q >> 1][(2 * q) & 3] *= bf_lo(t[q]); acc[ai][bj][m][q >> 1][(2 * q + 1) & 3] *= bf_hi(t[q]); } }
    }
    __device__ __forceinline__ void operator()(const f32x4 (&acc)[2][2][4][2], const Unit& u, int wr, int wc, int fr, int fq) const {
        const int row0 = u.pm * 256 + wr * 64 + fr; const size_t col0 = (size_t)u.pn * 256 + wc * 32 + 8 * fq;
#pragma unroll
        for (int ai = 0; ai < 2; ++ai)
#pragma unroll
            for (int m = 0; m < 4; ++m)
#pragma unroll
                for (int bj = 0; bj < 2; ++bj) { const size_t off = (size_t)(row0 + ai * 128 + m * 16) * D + col0 + bj * 128;
                    const u32x4 s = *(const u32x4*)(SGB + off); float o[8];
#pragma unroll
                    for (int q = 0; q < 4; ++q) { o[2 * q] = bf_lo(s[q]) * acc[ai][bj][m][q >> 1][(2 * q) & 3]; o[2 * q + 1] = bf_hi(s[q]) * acc[ai][bj][m][q >> 1][(2 * q + 1) & 3]; }
                    u32x4 w; w.x = cvt_pk_bf16(o[0], o[1]); w.y = cvt_pk_bf16(o[2], o[3]); w.z = cvt_pk_bf16(o[4], o[5]); w.w = cvt_pk_bf16(o[6], o[7]);
                    *(u32x4*)(OUT + off) = w; }
    }
};
struct EpiRes {
    static constexpr int KSPLIT = 0; static constexpr bool NEED_RSTD = false;
    bf16_t* H; float* ssq_out; bf16_t* OUT;
    __device__ __forceinline__ void operator()(const f32x4 (&acc)[2][2][4][2], const Unit& u, int wr, int wc, int fr, int fq) const {
        const int row0 = u.pm * 256 + wr * 64 + fr; const size_t col0 = (size_t)u.pn * 256 + wc * 32 + 8 * fq;
#pragma unroll
        for (int ai = 0; ai < 2; ++ai)
#pragma unroll
            for (int m = 0; m < 4; ++m) { const int row = row0 + ai * 128 + m * 16; float sq = 0.f;
#pragma unroll
                for (int bj = 0; bj < 2; ++bj) { const size_t off = (size_t)row * D + col0 + bj * 128;
                    const u32x4 t = *(const u32x4*)(H + off); float o[8];
#pragma unroll
                    for (int q = 0; q < 4; ++q) { o[2 * q] = bf_lo(t[q]) + acc[ai][bj][m][q >> 1][(2 * q) & 3]; o[2 * q + 1] = bf_hi(t[q]) + acc[ai][bj][m][q >> 1][(2 * q + 1) & 3]; }
#pragma unroll
                    for (int q = 0; q < 8; ++q) sq += o[q] * o[q];
                    u32x4 w; w.x = cvt_pk_bf16(o[0], o[1]); w.y = cvt_pk_bf16(o[2], o[3]); w.z = cvt_pk_bf16(o[4], o[5]); w.w = cvt_pk_bf16(o[6], o[7]);
                    *(u32x4*)(OUT + off) = w; }
                sq = sum_fq(sq);
                if (fq == 0) ssq_out[(size_t)(u.pn * 4 + wc) * MPAD + row] = sq; }
    }
};
struct Epi4 : RstdPrefetch {
    static constexpr int KSPLIT = 0;
    bf16_t* F;
    __device__ __forceinline__ void operator()(const f32x4 (&acc)[2][2][4][2], const Unit& u, int wr, int wc, int fr, int fq) const {
        asm volatile("" : "+v"(fr), "+v"(fq));
        const int row0 = u.pm * 256 + wr * 64 + fr;
        float rs[2][4]; load_rstd(rl, wr, fr, fq, rs);
        bf16_t* O = F + u.pn * 128 + wc * 32 + 8 * fq;
#pragma unroll
        for (int ai = 0; ai < 2; ++ai)
#pragma unroll
            for (int m = 0; m < 4; ++m) {
                const float r = rs[ai][m], rn = r * -1.4426950408889634f, r2 = r * r;
                f32x2 e[4], p[4];
#pragma unroll
                for (int q = 0; q < 4; ++q) { const f32x2 g = {acc[ai][0][m][q >> 1][(2 * q) & 3], acc[ai][0][m][q >> 1][(2 * q + 1) & 3]}, up = {acc[ai][1][m][q >> 1][(2 * q) & 3], acc[ai][1][m][q >> 1][(2 * q + 1) & 3]};
                    const f32x2 t = g * rn; e[q] = (f32x2){__builtin_amdgcn_exp2f(t.x), __builtin_amdgcn_exp2f(t.y)}; p[q] = (g * up) * r2; }
                unsigned wq[4];
#pragma unroll
                for (int q = 0; q < 4; ++q) { const f32x2 d = e[q] + 1.0f; const f32x2 s = {__builtin_amdgcn_rcpf(d.x), __builtin_amdgcn_rcpf(d.y)}; const f32x2 o = p[q] * s; wq[q] = cvt_pk_bf16(o.x, o.y); }
                u32x4 w; w.x = wq[0]; w.y = wq[1]; w.z = wq[2]; w.w = wq[3];
                *(u32x4*)(O + (size_t)(row0 + ai * 128 + m * 16) * DH) = w; }
    }
};

struct Args { const float* in[20]; float* out; unsigned char* ws; int ph_lo, ph_hi; };
#define KAS __attribute__((address_space(4)))
typedef const KAS Args* KArgs;
__device__ __forceinline__ KArgs fresh(KArgs p) { asm volatile("" : "+s"(p)); return p; }

__device__ __forceinline__ unsigned f2bf(float f) { unsigned u = __builtin_bit_cast(unsigned, f); return (u + 0x7fffu + ((u >> 16) & 1u)) >> 16; }
__device__ __forceinline__ unsigned pk2(float lo, float hi) { return pg8::cvt_pk_bf16(lo, hi); }
constexpr int P0_SCR = 64 * 65 * 4;
struct WItem { const float* W; int K, N; bf16_t* WT; int dest_row0; const float* gk; int kb, nb; };
template <bool NT = false> __device__ __forceinline__ void p0_item_load(const WItem& d, int lane, f32x4 (&v)[16]) {
    const float* src = d.W + (size_t)(64 * d.kb + (lane >> 4)) * d.N + 64 * d.nb + 4 * (lane & 15);
#pragma unroll
    for (int i = 0; i < 16; ++i) { if constexpr (NT) v[i] = __builtin_nontemporal_load((const f32x4*)(src + (size_t)(4 * i) * d.N)); else v[i] = *(const f32x4*)(src + (size_t)(4 * i) * d.N); }
}
template <bool NT = false> __device__ __forceinline__ void p0_item_finish(const WItem& d, LAS float* scr, int lane, const f32x4 (&v)[16]) {
    const int k0 = 64 * d.kb, K = d.K;
    const int c = lane & 7;
    f32x4 g0 = (f32x4){1.f, 1.f, 1.f, 1.f}, g1 = g0;
    if (d.gk) { g0 = *(const f32x4*)(d.gk + k0 + 8 * c); g1 = *(const f32x4*)(d.gk + k0 + 8 * c + 4); }
#pragma unroll
    for (int i = 0; i < 16; ++i) { LAS float* q = scr + (4 * i + (lane >> 4)) * 65 + 4 * (lane & 15); q[0] = v[i][0]; q[1] = v[i][1]; q[2] = v[i][2]; q[3] = v[i][3]; }
    LDS_WAIT(); asm volatile("" ::: "memory");
#pragma unroll
    for (int j = 0; j < 8; ++j) { const int n = (lane >> 3) + 8 * j; const LAS float* s = scr + (8 * c) * 65 + n;
        u32x4 o; o.x = pk2(s[0 * 65] * g0[0], s[1 * 65] * g0[1]); o.y = pk2(s[2 * 65] * g0[2], s[3 * 65] * g0[3]); o.z = pk2(s[4 * 65] * g1[0], s[5 * 65] * g1[1]); o.w = pk2(s[6 * 65] * g1[2], s[7 * 65] * g1[3]);
        if constexpr (NT) __builtin_nontemporal_store(o, (u32x4*)(d.WT + (size_t)(d.dest_row0 + n) * K + k0 + 8 * c)); else *(u32x4*)(d.WT + (size_t)(d.dest_row0 + n) * K + k0 + 8 * c) = o; }
    LDS_WAIT(); asm volatile("" ::: "memory");
}
__device__ __forceinline__ void p0_transpose_item(const float* W, int K, int N, bf16_t* WT, int dest_row0, const float* gk, LAS float* scr, int kb, int nb, int lane) {
    const WItem d{W, K, N, WT, dest_row0, gk, kb, nb}; f32x4 v[16]; p0_item_load<true>(d, lane, v); p0_item_finish(d, scr, lane, v);
}
__device__ __forceinline__ int win_map(int n0) {
    const int seg = n0 >> 10, off = n0 & 1023, p = off >> 7, j = off & 127;
    switch (seg) { case 0: return 256 * p + j; case 1: return 256 * p + 128 + j; case 2: return 4096 + off; case 3: return 2048 + 256 * p + j; case 4: return 2048 + 256 * p + 128 + j; case 5: return 5120 + 256 * p + j; default: return 5120 + 256 * p + 128 + j; }
}
constexpr int I_IN = (D / 64) * (NIN / 64), I_SQ = (D / 64) * (D / 64), I_GU = (D / 64) * (DH / 64), I_DN = (DH / 64) * (D / 64), I_LAYER = I_IN + 3 * I_SQ + 2 * I_GU + I_DN;
__device__ __forceinline__ void p0_weight_item(KArgs ap, int l, int r, LAS float* scr, int lane) {
    struct { const float* in[20]; float* out; unsigned char* ws; } a; a.ws = ap->ws; a.out = ap->out;
#pragma unroll
    for (int i = 0; i < 19; ++i) a.in[i] = ap->in[i];
    unsigned char* ws = a.ws; unsigned char* dob = (unsigned char*)a.out;
    bf16_t* w_in_t = (bf16_t*)(l ? dob + DO_W1_IN : ws + WS_W0_IN); bf16_t* w_ab_t = (bf16_t*)(ws + (l ? WS_W1_AB : WS_W0_AB)); bf16_t* w_o_t = (bf16_t*)(ws + (l ? WS_W1_O : WS_W0_O));
    bf16_t* w_gu_t = (bf16_t*)(l ? dob + DO_W1_GU : ws + WS_W0_GU); bf16_t* w_d_t = (bf16_t*)(l ? dob + DO_W1_D : ws + WS_W0_D);
    if (r < I_IN) { const int nblk = NIN / 64, kb = r / nblk, nb = r % nblk; p0_transpose_item(a.in[6] + (size_t)l * D * NIN, D, NIN, w_in_t, win_map(64 * nb), a.in[5] + l * D, scr, kb, nb, lane); return; } r -= I_IN;
    if (r < I_SQ) { const int nblk = D / 64, kb = r / nblk, nb = r % nblk; p0_transpose_item(a.in[11] + (size_t)l * D * D, D, D, w_ab_t, 64 * nb, nullptr, scr, kb, nb, lane); return; } r -= I_SQ;
    if (r < I_SQ) { const int nblk = D / 64, kb = r / nblk, nb = r % nblk; p0_transpose_item(a.in[13] + (size_t)l * D * D, D, D, w_ab_t, D + 64 * nb, nullptr, scr, kb, nb, lane); return; } r -= I_SQ;
    if (r < I_SQ) { const int nblk = D / 64, kb = r / nblk, nb = r % nblk; p0_transpose_item(a.in[14] + (size_t)l * D * D, D, D, w_o_t, 64 * nb, nullptr, scr, kb, nb, lane); return; } r -= I_SQ;
    if (r < I_GU) { const int nblk = DH / 64, kb = r / nblk, nb = r % nblk, n0 = 64 * nb; p0_transpose_item(a.in[16] + (size_t)l * D * DH, D, DH, w_gu_t, 256 * (n0 >> 7) + (n0 & 127), a.in[15] + l * D, scr, kb, nb, lane); return; } r -= I_GU;
    if (r < I_GU) { const int nblk = DH / 64, kb = r / nblk, nb = r % nblk, n0 = 64 * nb; p0_transpose_item(a.in[17] + (size_t)l * D * DH, D, DH, w_gu_t, 256 * (n0 >> 7) + 128 + (n0 & 127), a.in[15] + l * D, scr, kb, nb, lane); return; } r -= I_GU;
    { const int nblk = D / 64, kb = r / nblk, nb = r % nblk; p0_transpose_item(a.in[18] + (size_t)l * DH * D, DH, D, w_d_t, 64 * nb, nullptr, scr, kb, nb, lane); }
}
__device__ __forceinline__ WItem p0_weight_desc(KArgs ap, int l, int r) {
    struct { const float* in[20]; float* out; unsigned char* ws; } a; a.ws = ap->ws; a.out = ap->out;
#pragma unroll
    for (int i = 0; i < 19; ++i) a.in[i] = ap->in[i];
    unsigned char* ws = a.ws; unsigned char* dob = (unsigned char*)a.out;
    bf16_t* w_in_t = (bf16_t*)(l ? dob + DO_W1_IN : ws + WS_W0_IN); bf16_t* w_ab_t = (bf16_t*)(ws + (l ? WS_W1_AB : WS_W0_AB)); bf16_t* w_o_t = (bf16_t*)(ws + (l ? WS_W1_O : WS_W0_O));
    bf16_t* w_gu_t = (bf16_t*)(l ? dob + DO_W1_GU : ws + WS_W0_GU); bf16_t* w_d_t = (bf16_t*)(l ? dob + DO_W1_D : ws + WS_W0_D);
    if (r < I_IN) { const int nblk = NIN / 64, kb = r / nblk, nb = r % nblk; return WItem{a.in[6] + (size_t)l * D * NIN, D, NIN, w_in_t, win_map(64 * nb), a.in[5] + l * D, kb, nb}; } r -= I_IN;
    if (r < I_SQ) { const int nblk = D / 64, kb = r / nblk, nb = r % nblk; return WItem{a.in[11] + (size_t)l * D * D, D, D, w_ab_t, 64 * nb, nullptr, kb, nb}; } r -= I_SQ;
    if (r < I_SQ) { const int nblk = D / 64, kb = r / nblk, nb = r % nblk; return WItem{a.in[13] + (size_t)l * D * D, D, D, w_ab_t, D + 64 * nb, nullptr, kb, nb}; } r -= I_SQ;
    if (r < I_SQ) { const int nblk = D / 64, kb = r / nblk, nb = r % nblk; return WItem{a.in[14] + (size_t)l * D * D, D, D, w_o_t, 64 * nb, nullptr, kb, nb}; } r -= I_SQ;
    if (r < I_GU) { const int nblk = DH / 64, kb = r / nblk, nb = r % nblk, n0 = 64 * nb; return WItem{a.in[16] + (size_t)l * D * DH, D, DH, w_gu_t, 256 * (n0 >> 7) + (n0 & 127), a.in[15] + l * D, kb, nb}; } r -= I_GU;
    if (r < I_GU) { const int nblk = DH / 64, kb = r / nblk, nb = r % nblk, n0 = 64 * nb; return WItem{a.in[17] + (size_t)l * D * DH, D, DH, w_gu_t, 256 * (n0 >> 7) + 128 + (n0 & 127), a.in[15] + l * D, kb, nb}; } r -= I_GU;
    { const int nblk = D / 64, kb = r / nblk, nb = r % nblk; return WItem{a.in[18] + (size_t)l * DH * D, DH, D, w_d_t, 64 * nb, nullptr, kb, nb}; }
}
constexpr int NW_G1 = 231  , NW_G4 = 242  , N_HELPERS = 256 - NW_G1, BG_ITEMS = (I_LAYER - I_IN) + I_LAYER, BG_A = I_LAYER - I_IN, BG_B = BG_A + I_IN, BG_C = BG_ITEMS - I_DN;
struct WgRole { bool compute; int cc, h, vnext; };
__device__ __forceinline__ WgRole wg_role(int vcu, int NW) {
    const int idle = 256 - NW, base = idle >> 3, extra = idle & 7, xq = vcu >> 5, xr = vcu & 31, hx = base + (xq < extra ? 1 : 0), before = base * xq + (xq < extra ? xq : extra);
    WgRole r; r.compute = xr < 32 - hx; r.cc = vcu - before; r.h = before + (xr - (32 - hx)); r.vnext = (xr + 1 < 32 - hx) ? vcu + 1 : (xq + 1) * 32; return r;
}
__device__ __forceinline__ void p0_background(KArgs ap, LAS unsigned char* lds, int h, int nh, int lo, int hi, int wave, int lane) {
    LAS float* scr = (LAS float*)(lds + wave * P0_SCR);
    int it = lo + h * 8 + wave; if (it >= hi) return;
    WItem cur = (it < I_LAYER - I_IN) ? p0_weight_desc(ap, 0, I_IN + it) : p0_weight_desc(ap, 1, it - (I_LAYER - I_IN));
    f32x4 va[16]; p0_item_load<true>(cur, lane, va);
    for (;;) {
        const int nit = it + nh * 8; const bool more = nit < hi;
        const int nr = more ? nit : it;
        const WItem nxt = (nr < I_LAYER - I_IN) ? p0_weight_desc(ap, 0, I_IN + nr) : p0_weight_desc(ap, 1, nr - (I_LAYER - I_IN));
        f32x4 vb[16];
        if (more) p0_item_load<true>(nxt, lane, vb);
        p0_item_finish<true>(cur, scr, lane, va);
        if (!more) break;
#pragma unroll
        for (int i = 0; i < 16; ++i) va[i] = vb[i];
        cur = nxt; it = nit;
    }
}
__device__ __forceinline__ void p0_prologue(KArgs ap, LAS unsigned char* lds, int gw, int NGW, int wave, int lane) {
    struct { const float* in[20]; float* out; unsigned char* ws; } a; a.ws = ap->ws; a.out = ap->out;
#pragma unroll
    for (int i = 0; i < 19; ++i) a.in[i] = ap->in[i];
    LAS float* scr = (LAS float*)(lds + wave * P0_SCR);
    unsigned char* ws = a.ws;
    for (int it = gw; it < (MK_N_LAUNCHES == 1 ? I_IN : 2 * I_LAYER); it += NGW) p0_weight_item(ap, it / I_LAYER, it % I_LAYER, scr, lane);
    bf16_t* H = (bf16_t*)(ws + WS_H); float* ssq0 = (float*)(ws + WS_SSQ);
    for (int row = gw; row < MPAD; row += NGW) {
        const float* src = nullptr;
        if (row < ROW_S0) { const int b = row / TP, t = row % TP; src = t < 16 ? a.in[4] + (size_t)t * D : a.in[0] + ((size_t)b * 2048 + (t - 16)) * D; }
        else if (row < MREAL) src = a.in[1] + (size_t)(row - ROW_S0) * D;
        float s = 0.f;
#pragma unroll
        for (int j = 0; j < 4; ++j) { f32x4 v = src ? __builtin_nontemporal_load((const f32x4*)(src + 256 * j + 4 * lane)) : (f32x4){0.f, 0.f, 0.f, 0.f};
            s += (v[0] * v[0] + v[1] * v[1]) + (v[2] * v[2] + v[3] * v[3]);
            u32x2 o; o.x = pk2(v[0], v[1]); o.y = pk2(v[2], v[3]); *(u32x2*)(H + (size_t)row * D + 256 * j + 4 * lane) = o; }
        s = wave_sum(s);
        if (lane < 16) ssq0[(size_t)lane * MPAD + row] = lane == 0 ? s : 0.f;
    }
    bf16_t* haloA = (bf16_t*)(ws + WS_HALOA); bf16_t* haloB = (bf16_t*)(ws + WS_HALOB);
    for (int it = gw; it < 2 * NSTREAM * 32; it += NGW) {
        const int l = it / (NSTREAM * 32), S = (it / 32) % NSTREAM, p = it % 32;
        const float* src = nullptr; bf16_t* dst;
        if (p < 30) { dst = haloA + ((size_t)(l * NSTREAM + S) * 30 + p) * D; if (S >= NPROMPT) src = a.in[2] + ((size_t)(l * NSAMP + (S - NPROMPT)) * 30 + p) * D; }
        else { dst = haloB + ((size_t)(l * NSTREAM + S) * 2 + (p - 30)) * D; if (S >= NPROMPT) src = a.in[3] + ((size_t)(l * NSAMP + (S - NPROMPT)) * 2 + (p - 30)) * D; }
#pragma unroll
        for (int j = 0; j < 4; ++j) { f32x4 v = src ? *(const f32x4*)(src + 256 * j + 4 * lane) : (f32x4){0.f, 0.f, 0.f, 0.f};
            u32x2 o; o.x = pk2(v[0], v[1]); o.y = pk2(v[2], v[3]); *(u32x2*)(dst + 256 * j + 4 * lane) = o; }
    }
}

static_assert(true, "");
constexpr int CR = 24, N_CONV_ITEMS = NPROMPT * (TP / CR) + NSAMP;
static_assert(TP % CR == 0, "conv chunking");
constexpr int CONV_STAGE_BYTES = (CR + 30) * 2048;
static_assert(CONV_STAGE_BYTES + 8 * CR * 2 * 4 + CR * 2 * 4 <= RING_BYTES, "conv LDS");
static_assert(8 * P0_SCR <= LDSCTL_OFF, "prologue LDS");
struct ConvItem { int S, t0, nrows; size_t rowS; };
__device__ __forceinline__ ConvItem conv_item(int it) {
    ConvItem ci;
    if (it < NPROMPT * (TP / CR)) { ci.S = it / (TP / CR); ci.t0 = (it % (TP / CR)) * CR; ci.nrows = CR; ci.rowS = (size_t)ci.S * TP; }
    else { ci.S = NPROMPT + (it - NPROMPT * (TP / CR)); ci.t0 = 0; ci.nrows = TS; ci.rowS = (size_t)ROW_S0 + (size_t)(ci.S - NPROMPT) * TS; }
    return ci;
}
__device__ __forceinline__ void conv_stage_a(LAS unsigned char* lds, const bf16_t* UA, const bf16_t* haloA_l, const ConvItem& ci, int wave, int lane) {
    const bf16_t* hA = haloA_l + (size_t)ci.S * 30 * D; const bf16_t* uS = UA + ci.rowS * D;
    for (int p = wave; p < 2 * (CR + 30); p += 8) { const int r = p >> 1, h = p & 1, tp = ci.t0 - 30 + r;
        const bf16_t* src = tp >= 0 ? uS + (size_t)tp * D : hA + (size_t)(30 + tp) * D;
        __builtin_amdgcn_global_load_lds((const unsigned*)((const char*)src + h * 1024 + lane * 16), (LAS unsigned*)(lds + r * 2048 + h * 1024), 16, 0, 2  ); }
}
__device__ __forceinline__ void conv_load_b(u32x4 (&zb)[8], u32x4 (&bb)[6], const bf16_t* ZB, const bf16_t* BB, const bf16_t* haloB_l, const ConvItem& ci, int cg, int rg) {
    const bf16_t* hB = haloB_l + (size_t)ci.S * 2 * D; const bf16_t* zS = ZB + ci.rowS * D; const int r0 = ci.t0 + 6 * rg;
    const bf16_t* z0p = r0 == 0 ? hB : zS + (size_t)(r0 - 2) * D; const bf16_t* z1p = r0 == 0 ? hB + D : zS + (size_t)(r0 - 1) * D;
    zb[0] = *(const u32x4*)(z0p + 8 * cg); zb[1] = *(const u32x4*)(z1p + 8 * cg);
    const bf16_t* zp = zS + (size_t)r0 * D + 8 * cg;
#pragma unroll
    for (int i = 0; i < 6; ++i) { zb[2 + i] = __builtin_nontemporal_load((const u32x4*)zp); zp += D; asm volatile("" : "+v"(zp)); }
    const bf16_t* bp = BB + (ci.rowS + r0) * D + 8 * cg;
#pragma unroll
    for (int i = 0; i < 6; ++i) { bb[i] = __builtin_nontemporal_load((const u32x4*)bp); bp += D; asm volatile("" : "+v"(bp)); }
}
__device__ __forceinline__ void conv_phase(KArgs ap, int l, LAS unsigned char* lds, int tid, int wave, int lane) {
    struct { const float* in[20]; float* out; unsigned char* ws; } a; a.ws = ap->ws; a.out = ap->out; a.in[2] = ap->in[2]; a.in[7] = ap->in[7]; a.in[8] = ap->in[8]; a.in[9] = ap->in[9]; a.in[10] = ap->in[10]; a.in[12] = ap->in[12];
    unsigned char* ws = a.ws;
    const bf16_t* UA = (const bf16_t*)(ws + WS_UA); const bf16_t* ZB = (const bf16_t*)(ws + WS_ZB); bf16_t* BB = (bf16_t*)(ws + WS_BB); bf16_t* CA = (bf16_t*)((unsigned char*)a.out + DO_CA);
    const bf16_t* haloA = (const bf16_t*)(ws + WS_HALOA) + (size_t)l * NSTREAM * 30 * D; const bf16_t* haloB = (const bf16_t*)(ws + WS_HALOB) + (size_t)l * NSTREAM * 2 * D;
    LAS float* red = (LAS float*)(lds + CONV_STAGE_BYTES);
    LAS float* fin = red + 8 * CR * 2;
    const LAS unsigned char* xl = lds + tid * 4;
    const int c0 = 2 * tid;
    const int cg = tid & 127, rg = tid >> 7;
    const float* cbw = a.in[12] + (size_t)l * 3 * D + 8 * cg;
    const f32x2 bias = *(const f32x2*)(a.in[8] + l * D + c0), lng = *(const f32x2*)(a.in[9] + l * D + c0), lnb = *(const f32x2*)(a.in[10] + l * D + c0);
    f32x4 wb[3][2];
#pragma unroll
    for (int k = 0; k < 3; ++k) { wb[k][0] = *(const f32x4*)(cbw + k * D); wb[k][1] = *(const f32x4*)(cbw + k * D + 4); }
    f32x2 w[31];
#define CONV_LOAD_TAPS() do { const float* wp = a.in[7] + (size_t)l * 31 * D + c0; asm volatile("" : "+v"(wp)); \
        _Pragma("unroll") for (int k = 0; k < 31; ++k) { w[k] = *(const f32x2*)wp; wp += D; asm volatile("" : "+v"(wp)); } } while (0)
    CONV_LOAD_TAPS();
    u32x4 zb[8], bb[6];
    int it = blockIdx.x; ConvItem ci = conv_item(it < N_CONV_ITEMS ? it : 0);
    __syncthreads();
    if (it < N_CONV_ITEMS) { conv_stage_a(lds, UA, haloA, ci, wave, lane); conv_load_b(zb, bb, ZB, BB, haloB, ci, cg, rg); }
    for (; it < N_CONV_ITEMS; it += gridDim.x) {
        VM_WAIT(); __syncthreads();
        f32x2 acc[CR];
#pragma unroll
        for (int i = 0; i < CR; ++i) acc[i] = bias;
#pragma unroll
        for (int j = 0; j < CR + 30; ++j) {
            const unsigned xw = *(const LAS unsigned*)(xl + j * 2048); const f32x2 xv = {bf_lo(xw), bf_hi(xw)};
#pragma unroll
            for (int i = (j - 30 > 0 ? j - 30 : 0); i <= (j < CR - 1 ? j : CR - 1); ++i) acc[i] = __builtin_elementwise_fma(w[j - i], xv, acc[i]);
            if ((j & 7) == 7) {
#pragma unroll
                for (int i = 0; i < CR; i += 4) asm volatile("" : "+v"(acc[i].x), "+v"(acc[i].y), "+v"(acc[i + 1].x), "+v"(acc[i + 1].y), "+v"(acc[i + 2].x), "+v"(acc[i + 2].y), "+v"(acc[i + 3].x), "+v"(acc[i + 3].y) :: "memory");
            }
        }
        { float pv[2 * CR];
#pragma unroll
          for (int i = 0; i < CR; ++i) { pv[2 * i] = acc[i].x + acc[i].y; pv[2 * i + 1] = acc[i].x * acc[i].x + acc[i].y * acc[i].y; }
          const float tot = reduce48(pv, lane);
          if (lane < 2 * CR) red[wave * 2 * CR + lane] = tot; }
#pragma unroll
        for (int j = 0; j < 6; ++j) if (6 * rg + j < ci.nrows) {
            unsigned o[4];
#pragma unroll
            for (int q = 0; q < 4; ++q) {
                const float c0v = wb[0][q >> 1][(2 * q) & 3] * bf_lo(zb[j][q]) + wb[1][q >> 1][(2 * q) & 3] * bf_lo(zb[j + 1][q]) + wb[2][q >> 1][(2 * q) & 3] * bf_lo(zb[j + 2][q]);
                const float c1v = wb[0][q >> 1][(2 * q + 1) & 3] * bf_hi(zb[j][q]) + wb[1][q >> 1][(2 * q + 1) & 3] * bf_hi(zb[j + 1][q]) + wb[2][q >> 1][(2 * q + 1) & 3] * bf_hi(zb[j + 2][q]);
                o[q] = cvt_pk_bf16_pin(bf_lo(bb[j][q]) * c0v, bf_hi(bb[j][q]) * c1v); }
            u32x4 w4; w4.x = o[0]; w4.y = o[1]; w4.z = o[2]; w4.w = o[3];
            __builtin_nontemporal_store(w4, (u32x4*)(BB + (ci.rowS + ci.t0 + 6 * rg + j) * D + 8 * cg)); }
        LDS_WAIT(); __syncthreads();
        const int nit = it + gridDim.x; const bool more = nit < N_CONV_ITEMS; const ConvItem cn = conv_item(more ? nit : it);
        if (more) conv_stage_a(lds, UA, haloA, cn, wave, lane);
        if (tid < CR) { float s1 = 0.f, s2 = 0.f;
#pragma unroll
            for (int wv = 0; wv < 8; ++wv) { s1 += red[(wv * CR + tid) * 2]; s2 += red[(wv * CR + tid) * 2 + 1]; }
            const float mean = s1 * (1.0f / D); float var = s2 * (1.0f / D) - mean * mean; var = var > 0.f ? var : 0.f;
            fin[tid * 2] = mean; fin[tid * 2 + 1] = __builtin_amdgcn_rsqf(var + LN_EPS); }
        LDS_WAIT(); __syncthreads();
#pragma unroll
        for (int i = 0; i < CR; ++i) if (i < ci.nrows) {
            const float mean = fin[i * 2], rstd = fin[i * 2 + 1];
            const float y0 = (acc[i].x - mean) * rstd * lng.x + lnb.x, y1 = (acc[i].y - mean) * rstd * lng.y + lnb.y;
            __builtin_nontemporal_store(cvt_pk_bf16_pin(y0 * sigmoid_fast(y0), y1 * sigmoid_fast(y1)), (unsigned*)(CA + (ci.rowS + ci.t0 + i) * D + c0)); }
        if (more) { conv_load_b(zb, bb, ZB, BB, haloB, cn, cg, rg); CONV_LOAD_TAPS(); }
        ci = cn;
    }
    VM_WAIT(); __syncthreads();
    for (int it = blockIdx.x; it < NSTREAM * 32; it += gridDim.x) {
        const int S = it / 32, p = it % 32; float* dst; f32x2 v;
        if (p < 30) {
            if (S < NPROMPT) { dst = a.out + OUT_NAP + ((size_t)(l * NPROMPT + S) * 30 + p) * D; const unsigned xw = *(const unsigned*)(UA + ((size_t)S * TP + (TP - 30) + p) * D + c0); v = (f32x2){bf_lo(xw), bf_hi(xw)}; }
            else { const int s = S - NPROMPT; dst = a.out + OUT_NAS + ((size_t)(l * NSAMP + s) * 30 + p) * D;
                if (p < 30 - TS) v = *(const f32x2*)(a.in[2] + ((size_t)(l * NSAMP + s) * 30 + TS + p) * D + c0);
                else { const unsigned xw = *(const unsigned*)(UA + ((size_t)ROW_S0 + (size_t)s * TS + (p - (30 - TS))) * D + c0); v = (f32x2){bf_lo(xw), bf_hi(xw)}; } }
        } else { const int q = p - 30;
            if (S < NPROMPT) { dst = a.out + OUT_NBP + ((size_t)(l * NPROMPT + S) * 2 + q) * D; const unsigned xw = *(const unsigned*)(ZB + ((size_t)S * TP + (TP - 2) + q) * D + c0); v = (f32x2){bf_lo(xw), bf_hi(xw)}; }
            else { const int s = S - NPROMPT; dst = a.out + OUT_NBS + ((size_t)(l * NSAMP + s) * 2 + q) * D; const unsigned xw = *(const unsigned*)(ZB + ((size_t)ROW_S0 + (size_t)s * TS + (TS - 2) + q) * D + c0); v = (f32x2){bf_lo(xw), bf_hi(xw)}; } }
        *(f32x2*)(dst + c0) = v;
    }
}

__device__ __forceinline__ void final_phase(KArgs ap, int gw, int NGW, int lane) {
    struct { const float* in[20]; float* out; unsigned char* ws; } a; a.ws = ap->ws; a.out = ap->out; a.in[19] = ap->in[19];
    const bf16_t* H = (const bf16_t*)(a.ws + WS_H); const float* ssq = (const float*)(a.ws + WS_SSQ + 4 * SSQ_ONE); const float* g = a.in[19];
    for (int row = gw; row < MREAL; row += NGW) {
        float* dst;
        if (row < ROW_S0) { const int b = row / TP, t = row % TP; if (t < 16) continue; dst = a.out + OUT_YP + ((size_t)b * 2048 + (t - 16)) * D; }
        else dst = a.out + OUT_YS + (size_t)(row - ROW_S0) * D;
        float s = lane < 16 ? ssq[(size_t)lane * MPAD + row] : 0.f; s = wave_sum(s);
        const float r = __builtin_amdgcn_rsqf(s * (1.0f / D) + RMS_EPS);
#pragma unroll
        for (int j = 0; j < 2; ++j) { const int c = 512 * j + 8 * lane; const u32x4 h = __builtin_nontemporal_load((const u32x4*)(H + (size_t)row * D + c));
            const f32x4 g0 = *(const f32x4*)(g + c), g1 = *(const f32x4*)(g + c + 4);
            f32x4 o0, o1; o0[0] = bf_lo(h.x) * r * g0[0]; o0[1] = bf_hi(h.x) * r * g0[1]; o0[2] = bf_lo(h.y) * r * g0[2]; o0[3] = bf_hi(h.y) * r * g0[3];
            o1[0] = bf_lo(h.z) * r * g1[0]; o1[1] = bf_hi(h.z) * r * g1[1]; o1[2] = bf_lo(h.w) * r * g1[2]; o1[3] = bf_hi(h.w) * r * g1[3];
            __builtin_nontemporal_store(o0, (f32x4*)(dst + c)); __builtin_nontemporal_store(o1, (f32x4*)(dst + c + 4)); }
    }
}

__global__ void __launch_bounds__(512, 2) mega_fwd(Args a_unused) {
    extern __shared__ __attribute__((aligned(16))) unsigned char lds_raw[];
    LAS unsigned char* lds = (LAS unsigned char*)lds_raw;
    const KArgs kp = (KArgs)__builtin_amdgcn_kernarg_segment_ptr();
    const int wave = __builtin_amdgcn_readfirstlane(threadIdx.x >> 6);
    const int G = gridDim.x, bx = blockIdx.x, vcu = (G % 8 == 0) ? (bx % 8) * (G / 8) + bx / 8 : bx;
    const int gw = vcu * 8 + wave, NGW = G * 8;
    volatile LAS unsigned* ctl = (volatile LAS unsigned*)(lds + LDSCTL_OFF);
    if (threadIdx.x < 64) ctl[threadIdx.x] = 0u;
    __syncthreads();
    XcdBarrier bar; bar.bar = (unsigned*)(kp->ws + WS_CTL); bar.x = 0; bar.st = nullptr;
    if (MK_N_LAUNCHES == 1) bar = xcd_barrier_post((unsigned*)(kp->ws + WS_CTL), ctl + 8);
    const unsigned my_xcc = xb_xcc_id();
    if (threadIdx.x == 0) __hip_atomic_store((unsigned*)(kp->ws + WS_XCCTAB) + vcu, my_xcc + 1u, __ATOMIC_RELAXED, __HIP_MEMORY_SCOPE_AGENT);
    const int lo = kp->ph_lo, hi = kp->ph_hi;
#define IN(k) (lo <= (k) && (k) < hi)
#define SEAM(k) do { if (IN(k) && IN((k) + 1)) xcd_barrier(bar, wave); } while (0)

    if (IN(0)) { for (int rep = 0; rep < REP_P0; ++rep) { p0_prologue(fresh(kp), lds, gw, NGW, wave, lane_id()); __syncthreads(); } SEAM(0); }

    const int same_next = (MK_N_LAUNCHES == 1 && vcu + 1 < G) ? (__builtin_amdgcn_readfirstlane(__hip_atomic_load((unsigned*)(kp->ws + WS_XCCTAB) + vcu + 1, __ATOMIC_RELAXED, __HIP_MEMORY_SCOPE_AGENT)) == my_xcc + 1u) : 0;
#pragma unroll 1
    for (int l = 0; l < 2; ++l) {
        const int pb = 1 + 6 * l;
        if (IN(pb + 0)) {
            const KArgs ap = fresh(kp); unsigned char* ws = ap->ws; unsigned char* dob = (unsigned char*)ap->out;
            const bf16_t* H = (const bf16_t*)(ws + WS_H); const bf16_t* w_in_t = (const bf16_t*)(l ? dob + DO_W1_IN : ws + WS_W0_IN);
            pg8::Gemm g{H, w_in_t, H, w_in_t}; pg8::StreamK<NIN / 256, D / 128, 0> S; S.init(vcu);
            Epi1 E{{(const float*)(ws + WS_SSQ + (size_t)(2 * l) * SSQ_ONE), lds + RSTD_OFF}, (bf16_t*)(ws + WS_UA)}; pg8::SlotIO io{dob + DO_CA, (unsigned*)(ws + WS_SKFLAG) + (size_t)(5 * l + 0) * 256 * 64, vcu, same_next};
            if (MK_N_LAUNCHES == 1) {
                const WgRole wr = wg_role(vcu, NW_G1);
                if (!wr.compute) p0_background(fresh(kp), lds, wr.h, N_HELPERS, l ? BG_B : 0, l ? BG_C : BG_A, wave, lane_id());
                else {
                    const KArgs ap2 = fresh(kp); unsigned char* ws2 = ap2->ws; unsigned char* dob2 = (unsigned char*)ap2->out;
                    const bf16_t* H2 = (const bf16_t*)(ws2 + WS_H); const bf16_t* w2 = (const bf16_t*)(l ? dob2 + DO_W1_IN : ws2 + WS_W0_IN);
                    const pg8::Gemm g2{H2, w2, H2, w2}; pg8::StreamK<NIN / 256, D / 128, 0, NW_G1> S2; S2.init(opaque_s(wr.cc));
                    const Epi1 E2{{(const float*)(ws2 + WS_SSQ + (size_t)(2 * l) * SSQ_ONE), lds + RSTD_OFF}, (bf16_t*)(ws2 + WS_UA)}; const pg8::SlotIO io2{dob2 + DO_CA, (unsigned*)(ws2 + WS_SKFLAG) + (size_t)(5 * l + 0) * 256 * 64, opaque_s(wr.cc), 0};
                    pg8::gemm_phase<Epi1, pg8::StreamK<NIN / 256, D / 128, 0, NW_G1>, D, 1 << 20>(lds, g2, S2, E2, io2, wave);
                }
            } else
            for (int rep = 0; rep < REP_G1; ++rep) pg8::gemm_phase<Epi1, pg8::StreamK<NIN / 256, D / 128, 0>, D, 1 << 20>(lds, g, S, E, io, wave);
            SEAM(pb + 0);
        }
        if (IN(pb + 1)) { const int l_ = lane_id(); conv_phase(fresh(kp), l, lds, wave * 64 + l_, wave, l_); SEAM(pb + 1); }
        if (IN(pb + 2)) {
            const KArgs ap = fresh(kp); unsigned char* ws = ap->ws; unsigned char* dob = (unsigned char*)ap->out;
            const bf16_t* w_ab_t = (const bf16_t*)(ws + (l ? WS_W1_AB : WS_W0_AB));
            pg8::Gemm g{(const bf16_t*)(dob + DO_CA), w_ab_t, (const bf16_t*)(ws + WS_BB), w_ab_t + (size_t)D * D}; pg8::StreamK<D / 256, 2 * D / 128, 16> S; S.init(vcu);
            Epi2 E{(bf16_t*)(ws + WS_SGA), (const bf16_t*)(ws + WS_SGB), (bf16_t*)(ws + WS_SGA)}; pg8::SlotIO io{ws + WS_UA, (unsigned*)(ws + WS_SKFLAG) + (size_t)(5 * l + 1) * 256 * 64, vcu, same_next};
            pg8::gemm_phase<Epi2, pg8::StreamK<D / 256, 2 * D / 128, 16>, D, 16>(lds, g, S, E, io, wave);
            SEAM(pb + 2);
        }
        if (IN(pb + 3)) {
            const KArgs ap = fresh(kp); unsigned char* ws = ap->ws;
            const bf16_t* MG = (const bf16_t*)(ws + WS_SGA); const bf16_t* w_o_t = (const bf16_t*)(ws + (l ? WS_W1_O : WS_W0_O));
            pg8::Gemm g{MG, w_o_t, MG, w_o_t}; pg8::StreamK<D / 256, D / 128, 0> S; S.init(vcu);
            EpiRes E{(bf16_t*)(ws + WS_H), (float*)(ws + WS_SSQ + (size_t)(2 * l + 1) * SSQ_ONE), (bf16_t*)(ws + WS_H)}; pg8::SlotIO io{ws + WS_UA, (unsigned*)(ws + WS_SKFLAG) + (size_t)(5 * l + 2) * 256 * 64, vcu, same_next};
            pg8::gemm_phase<EpiRes, pg8::StreamK<D / 256, D / 128, 0>, D, 1 << 20>(lds, g, S, E, io, wave);
            SEAM(pb + 3);
        }
        if (IN(pb + 4)) {
            const KArgs ap = fresh(kp); unsigned char* ws = ap->ws; unsigned char* dob = (unsigned char*)ap->out;
            const bf16_t* H = (const bf16_t*)(ws + WS_H); const bf16_t* w_gu_t = (const bf16_t*)(l ? dob + DO_W1_GU : ws + WS_W0_GU);
            pg8::Gemm g{H, w_gu_t, H, w_gu_t}; pg8::StreamK<NGU / 256, D / 128, 0> S; S.init(vcu);
            Epi4 E{{(const float*)(ws + WS_SSQ + (size_t)(2 * l + 1) * SSQ_ONE), lds + RSTD_OFF}, (bf16_t*)(ws + WS_F)}; pg8::SlotIO io{ws + WS_SGB, (unsigned*)(ws + WS_SKFLAG) + (size_t)(5 * l + 3) * 256 * 64, vcu, same_next};
            if (MK_N_LAUNCHES == 1) {
                const WgRole wr = wg_role(vcu, NW_G4);
                if (!wr.compute) p0_background(fresh(kp), lds, wr.h, 256 - NW_G4, l ? BG_C : BG_A, l ? BG_ITEMS : BG_B, wave, lane_id());
                else {
                    const KArgs ap2 = fresh(kp); unsigned char* ws2 = ap2->ws; unsigned char* dob2 = (unsigned char*)ap2->out;
                    const bf16_t* H2 = (const bf16_t*)(ws2 + WS_H); const bf16_t* w2 = (const bf16_t*)(l ? dob2 + DO_W1_GU : ws2 + WS_W0_GU);
                    const pg8::Gemm g2{H2, w2, H2, w2}; pg8::StreamK<NGU / 256, D / 128, 0, NW_G4> S2; S2.init(opaque_s(wr.cc));
                    const Epi4 E2{{(const float*)(ws2 + WS_SSQ + (size_t)(2 * l + 1) * SSQ_ONE), lds + RSTD_OFF}, (bf16_t*)(ws2 + WS_F)}; const pg8::SlotIO io2{ws2 + WS_SGB, (unsigned*)(ws2 + WS_SKFLAG) + (size_t)(5 * l + 3) * 256 * 64, opaque_s(wr.cc), 0};
                    pg8::gemm_phase<Epi4, pg8::StreamK<NGU / 256, D / 128, 0, NW_G4>, D, 1 << 20>(lds, g2, S2, E2, io2, wave);
                }
            } else
            for (int rep = 0; rep < REP_G4; ++rep) pg8::gemm_phase<Epi4, pg8::StreamK<NGU / 256, D / 128, 0>, D, 1 << 20>(lds, g, S, E, io, wave);
            SEAM(pb + 4);
        }
        if (IN(pb + 5)) {
            const KArgs ap = fresh(kp); unsigned char* ws = ap->ws; unsigned char* dob = (unsigned char*)ap->out;
            const bf16_t* F = (const bf16_t*)(ws + WS_F); const bf16_t* w_d_t = (const bf16_t*)(l ? dob + DO_W1_D : ws + WS_W0_D);
            pg8::Gemm g{F, w_d_t, F, w_d_t}; pg8::StreamK<D / 256, DH / 128, 0> S; S.init(vcu);
            EpiRes E{(bf16_t*)(ws + WS_H), (float*)(ws + WS_SSQ + (size_t)(2 * l + 2) * SSQ_ONE), (bf16_t*)(ws + WS_H)}; pg8::SlotIO io{ws + WS_SGB, (unsigned*)(ws + WS_SKFLAG) + (size_t)(5 * l + 4) * 256 * 64, vcu, same_next};
            pg8::gemm_phase<EpiRes, pg8::StreamK<D / 256, DH / 128, 0>, DH, 1 << 20>(lds, g, S, E, io, wave);
            SEAM(pb + 5);
        }
    }
    if (IN(13)) for (int rep = 0; rep < REP_FIN; ++rep) final_phase(fresh(kp), gw, NGW, lane_id());
#undef IN
#undef SEAM
}

extern "C" void kernel_launch(void* const* d_in, const int* in_sizes, int n_in, void* d_out, int out_size, void* d_ws, size_t ws_size, hipStream_t stream) {
    static int grid = 0;
    if (grid == 0) {
        if (n_in != 20 || (size_t)out_size != OUT_TOTAL || ws_size < WS_END) { fprintf(stderr, "kernel_launch: unexpected shapes (n_in %d, out %d, ws %zu); nothing launched\n", n_in, out_size, ws_size); grid = -1; return; }
        int dev = 0, cus = 0, per_cu = 0;
        if (hipGetDevice(&dev) != hipSuccess || hipDeviceGetAttribute(&cus, hipDeviceAttributeMultiprocessorCount, dev) != hipSuccess) { grid = -1; return; }
        if (hipFuncSetAttribute((const void*)mega_fwd, hipFuncAttributeMaxDynamicSharedMemorySize, LDS_BYTES) != hipSuccess) { fprintf(stderr, "kernel_launch: hipFuncSetAttribute failed\n"); grid = -1; return; }
        if (hipOccupancyMaxActiveBlocksPerMultiprocessor(&per_cu, (const void*)mega_fwd, 512, LDS_BYTES) != hipSuccess || per_cu < 1) { fprintf(stderr, "kernel_launch: occupancy query says %d blocks per CU\n", per_cu); per_cu = 1; }
        (void)hipGetLastError();
        if (cus != 256) { fprintf(stderr, "kernel_launch: built for a 256-CU device (got %d)\n", cus); grid = -1; return; }
        grid = cus;
    }
    if (grid < 0) return;
    if (hipMemsetAsync((char*)d_ws + WS_CTL, 0, CTL_ZERO_BYTES, stream) != hipSuccess) { fprintf(stderr, "kernel_launch: memset failed\n"); return; }
    Args a{};
    for (int i = 0; i < 20; ++i) a.in[i] = (const float*)d_in[i];
    a.out = (float*)d_out; a.ws = (unsigned char*)d_ws;
    for (int li = 0; li < MK_N_LAUNCHES; ++li) {
        a.ph_lo = (MK_N_LAUNCHES == 1) ? 0 : li; a.ph_hi = (MK_N_LAUNCHES == 1) ? NPHASE : li + 1;
        hipLaunchKernelGGL(mega_fwd, dim3(grid), dim3(512), LDS_BYTES, stream, a);
        const hipError_t le = hipPeekAtLastError();
        if (le != hipSuccess) { fprintf(stderr, "kernel_launch: launch %d failed: %s\n", li, hipGetErrorName(le)); break; }
    }
}
```

```cpp
#include <hip/hip_runtime.h>
#include <cstdio>
#include <cstdint>

#ifndef REP_P0
#define REP_P0 1
#endif
#ifndef REP_G1
#define REP_G1 1
#endif
#ifndef REP_G4
#define REP_G4 1
#endif
#ifndef REP_FIN
#define REP_FIN 1
#endif
#ifndef DRY_G2
#define DRY_G2 0
#endif
#ifndef DRY_G3
#define DRY_G3 0
#endif
#ifndef DRY_G5
#define DRY_G5 0
#endif
#ifndef MK_N_LAUNCHES
#define MK_N_LAUNCHES 1
#endif

constexpr int D = 1024, NIN = 7168, DH = 2816, NGU = 2 * DH;
constexpr int NPROMPT = 8, TP = 2064, NSAMP = 16, TS = 16, NSTREAM = NPROMPT + NSAMP;
constexpr int ROW_S0 = NPROMPT * TP;
constexpr int MREAL = ROW_S0 + NSAMP * TS;
constexpr int MPAD = 16896, NPAN = MPAD / 256;
static_assert(NPAN == 66, "StreamK assumes 66 row panels (a last group of two)");
constexpr float RMS_EPS = 1e-6f, LN_EPS = 1e-5f;
constexpr int NPHASE = 14;

__device__ __forceinline__ int opaque_v(int x) { asm volatile("" : "+v"(x)); return x; }
__device__ __forceinline__ int opaque_s(int x) { asm volatile("" : "+s"(x)); return x; }
__device__ __forceinline__ int lane_id() { int x; asm volatile("v_mbcnt_lo_u32_b32 %0, -1, 0\n\tv_mbcnt_hi_u32_b32 %0, -1, %0" : "=v"(x)); return x; }
namespace pg8 {
#define PG8_LAS __attribute__((address_space(3)))
typedef unsigned short bf16_t;
typedef short bf16x8 __attribute__((ext_vector_type(8)));
typedef float f32x4 __attribute__((ext_vector_type(4)));
typedef unsigned u32x4 __attribute__((ext_vector_type(4)));
constexpr int BM = 256, BK = 64, HALF = 128, HTB = HALF * BK * 2  , STAGE_BYTES = 8 * HTB, NXCD = 8, WGM = 8;

__host__ __device__ __forceinline__ int lds_byte(int r, int c) { const int st = (r >> 4) * 2 + (c >> 5), rr = r & 15, cc = c & 31, ob = rr * 64 + cc * 2; return st * 1024 + (ob ^ (((ob >> 9) & 1) << 5)); }
__host__ __device__ __forceinline__ void stage_rc(int b, int& R, int& C) { const int st = b / 1024, sb = b % 1024, swz = sb ^ (((sb >> 9) & 1) << 5); R = (st >> 1) * 16 + swz / 64; C = (st & 1) * 32 + (swz % 64) / 2; }
__host__ __device__ __forceinline__ int perm32(int rho) { const int n = rho >> 4, i = rho & 15; return 8 * (i >> 2) + 4 * n + (i & 3); }

struct Unit { int pm, pn, kb, nk, flags; };
struct Gemm { const bf16_t* A; const bf16_t* Bt; const bf16_t* A2; const bf16_t* Bt2; };
struct SlotIO { unsigned char* slots; unsigned* flags; int me; int same_next; };

template <int NN  , int P  , int KSPLIT  , int NW = 256  >
struct StreamK {
    static constexpr int nM = 66, nN = NN, NTILES = nM * nN, N_DP_ROUNDS = (NTILES / NW - 1) > 0 ? (NTILES / NW - 1) : 0, N_DP = NW * N_DP_ROUNDS;
    static constexpr bool WHOLE = (NTILES % NW == 0) && KSPLIT == 0;
    int c, t_first, o_s, t_last, o_e, has_head, has_tail, first_full, n_full;
    __device__ static int cut(int c) { return (int)((long)(NTILES - N_DP) * P * c / NW); }
    __device__ void init(int c_) {
        c = c_;
        const int s = cut(c), e = cut(c + 1);
        t_first = s / P; o_s = s % P; t_last = (e - 1) / P; o_e = e - t_last * P;
        has_tail = (o_s > 0 && e > s); has_head = (o_e < P && e > s && !(t_last == t_first && o_s > 0));
        first_full = has_tail ? t_first + 1 : t_first; const int last_full = has_head ? t_last - 1 : t_last; n_full = (e > s) ? last_full - first_full + 1 : 0; if (n_full < 0) n_full = 0;
    }
    __device__ static void tile_of(int t, Unit& u) { constexpr int nig = WGM * nN; const int gid = t / nig, fm = gid * WGM, r = t - gid * nig;
        if (nM - fm >= WGM) { u.pm = fm + (r & (WGM - 1)); u.pn = r / WGM; } else { u.pm = fm + (r & 1); u.pn = r >> 1; } }
    __device__ bool base(int i, Unit& u) const {
        if (has_head) { if (i == 0) { tile_of(N_DP + t_last, u); u.kb = 0; u.nk = 2 * o_e; u.flags = 2; return true; } --i; }
        if (i < N_DP_ROUNDS) { tile_of(NW * i + c, u); u.kb = 0; u.nk = 2 * P; u.flags = 0; return true; } i -= N_DP_ROUNDS;
        if (i < n_full) { tile_of(N_DP + first_full + i, u); u.kb = 0; u.nk = 2 * P; u.flags = 0; return true; } i -= n_full;
        if (has_tail && i == 0) { tile_of(N_DP + t_first, u); u.kb = 2 * o_s; u.nk = 2 * (P - o_s); u.flags = 1; return true; }
        return false;
    }
    mutable int it_i, it_second; mutable Unit it_u;
    __device__ void start() const { it_i = 0; it_second = 0; }
    __device__ bool advance(Unit& u) const {
        if constexpr (KSPLIT > 0) { if (it_second) { u = it_u; u.nk = it_u.kb + it_u.nk - KSPLIT; u.kb = KSPLIT; u.flags = 8 | (it_u.flags & 2); it_second = 0; return true; } }
        if (!base(it_i, u)) return false; ++it_i;
        if constexpr (KSPLIT > 0) {
            if (u.kb < KSPLIT && u.kb + u.nk > KSPLIT) { it_u = u; it_second = 1; u.nk = KSPLIT - u.kb; u.flags = (u.flags & 1) | 4; }
            else if (u.kb + u.nk == KSPLIT) u.flags |= 16;
        }
        return true;
    }
};

typedef __bf16 bf16x2_t __attribute__((ext_vector_type(2)));
typedef float f32x2_t __attribute__((ext_vector_type(2)));
__device__ __forceinline__ unsigned cvt_pk_bf16(float lo, float hi) { const f32x2_t v = {lo, hi}; const bf16x2_t r = __builtin_convertvector(v, bf16x2_t); return __builtin_bit_cast(unsigned, r); }

template <class Epi, class Sched, int KPITCH  , int KWRAP  >
__device__ __forceinline__ void gemm_phase(PG8_LAS unsigned char* lds, const Gemm g, const Sched& S, const Epi& E, const SlotIO io, const int wid_in  ) {
    const int wid = opaque_s(wid_in), lane = lane_id(), tid = wid * 64 + lane, wr = wid >> 2, wc = wid & 3, fr = lane & 15, fq = lane >> 4;
    constexpr int K = KPITCH;
    unsigned voffA[2], voffB[2];
#pragma unroll
    for (int i = 0; i < 2; ++i) { int R, C; stage_rc(tid * 16 + i * 8192, R, C); const int Rb = (R & ~31) + perm32(R & 31);
        voffA[i] = (unsigned)(R * K + C) * 2u; voffB[i] = (unsigned)(Rb * K + C) * 2u; }
    const size_t kstep = (size_t)(BK * 2);
    const size_t hstep = (size_t)HALF * K * 2;
    const size_t tstep = 2 * hstep;
    const unsigned ldsw = (unsigned)wid * 1024u;
    const int aoff = lds_byte(wr * 64 + fr, fq * 8), boff = lds_byte(wc * 32 + fr, fq * 8);
#define PG8_SA(b, h) (((b) * 2 + (h)) * HTB)
#define PG8_SB(b, h) ((4 + (b) * 2 + (h)) * HTB)
#define PG8_STAGE(bufoff, gbase, voff) do { _Pragma("unroll") for (int _i = 0; _i < 2; ++_i) \
        __builtin_amdgcn_global_load_lds((const unsigned*)((const char*)(gbase) + (voff)[_i]), (PG8_LAS unsigned*)(lds + (bufoff) + ldsw + _i * 8192), 16, 0, 0); } while (0)
#define PG8_LDA(dst, b, h) do { _Pragma("unroll") for (int m = 0; m < 4; ++m) _Pragma("unroll") for (int k = 0; k < 2; ++k) dst[m][k] = *(const PG8_LAS bf16x8*)(lds + PG8_SA(b, h) + aoff + m * 2048 + k * 1024); } while (0)
#define PG8_LDB(dst, b, h) do { _Pragma("unroll") for (int n = 0; n < 2; ++n) _Pragma("unroll") for (int k = 0; k < 2; ++k) dst[n][k] = *(const PG8_LAS bf16x8*)(lds + PG8_SB(b, h) + boff + n * 2048 + k * 1024); } while (0)
#define PG8_MMA(ai, bj, At, Bt) do { __builtin_amdgcn_s_setprio(1); _Pragma("unroll") for (int m = 0; m < 4; ++m) _Pragma("unroll") for (int n = 0; n < 2; ++n) _Pragma("unroll") for (int k = 0; k < 2; ++k) \
        acc[ai][bj][m][n] = __builtin_amdgcn_mfma_f32_16x16x32_bf16(Bt[n][k], At[m][k], acc[ai][bj][m][n], 0, 0, 0); __builtin_amdgcn_s_setprio(0); } while (0)
#define PG8_WAIT_V(n) asm volatile("s_waitcnt vmcnt(" #n ")" ::: "memory")
#define PG8_WAIT_L(n) asm volatile("s_waitcnt lgkmcnt(" #n ")" ::: "memory")
#define PG8_BAR __builtin_amdgcn_s_barrier()
#define PG8_SCHED __builtin_amdgcn_sched_barrier(0)
#define PG8_KA(u, T) ((const char*)(((T) < KWRAP) ? g.A : g.A2) + (size_t)(u).pm * tstep + (size_t)(((T) < KWRAP) ? (T) : (T) - KWRAP) * kstep)
#define PG8_KB(u, T) ((const char*)(((T) < KWRAP) ? g.Bt : g.Bt2) + (size_t)(u).pn * tstep + (size_t)(((T) < KWRAP) ? (T) : (T) - KWRAP) * kstep)
    Unit cur, nxt; int ui = 0;
    S.start();
    if (!S.advance(cur)) return;
    f32x4 acc[2][2][4][2];
    bf16x8 At[4][2], B0[2][2], B1[2][2];
    {   const char* cA = PG8_KA(cur, cur.kb); const char* cB = PG8_KB(cur, cur.kb);
        PG8_STAGE(PG8_SB(0, 0), cB, voffB); PG8_STAGE(PG8_SB(0, 1), cB + hstep, voffB); PG8_STAGE(PG8_SA(0, 0), cA, voffA); PG8_STAGE(PG8_SA(0, 1), cA + hstep, voffA);
        if (wr == 1) PG8_BAR;
        PG8_WAIT_V(2); PG8_BAR;
        PG8_STAGE(PG8_SB(1, 0), cB + kstep, voffB); PG8_STAGE(PG8_SA(1, 0), cA + kstep, voffA); PG8_STAGE(PG8_SB(1, 1), cB + hstep + kstep, voffB);
        PG8_WAIT_V(6); PG8_BAR; }
    for (;;) {
        const bool has_next = S.advance(nxt);
        if (!Sched::WHOLE && (cur.flags & 8)) {   }
        else if (!Sched::WHOLE && (cur.flags & 1)) {
            const __amdgpu_buffer_rsrc_t rs_in = __builtin_amdgcn_make_buffer_rsrc((void*)(io.slots + (size_t)(io.me - 1) * 131072), 0, 131072, 0x00020000);
            unsigned* fl = io.flags + (size_t)(io.me - 1) * 64; unsigned spins = 0;
            while ((unsigned)__builtin_amdgcn_readfirstlane(__hip_atomic_load(fl, __ATOMIC_RELAXED, __HIP_MEMORY_SCOPE_AGENT)) < 8u) { __builtin_amdgcn_s_sleep(2); if (++spins > (1u << 22)) break; }
            asm volatile("" ::: "memory");
#pragma unroll
            for (int q = 0; q < 16; ++q) { const u32x4 w = __builtin_amdgcn_raw_buffer_load_b128(rs_in, (q * 512 + tid) * 16, 0, 16);
                acc[q >> 3][(q >> 2) & 1][q & 3][0] = (f32x4){__builtin_bit_cast(float, w.x << 16), __builtin_bit_cast(float, w.x & 0xffff0000u), __builtin_bit_cast(float, w.y << 16), __builtin_bit_cast(float, w.y & 0xffff0000u)};
                acc[q >> 3][(q >> 2) & 1][q & 3][1] = (f32x4){__builtin_bit_cast(float, w.z << 16), __builtin_bit_cast(float, w.z & 0xffff0000u), __builtin_bit_cast(float, w.w << 16), __builtin_bit_cast(float, w.w & 0xffff0000u)}; }
        } else {
#pragma unroll
            for (int a = 0; a < 2; ++a)
#pragma unroll
                for (int b = 0; b < 2; ++b)
#pragma unroll
                    for (int m = 0; m < 4; ++m)
#pragma unroll
                        for (int n = 0; n < 2; ++n) acc[a][b][m][n] = (f32x4){0.f, 0.f, 0.f, 0.f};
        }
        const int nk = cur.nk, kb = cur.kb;
        for (int t = 0; t < nk; t += 2) {
            const bool last = (t == nk - 2); const int T = kb + t;
            const char* a1 = PG8_KA(cur, T) + kstep;
            const char* a2 = last ? (has_next ? PG8_KA(nxt, nxt.kb) : PG8_KA(cur, kb)) : PG8_KA(cur, T + 2);
            const char* b2 = last ? (has_next ? PG8_KB(nxt, nxt.kb) : PG8_KB(cur, kb)) : PG8_KB(cur, T + 2);
            const char* a3 = a2 + kstep; const char* b3 = b2 + kstep;
            PG8_LDB(B0, 0, 0); PG8_LDB(B1, 0, 1); PG8_SCHED; PG8_LDA(At, 0, 0); PG8_STAGE(PG8_SA(1, 1), a1 + hstep, voffA);
            PG8_WAIT_V(8); PG8_WAIT_L(0); PG8_BAR; PG8_MMA(0, 0, At, B0); PG8_MMA(0, 1, At, B1); PG8_BAR; PG8_SCHED;
            if constexpr (Epi::NEED_RSTD) { if (t == 0) { E.prefetch(cur, wid); PG8_SCHED; } }
            PG8_LDA(At, 0, 1); PG8_STAGE(PG8_SB(0, 0), b2, voffB); PG8_STAGE(PG8_SB(0, 1), b2 + hstep, voffB); PG8_STAGE(PG8_SA(0, 0), a2, voffA);
            PG8_WAIT_V(8); PG8_WAIT_L(0); PG8_BAR; PG8_MMA(1, 0, At, B0); PG8_MMA(1, 1, At, B1); PG8_BAR; PG8_SCHED;
            PG8_LDB(B0, 1, 0); PG8_LDB(B1, 1, 1); PG8_SCHED; PG8_LDA(At, 1, 0); PG8_STAGE(PG8_SA(0, 1), a2 + hstep, voffA);
            PG8_WAIT_V(8); PG8_WAIT_L(0); PG8_BAR; PG8_MMA(0, 0, At, B0); PG8_MMA(0, 1, At, B1); PG8_BAR; PG8_SCHED;
            PG8_LDA(At, 1, 1); PG8_STAGE(PG8_SB(1, 0), b3, voffB); PG8_STAGE(PG8_SB(1, 1), b3 + hstep, voffB); PG8_STAGE(PG8_SA(1, 0), a3, voffA);
            PG8_WAIT_V(8); PG8_WAIT_L(0); PG8_BAR; PG8_MMA(1, 0, At, B0); PG8_MMA(1, 1, At, B1); PG8_BAR; PG8_SCHED;
        }
        if (wr == 0) PG8_BAR;
        if constexpr (Epi::KSPLIT > 0) { if (cur.flags & (4 | 16)) E.mid(acc, cur, wr, wc, fr, fq); }
        if (!Sched::WHOLE && (cur.flags & 4)) {   }
        else if (!Sched::WHOLE && (cur.flags & 2)) {
            const __amdgpu_buffer_rsrc_t rs_out = __builtin_amdgcn_make_buffer_rsrc((void*)(io.slots + (size_t)io.me * 131072), 0, 131072, 0x00020000);
#pragma unroll
            for (int q = 0; q < 16; ++q) { const f32x4 v0 = acc[q >> 3][(q >> 2) & 1][q & 3][0], v1 = acc[q >> 3][(q >> 2) & 1][q & 3][1];
                u32x4 w; w.x = cvt_pk_bf16(v0[0], v0[1]); w.y = cvt_pk_bf16(v0[2], v0[3]); w.z = cvt_pk_bf16(v1[0], v1[1]); w.w = cvt_pk_bf16(v1[2], v1[3]);
                if (io.same_next) __builtin_amdgcn_raw_buffer_store_b128(w, rs_out, (q * 512 + tid) * 16, 0, 0);
                else __builtin_amdgcn_raw_buffer_store_b128(w, rs_out, (q * 512 + tid) * 16, 0, 16); }
            asm volatile("s_waitcnt vmcnt(0)" ::: "memory");
            if (lane == 0) __hip_atomic_fetch_add(io.flags + (size_t)io.me * 64, 1u, __ATOMIC_RELAXED, __HIP_MEMORY_SCOPE_AGENT);
        } else E(acc, cur, wr, wc, fr, fq);
        if (!has_next) break;
        cur = nxt; ++ui;
        if (wr == 1) PG8_BAR;
    }
    PG8_WAIT_V(0);
    PG8_BAR;
#undef PG8_SA
#undef PG8_SB
#undef PG8_STAGE
#undef PG8_LDA
#undef PG8_LDB
#undef PG8_MMA
#undef PG8_WAIT_V
#undef PG8_WAIT_L
#undef PG8_BAR
#undef PG8_SCHED
#undef PG8_KA
#undef PG8_KB
}
}

using pg8::bf16_t; using pg8::f32x4; using pg8::u32x4; using pg8::Unit; using pg8::cvt_pk_bf16;
__device__ __forceinline__ unsigned cvt_pk_bf16_pin(float lo, float hi) { unsigned r; asm volatile("v_cvt_pk_bf16_f32 %0, %1, %2" : "=v"(r) : "v"(lo), "v"(hi)); return r; }
#define GAS __attribute__((address_space(1)))
#define LAS __attribute__((address_space(3)))
typedef unsigned u32x2 __attribute__((ext_vector_type(2)));
typedef float f32x2 __attribute__((ext_vector_type(2)));
#define LDS_WAIT() asm volatile("s_waitcnt lgkmcnt(0)" ::: "memory")
#define VM_WAIT() asm volatile("s_waitcnt vmcnt(0)" ::: "memory")

__device__ __forceinline__ float bf_lo(unsigned w) { return __builtin_bit_cast(float, w << 16); }
__device__ __forceinline__ float bf_hi(unsigned w) { return __builtin_bit_cast(float, w & 0xffff0000u); }
__device__ __forceinline__ float sigmoid_fast(float x) { return __builtin_amdgcn_rcpf(1.0f + __builtin_amdgcn_exp2f(-1.4426950408889634f * x)); }
template <int M> __device__ __forceinline__ float swz_xor(float v) { return __builtin_bit_cast(float, __builtin_amdgcn_ds_swizzle(__builtin_bit_cast(int, v), 0x1f | (M << 10))); }
__device__ __forceinline__ float sum_xor32(float v) { const unsigned b = __builtin_bit_cast(unsigned, v); auto r = __builtin_amdgcn_permlane32_swap(b, b, false, false); return __builtin_bit_cast(float, (unsigned)r[0]) + __builtin_bit_cast(float, (unsigned)r[1]); }
__device__ __forceinline__ float sum_fq(float v) { v += swz_xor<16>(v); return sum_xor32(v); }
__device__ __forceinline__ float wave_sum(float v) { v += swz_xor<1>(v); v += swz_xor<2>(v); v += swz_xor<4>(v); v += swz_xor<8>(v); v += swz_xor<16>(v); return sum_xor32(v); }

__device__ __forceinline__ float sum2_swap32(float a, float b) { auto r = __builtin_amdgcn_permlane32_swap(__builtin_bit_cast(unsigned, a), __builtin_bit_cast(unsigned, b), false, false); return __builtin_bit_cast(float, (unsigned)r[0]) + __builtin_bit_cast(float, (unsigned)r[1]); }
__device__ __forceinline__ float sum2_swap16(float a, float b) { auto r = __builtin_amdgcn_permlane16_swap(__builtin_bit_cast(unsigned, a), __builtin_bit_cast(unsigned, b), false, false); return __builtin_bit_cast(float, (unsigned)r[0]) + __builtin_bit_cast(float, (unsigned)r[1]); }
__device__ __forceinline__ float reduce48(const float (&v)[48], int lane) {
    float w[32];
#pragma unroll
    for (int i = 0; i < 32; ++i) w[i] = sum2_swap32(v[i], i + 32 < 48 ? v[i + 32] : 0.f);
    float x[16];
#pragma unroll
    for (int i = 0; i < 16; ++i) x[i] = sum2_swap16(w[i], w[i + 16]);
    float y[8]; const bool b8 = (lane & 8) != 0;
#pragma unroll
    for (int i = 0; i < 8; ++i) { const float keep = b8 ? x[i + 8] : x[i], send = b8 ? x[i] : x[i + 8]; y[i] = keep + swz_xor<8>(send); }
    float z[4]; const bool b4 = (lane & 4) != 0;
#pragma unroll
    for (int i = 0; i < 4; ++i) { const float keep = b4 ? y[i + 4] : y[i], send = b4 ? y[i] : y[i + 4]; z[i] = keep + swz_xor<4>(send); }
    float q[2]; const bool b2 = (lane & 2) != 0;
#pragma unroll
    for (int i = 0; i < 2; ++i) { const float keep = b2 ? z[i + 2] : z[i], send = b2 ? z[i] : z[i + 2]; q[i] = keep + swz_xor<2>(send); }
    const bool b1 = (lane & 1) != 0; const float keep = b1 ? q[1] : q[0], send = b1 ? q[0] : q[1];
    return keep + swz_xor<1>(send);
}

constexpr size_t MiB = 1u << 20;
constexpr size_t ACT_BYTES = (size_t)MPAD * D * 2;
constexpr size_t WS_CTL = 0, CTL_ZERO_BYTES = 1 * MiB;
constexpr size_t WS_XCCTAB = 32 * 1024;
constexpr size_t WS_SKFLAG = 64 * 1024;
static_assert(WS_SKFLAG + (size_t)10 * 256 * 256 <= CTL_ZERO_BYTES, "ctl map");
constexpr size_t SSQ_ONE = (size_t)16 * MPAD * 4;
constexpr size_t WS_SSQ = 1 * MiB;
constexpr size_t WS_HALOA = WS_SSQ + 5 * SSQ_ONE;
constexpr size_t WS_HALOB = WS_HALOA + (size_t)2 * NSTREAM * 30 * D * 2;
constexpr size_t WS_W0 = 10 * MiB;
constexpr size_t W_IN_B = (size_t)NIN * D * 2, W_AB_B = (size_t)2 * D * D * 2, W_O_B = (size_t)D * D * 2, W_GU_B = (size_t)NGU * D * 2, W_D_B = (size_t)D * DH * 2;
constexpr size_t WS_W0_IN = WS_W0, WS_W0_AB = WS_W0_IN + W_IN_B, WS_W0_O = WS_W0_AB + W_AB_B, WS_W0_GU = WS_W0_O + W_O_B, WS_W0_D = WS_W0_GU + W_GU_B, WS_W0_END = WS_W0_D + W_D_B;
constexpr size_t WS_W1_AB = WS_W0_END, WS_W1_O = WS_W1_AB + W_AB_B, WS_W1_END = WS_W1_O + W_O_B;
constexpr size_t WS_H = 53 * MiB;
constexpr size_t WS_UA = 86 * MiB, WS_ZB = WS_UA + ACT_BYTES, WS_BB = WS_ZB + ACT_BYTES, WS_SGA = WS_BB + ACT_BYTES, WS_SGB = WS_SGA + ACT_BYTES, WS_END = WS_SGB + ACT_BYTES;
constexpr size_t WS_F = WS_UA;
static_assert(WS_HALOB + (size_t)2 * NSTREAM * 2 * D * 2 <= WS_W0, "ws map: small buffers");
static_assert(WS_W1_END <= WS_H && WS_H + ACT_BYTES <= WS_UA && WS_END + SSQ_ONE <= 256 * MiB, "ws map (a dummy ssq set for timing probes sits at WS_END)");
static_assert(WS_F + (size_t)MPAD * DH * 2 <= WS_SGA, "F overlay");
constexpr size_t DO_CA = 0, DO_W1_IN = ACT_BYTES, DO_W1_GU = DO_W1_IN + W_IN_B, DO_W1_D = DO_W1_GU + W_GU_B, DO_END = DO_W1_D + W_D_B;
static_assert(DO_END <= (size_t)NPROMPT * 2048 * D * 4, "d_out scratch must stay inside the y_prompt region");
constexpr size_t OUT_YP = 0, OUT_YS = OUT_YP + (size_t)NPROMPT * 2048 * D, OUT_NAP = OUT_YS + (size_t)NSAMP * TS * D, OUT_NBP = OUT_NAP + (size_t)2 * NPROMPT * 30 * D,
                 OUT_NAS = OUT_NBP + (size_t)2 * NPROMPT * 2 * D, OUT_NBS = OUT_NAS + (size_t)2 * NSAMP * 30 * D, OUT_TOTAL = OUT_NBS + (size_t)2 * NSAMP * 2 * D;

constexpr int RING_BYTES = 131072, RSTD_OFF = RING_BYTES, RSTD_PITCH = 1040  , LDSCTL_OFF = RSTD_OFF + 16 * RSTD_PITCH, LDS_BYTES = 149504;

#define XB_TMO      128
#define XB_XCNT(j)  (256  + 64 * (j))
#define XB_XSUB(j)  (1280 + 64 * (j))
#define XB_XGEN(j)  (2304 + 64 * (j))
#define XB_TOP      3328
#define XB_TOPGEN   3392
#define XCD_BAR_WORDS 3456
#define XB_SPIN_CAP (1u << 18)
__device__ __forceinline__ unsigned xb_ld(unsigned* p)              { return __hip_atomic_load(p, __ATOMIC_RELAXED, __HIP_MEMORY_SCOPE_AGENT); }
__device__ __forceinline__ unsigned xb_add(unsigned* p, unsigned v) { return __hip_atomic_fetch_add(p, v, __ATOMIC_RELAXED, __HIP_MEMORY_SCOPE_AGENT); }
__device__ __forceinline__ unsigned xb_xcc_id() { return (unsigned)__builtin_amdgcn_s_getreg((3 << 11) | 20) & 0xFu; }
#define XB_SPIN(cond, bar) do { unsigned _sp = 0; while (cond) { __builtin_amdgcn_s_sleep(1); \
    if ((++_sp & 255u) == 0u) { if (xb_ld(&(bar)[XB_TMO])) break; if (_sp > XB_SPIN_CAP) { atomicAdd(&(bar)[XB_TMO], 1u); break; } } } } while (0)
struct XcdBarrier { unsigned* bar; unsigned x; volatile LAS unsigned* st; };
__device__ __forceinline__ XcdBarrier xcd_barrier_post(unsigned* bar, volatile LAS unsigned* st) {
    XcdBarrier b; b.bar = bar; b.x = xb_xcc_id(); b.st = st;
    if (threadIdx.x == 0) { const unsigned old = xb_add(&bar[XB_XCNT(b.x)], 1u); st[2] = (old == 0u) ? 1u : 0u; }
    return b;
}
__device__ __forceinline__ void xcd_barrier_complete(unsigned* bar, unsigned x, unsigned& nloc, unsigned& nx) {
    const unsigned G = gridDim.x * gridDim.y * gridDim.z;
    unsigned sum, cnt, mine, sp = 0u;
    for (;;) {
        sum = 0u; cnt = 0u; mine = 0u;
#pragma unroll
        for (unsigned j = 0; j < 16; ++j) { const unsigned c = xb_ld(&bar[XB_XCNT(j)]); sum += c; cnt += (c > 0u) ? 1u : 0u; mine = (j == x) ? c : mine; }
        if (sum == G) break;
        __builtin_amdgcn_s_sleep(1);
        if ((++sp & 255u) == 0u) { if (xb_ld(&bar[XB_TMO])) break; if (sp > XB_SPIN_CAP) { atomicAdd(&bar[XB_TMO], 1u); break; } }
    }
    nloc = mine > 0u ? mine : 1u; nx = cnt > 0u ? cnt : 1u;
}
__device__ __forceinline__ void xcd_barrier(const XcdBarrier& b, const int wave) {
    asm volatile("s_waitcnt vmcnt(0)" ::: "memory");
    __syncthreads();
    if (wave == 0 && lane_id() == 0) {
        unsigned* bar = b.bar;
        __builtin_amdgcn_s_waitcnt(0);
        unsigned nloc = b.st[0], nx = b.st[1];
        if (nloc == 0u) { xcd_barrier_complete(bar, b.x, nloc, nx); b.st[0] = nloc; b.st[1] = nx; }
        const unsigned k = b.st[3] + 1u; b.st[3] = k;
        __builtin_amdgcn_fence(__ATOMIC_ACQUIRE, "agent");
        asm volatile("s_waitcnt vmcnt(0)" ::: "memory");
        if (b.st[2] == 0u) {
            (void)__hip_atomic_fetch_add(&bar[XB_XSUB(b.x)], 1u, __ATOMIC_RELAXED, __HIP_MEMORY_SCOPE_AGENT);
        } else {
            const unsigned want = (nloc - 1u) * k;
            XB_SPIN(xb_ld(&bar[XB_XSUB(b.x)]) < want, bar);
            __builtin_amdgcn_fence(__ATOMIC_RELEASE, "agent");
            asm volatile("s_waitcnt vmcnt(0)" ::: "memory");
            (void)__hip_atomic_fetch_add(&bar[XB_TOP], 1u, __ATOMIC_RELAXED, __HIP_MEMORY_SCOPE_AGENT);
        }
        const unsigned want_top = nx * k;
        XB_SPIN(xb_ld(&bar[XB_TOP]) < want_top, bar);
        asm volatile("s_waitcnt vmcnt(0)" ::: "memory");
    }
    __syncthreads();
}


__device__ __forceinline__ void sigmoid8(const float (&x)[8], float (&s)[8]) {
    float e[8];
#pragma unroll
    for (int k = 0; k < 8; ++k) e[k] = __builtin_amdgcn_exp2f(-1.4426950408889634f * x[k]);
#pragma unroll
    for (int k = 0; k < 8; ++k) e[k] = 1.0f + e[k];
#pragma unroll
    for (int k = 0; k < 8; ++k) s[k] = __builtin_amdgcn_rcpf(e[k]);
}
__device__ __forceinline__ void load_rstd(const LAS unsigned char* rl, int wr, int fr, int fq, float (&rs)[2][4]) {
    const LAS float* p = (const LAS float*)(rl + fq * 4 * RSTD_PITCH) + wr * 64 + fr;
#pragma unroll
    for (int ai = 0; ai < 2; ++ai)
#pragma unroll
        for (int m = 0; m < 4; ++m) {
            float s = 0.f;
#pragma unroll
            for (int j = 0; j < 4; ++j) s += p[j * (RSTD_PITCH / 4) + ai * 128 + m * 16];
            s = sum_fq(s);
            rs[ai][m] = __builtin_amdgcn_rsqf(s * (1.0f / D) + RMS_EPS);
        }
}
struct RstdPrefetch {
    static constexpr bool NEED_RSTD = true;
    const float* ssq; LAS unsigned char* rl;
    __device__ __forceinline__ void prefetch(const Unit& u, int wid) const {
        const unsigned lo = (unsigned)lane_id() * 16u;
#pragma unroll
        for (int i = 0; i < 2; ++i) { const int j = wid * 2 + i;
            __builtin_amdgcn_global_load_lds((const unsigned*)((const char*)ssq + ((size_t)j * MPAD + (size_t)u.pm * 256) * 4 + lo), (LAS unsigned*)(rl + j * RSTD_PITCH), 16, 0, 0); }
    }
};
struct Epi1 : RstdPrefetch {
    static constexpr int KSPLIT = 0;
    bf16_t* ACT5;
    static __device__ __forceinline__ f32x2 pr(const f32x4 (&acc)[2][2][4][2], int ai, int bj, int m, int q) { return (f32x2){acc[ai][bj][m][q >> 1][(2 * q) & 3], acc[ai][bj][m][q >> 1][(2 * q + 1) & 3]}; }
    __device__ __forceinline__ void operator()(const f32x4 (&acc)[2][2][4][2], const Unit& u, int wr, int wc, int fr, int fq) const {
        asm volatile("" : "+v"(fr), "+v"(fq));
        const int row0 = u.pm * 256 + wr * 64 + fr;
        float rs[2][4]; load_rstd(rl, wr, fr, fq, rs);
        const int pn = u.pn;
        if (pn < 16) {
            bf16_t* O = ACT5 + (size_t)(pn >> 3) * ((size_t)MPAD * D) + (pn & 7) * 128 + wc * 32 + 8 * fq;
            if (pn < 8) {
#pragma unroll
                for (int ai = 0; ai < 2; ++ai)
#pragma unroll
                    for (int m = 0; m < 4; ++m) { const float r = rs[ai][m], rn = r * -1.4426950408889634f;
                        f32x2 e[4]; unsigned wq[4];
#pragma unroll
                        for (int q = 0; q < 4; ++q) { const f32x2 t = pr(acc, ai, 1, m, q) * rn; e[q] = (f32x2){__builtin_amdgcn_exp2f(t.x), __builtin_amdgcn_exp2f(t.y)}; }
#pragma unroll
                        for (int q = 0; q < 4; ++q) { const f32x2 d = e[q] + 1.0f; const f32x2 s = {__builtin_amdgcn_rcpf(d.x), __builtin_amdgcn_rcpf(d.y)}; const f32x2 o = (pr(acc, ai, 0, m, q) * r) * s; wq[q] = cvt_pk_bf16(o.x, o.y); }
                        u32x4 w; w.x = wq[0]; w.y = wq[1]; w.z = wq[2]; w.w = wq[3];
                        *(u32x4*)(O + (size_t)(row0 + ai * 128 + m * 16) * D) = w; }
            } else {
#pragma unroll
                for (int ai = 0; ai < 2; ++ai)
#pragma unroll
                    for (int m = 0; m < 4; ++m) { const float r2 = rs[ai][m] * rs[ai][m]; unsigned wq[4];
#pragma unroll
                        for (int q = 0; q < 4; ++q) { const f32x2 o = (pr(acc, ai, 0, m, q) * pr(acc, ai, 1, m, q)) * r2; wq[q] = cvt_pk_bf16(o.x, o.y); }
                        u32x4 w; w.x = wq[0]; w.y = wq[1]; w.z = wq[2]; w.w = wq[3];
                        *(u32x4*)(O + (size_t)(row0 + ai * 128 + m * 16) * D) = w; }
            }
        } else if (pn < 20) {
            bf16_t* O = ACT5 + (size_t)2 * ((size_t)MPAD * D) + (pn - 16) * 256 + wc * 32 + 8 * fq;
#pragma unroll
            for (int ai = 0; ai < 2; ++ai)
#pragma unroll
                for (int m = 0; m < 4; ++m) { const float r = rs[ai][m];
#pragma unroll
                    for (int bj = 0; bj < 2; ++bj) { unsigned wq[4];
#pragma unroll
                        for (int q = 0; q < 4; ++q) { const f32x2 o = pr(acc, ai, bj, m, q) * r; wq[q] = cvt_pk_bf16(o.x, o.y); }
                        u32x4 w; w.x = wq[0]; w.y = wq[1]; w.z = wq[2]; w.w = wq[3];
                        *(u32x4*)(O + (size_t)(row0 + ai * 128 + m * 16) * D + bj * 128) = w; } }
        } else {
            bf16_t* O = ACT5 + (size_t)3 * ((size_t)MPAD * D) + (pn - 20) * 128 + wc * 32 + 8 * fq;
#pragma unroll
            for (int ai = 0; ai < 2; ++ai)
#pragma unroll
                for (int m = 0; m < 4; ++m) { const float rn = rs[ai][m] * -1.4426950408889634f;
                    f32x2 ea[4], eb[4]; unsigned wo[4], ws_[4];
#pragma unroll
                    for (int q = 0; q < 4; ++q) { const f32x2 ta = pr(acc, ai, 0, m, q) * rn, tb = pr(acc, ai, 1, m, q) * rn;
                        ea[q] = (f32x2){__builtin_amdgcn_exp2f(ta.x), __builtin_amdgcn_exp2f(ta.y)}; eb[q] = (f32x2){fminf(__builtin_amdgcn_exp2f(tb.x), 1e30f), fminf(__builtin_amdgcn_exp2f(tb.y), 1e30f)}; }
#pragma unroll
                    for (int q = 0; q < 4; ++q) { const f32x2 da = ea[q] + 1.0f, db = eb[q] + 1.0f;
                        const f32x2 sa = {__builtin_amdgcn_rcpf(da.x), __builtin_amdgcn_rcpf(da.y)}, sb = {__builtin_amdgcn_rcpf(db.x), __builtin_amdgcn_rcpf(db.y)};
                        const f32x2 o = sa * db; wo[q] = cvt_pk_bf16(o.x, o.y); ws_[q] = cvt_pk_bf16(sb.x, sb.y); }
                    u32x4 w; w.x = wo[0]; w.y = wo[1]; w.z = wo[2]; w.w = wo[3];
                    *(u32x4*)(O + (size_t)(row0 + ai * 128 + m * 16) * D) = w;
                    w.x = ws_[0]; w.y = ws_[1]; w.z = ws_[2]; w.w = ws_[3];
                    *(u32x4*)(O + (size_t)MPAD * D + (size_t)(row0 + ai * 128 + m * 16) * D) = w; }
        }
    }
};
struct Epi2 {
    static constexpr int KSPLIT = 16; static constexpr bool NEED_RSTD = false;
    bf16_t* RT; const bf16_t* SGB; bf16_t* OUT;
    __device__ __forceinline__ void mid(f32x4 (&acc)[2][2][4][2], const Unit& u, int wr, int wc, int fr, int fq) const {
        const int row0 = u.pm * 256 + wr * 64 + fr; const size_t col0 = (size_t)u.pn * 256 + wc * 32 + 8 * fq;
#pragma unroll
        for (int ai = 0; ai < 2; ++ai)
#pragma unroll
            for (int m = 0; m < 4; ++m)
#pragma unroll
                for (int bj = 0; bj < 2; ++bj) { const u32x4 t = *(const u32x4*)(RT + (size_t)(row0 + ai * 128 + m * 16) * D + col0 + bj * 128);
#pragma unroll
                    for (int q = 0; q < 4; ++q) { const f32x2 o = (f32x2){acc[ai][bj][m][q >> 1][(2 * q) & 3], acc[ai][bj][m][q >> 1][(2 * q + 1) & 3]} * (f32x2){bf_lo(t[q]), bf_hi(t[q])};
                        acc[ai][bj][m][q >> 1][(2 * q) & 3] = o.x; acc[ai][bj][m][q >> 1][(2 * q + 1) & 3] = o.y; } }
    }
    __device__ __forceinline__ void operator()(const f32x4 (&acc)[2][2][4][2], const Unit& u, int wr, int wc, int fr, int fq) const {
        const int row0 = u.pm * 256 + wr * 64 + fr; const size_t col0 = (size_t)u.pn * 256 + wc * 32 + 8 * fq;
#pragma unroll
        for (int ai = 0; ai < 2; ++ai)
#pragma unroll
            for (int m = 0; m < 4; ++m)
#pragma unroll
                for (int bj = 0; bj < 2; ++bj) { const size_t off = (size_t)(row0 + ai * 128 + m * 16) * D + col0 + bj * 128;
                    const u32x4 s = *(const u32x4*)(SGB + off); unsigned wq[4];
#pragma unroll
                    for (int q = 0; q < 4; ++q) { const f32x2 o = (f32x2){bf_lo(s[q]), bf_hi(s[q])} * (f32x2){acc[ai][bj][m][q >> 1][(2 * q) & 3], acc[ai][bj][m][q >> 1][(2 * q + 1) & 3]}; wq[q] = cvt_pk_bf16(o.x, o.y); }
                    u32x4 w; w.x = wq[0]; w.y = wq[1]; w.z = wq[2]; w.w = wq[3];
                    *(u32x4*)(OUT + off) = w; }
    }
};
struct EpiRes {
    static constexpr int KSPLIT = 0; static constexpr bool NEED_RSTD = false;
    bf16_t* H; float* ssq_out; bf16_t* OUT;
    __device__ __forceinline__ void operator()(const f32x4 (&acc)[2][2][4][2], const Unit& u, int wr, int wc, int fr, int fq) const {
        const int row0 = u.pm * 256 + wr * 64 + fr; const size_t col0 = (size_t)u.pn * 256 + wc * 32 + 8 * fq;
#pragma unroll
        for (int ai = 0; ai < 2; ++ai)
#pragma unroll
            for (int m = 0; m < 4; ++m) { const int row = row0 + ai * 128 + m * 16; f32x2 sq2 = {0.f, 0.f};
#pragma unroll
                for (int bj = 0; bj < 2; ++bj) { const size_t off = (size_t)row * D + col0 + bj * 128;
                    const u32x4 t = *(const u32x4*)(H + off); unsigned wq[4];
#pragma unroll
                    for (int q = 0; q < 4; ++q) { const f32x2 o = (f32x2){bf_lo(t[q]), bf_hi(t[q])} + (f32x2){acc[ai][bj][m][q >> 1][(2 * q) & 3], acc[ai][bj][m][q >> 1][(2 * q + 1) & 3]};
                        sq2 = __builtin_elementwise_fma(o, o, sq2); wq[q] = cvt_pk_bf16(o.x, o.y); }
                    u32x4 w; w.x = wq[0]; w.y = wq[1]; w.z = wq[2]; w.w = wq[3];
                    *(u32x4*)(OUT + off) = w; }
                float sq = sq2.x + sq2.y;
                sq = sum_fq(sq);
                if (fq == 0) ssq_out[(size_t)(u.pn * 4 + wc) * MPAD + row] = sq; }
    }
};
struct Epi4 : RstdPrefetch {
    static constexpr int KSPLIT = 0;
    bf16_t* F;
    __device__ __forceinline__ void operator()(const f32x4 (&acc)[2][2][4][2], const Unit& u, int wr, int wc, int fr, int fq) const {
        asm volatile("" : "+v"(fr), "+v"(fq));
        const int row0 = u.pm * 256 + wr * 64 + fr;
        float rs[2][4]; load_rstd(rl, wr, fr, fq, rs);
        bf16_t* O = F + u.pn * 128 + wc * 32 + 8 * fq;
#pragma unroll
        for (int ai = 0; ai < 2; ++ai)
#pragma unroll
            for (int m = 0; m < 4; ++m) {
                const float r = rs[ai][m], rn = r * -1.4426950408889634f, r2 = r * r;
                f32x2 e[4], p[4];
#pragma unroll
                for (int q = 0; q < 4; ++q) { const f32x2 g = {acc[ai][0][m][q >> 1][(2 * q) & 3], acc[ai][0][m][q >> 1][(2 * q + 1) & 3]}, up = {acc[ai][1][m][q >> 1][(2 * q) & 3], acc[ai][1][m][q >> 1][(2 * q + 1) & 3]};
                    const f32x2 t = g * rn; e[q] = (f32x2){__builtin_amdgcn_exp2f(t.x), __builtin_amdgcn_exp2f(t.y)}; p[q] = (g * up) * r2; }
                unsigned wq[4];
#pragma unroll
                for (int q = 0; q < 4; ++q) { const f32x2 d = e[q] + 1.0f; const f32x2 s = {__builtin_amdgcn_rcpf(d.x), __builtin_amdgcn_rcpf(d.y)}; const f32x2 o = p[q] * s; wq[q] = cvt_pk_bf16(o.x, o.y); }
                u32x4 w; w.x = wq[0]; w.y = wq[1]; w.z = wq[2]; w.w = wq[3];
                *(u32x4*)(O + (size_t)(row0 + ai * 128 + m * 16) * DH) = w; }
    }
};

struct Args { const float* in[20]; float* out; unsigned char* ws; int ph_lo, ph_hi; };
#define KAS __attribute__((address_space(4)))
typedef const KAS Args* KArgs;
__device__ __forceinline__ KArgs fresh(KArgs p) { asm volatile("" : "+s"(p)); return p; }

__device__ __forceinline__ unsigned f2bf(float f) { unsigned u = __builtin_bit_cast(unsigned, f); return (u + 0x7fffu + ((u >> 16) & 1u)) >> 16; }
__device__ __forceinline__ unsigned pk2(float lo, float hi) { return pg8::cvt_pk_bf16(lo, hi); }
constexpr int P0_SCR = 64 * 65 * 4;
struct WItem { const float* W; int K, N; bf16_t* WT; int dest_row0; const float* gk; int kb, nb; };
template <bool NT = false> __device__ __forceinline__ void p0_item_load(const WItem& d, int lane, f32x4 (&v)[16]) {
    const float* src = d.W + (size_t)(64 * d.kb + (lane >> 4)) * d.N + 64 * d.nb + 4 * (lane & 15);
#pragma unroll
    for (int i = 0; i < 16; ++i) { if constexpr (NT) v[i] = __builtin_nontemporal_load((const f32x4*)(src + (size_t)(4 * i) * d.N)); else v[i] = *(const f32x4*)(src + (size_t)(4 * i) * d.N); }
}
template <bool NT = false> __device__ __forceinline__ void p0_item_finish(const WItem& d, LAS float* scr, int lane, const f32x4 (&v)[16]) {
    const int k0 = 64 * d.kb, K = d.K;
    const int c = lane & 7;
    f32x4 g0 = (f32x4){1.f, 1.f, 1.f, 1.f}, g1 = g0;
    if (d.gk) { g0 = *(const f32x4*)(d.gk + k0 + 8 * c); g1 = *(const f32x4*)(d.gk + k0 + 8 * c + 4); }
#pragma unroll
    for (int i = 0; i < 16; ++i) { LAS float* q = scr + (4 * i + (lane >> 4)) * 65 + 4 * (lane & 15); q[0] = v[i][0]; q[1] = v[i][1]; q[2] = v[i][2]; q[3] = v[i][3]; }
    LDS_WAIT(); asm volatile("" ::: "memory");
#pragma unroll
    for (int j = 0; j < 8; ++j) { const int n = (lane >> 3) + 8 * j; const LAS float* s = scr + (8 * c) * 65 + n;
        u32x4 o; o.x = pk2(s[0 * 65] * g0[0], s[1 * 65] * g0[1]); o.y = pk2(s[2 * 65] * g0[2], s[3 * 65] * g0[3]); o.z = pk2(s[4 * 65] * g1[0], s[5 * 65] * g1[1]); o.w = pk2(s[6 * 65] * g1[2], s[7 * 65] * g1[3]);
        if constexpr (NT) __builtin_nontemporal_store(o, (u32x4*)(d.WT + (size_t)(d.dest_row0 + n) * K + k0 + 8 * c)); else *(u32x4*)(d.WT + (size_t)(d.dest_row0 + n) * K + k0 + 8 * c) = o; }
    LDS_WAIT(); asm volatile("" ::: "memory");
}
__device__ __forceinline__ void p0_transpose_item(const float* W, int K, int N, bf16_t* WT, int dest_row0, const float* gk, LAS float* scr, int kb, int nb, int lane) {
    const WItem d{W, K, N, WT, dest_row0, gk, kb, nb}; f32x4 v[16]; p0_item_load<true>(d, lane, v); p0_item_finish(d, scr, lane, v);
}
__device__ __forceinline__ int win_map(int n0) {
    const int seg = n0 >> 10, off = n0 & 1023, p = off >> 7, j = off & 127;
    switch (seg) { case 0: return 256 * p + j; case 1: return 256 * p + 128 + j; case 2: return 4096 + off; case 3: return 2048 + 256 * p + j; case 4: return 2048 + 256 * p + 128 + j; case 5: return 5120 + 256 * p + j; default: return 5120 + 256 * p + 128 + j; }
}
constexpr int I_IN = (D / 64) * (NIN / 64), I_SQ = (D / 64) * (D / 64), I_GU = (D / 64) * (DH / 64), I_DN = (DH / 64) * (D / 64), I_LAYER = I_IN + 3 * I_SQ + 2 * I_GU + I_DN;
__device__ __forceinline__ void p0_weight_item(KArgs ap, int l, int r, LAS float* scr, int lane) {
    struct { const float* in[20]; float* out; unsigned char* ws; } a; a.ws = ap->ws; a.out = ap->out;
#pragma unroll
    for (int i = 0; i < 19; ++i) a.in[i] = ap->in[i];
    unsigned char* ws = a.ws; unsigned char* dob = (unsigned char*)a.out;
    bf16_t* w_in_t = (bf16_t*)(l ? dob + DO_W1_IN : ws + WS_W0_IN); bf16_t* w_ab_t = (bf16_t*)(ws + (l ? WS_W1_AB : WS_W0_AB)); bf16_t* w_o_t = (bf16_t*)(ws + (l ? WS_W1_O : WS_W0_O));
    bf16_t* w_gu_t = (bf16_t*)(l ? dob + DO_W1_GU : ws + WS_W0_GU); bf16_t* w_d_t = (bf16_t*)(l ? dob + DO_W1_D : ws + WS_W0_D);
    if (r < I_IN) { const int nblk = NIN / 64, kb = r / nblk, nb = r % nblk; p0_transpose_item(a.in[6] + (size_t)l * D * NIN, D, NIN, w_in_t, win_map(64 * nb), a.in[5] + l * D, scr, kb, nb, lane); return; } r -= I_IN;
    if (r < I_SQ) { const int nblk = D / 64, kb = r / nblk, nb = r % nblk; p0_transpose_item(a.in[11] + (size_t)l * D * D, D, D, w_ab_t, 64 * nb, nullptr, scr, kb, nb, lane); return; } r -= I_SQ;
    if (r < I_SQ) { const int nblk = D / 64, kb = r / nblk, nb = r % nblk; p0_transpose_item(a.in[13] + (size_t)l * D * D, D, D, w_ab_t, D + 64 * nb, nullptr, scr, kb, nb, lane); return; } r -= I_SQ;
    if (r < I_SQ) { const int nblk = D / 64, kb = r / nblk, nb = r % nblk; p0_transpose_item(a.in[14] + (size_t)l * D * D, D, D, w_o_t, 64 * nb, nullptr, scr, kb, nb, lane); return; } r -= I_SQ;
    if (r < I_GU) { const int nblk = DH / 64, kb = r / nblk, nb = r % nblk, n0 = 64 * nb; p0_transpose_item(a.in[16] + (size_t)l * D * DH, D, DH, w_gu_t, 256 * (n0 >> 7) + (n0 & 127), a.in[15] + l * D, scr, kb, nb, lane); return; } r -= I_GU;
    if (r < I_GU) { const int nblk = DH / 64, kb = r / nblk, nb = r % nblk, n0 = 64 * nb; p0_transpose_item(a.in[17] + (size_t)l * D * DH, D, DH, w_gu_t, 256 * (n0 >> 7) + 128 + (n0 & 127), a.in[15] + l * D, scr, kb, nb, lane); return; } r -= I_GU;
    { const int nblk = D / 64, kb = r / nblk, nb = r % nblk; p0_transpose_item(a.in[18] + (size_t)l * DH * D, DH, D, w_d_t, 64 * nb, nullptr, scr, kb, nb, lane); }
}
__device__ __forceinline__ WItem p0_weight_desc(KArgs ap, int l, int r) {
    struct { const float* in[20]; float* out; unsigned char* ws; } a; a.ws = ap->ws; a.out = ap->out;
#pragma unroll
    for (int i = 0; i < 19; ++i) a.in[i] = ap->in[i];
    unsigned char* ws = a.ws; unsigned char* dob = (unsigned char*)a.out;
    bf16_t* w_in_t = (bf16_t*)(l ? dob + DO_W1_IN : ws + WS_W0_IN); bf16_t* w_ab_t = (bf16_t*)(ws + (l ? WS_W1_AB : WS_W0_AB)); bf16_t* w_o_t = (bf16_t*)(ws + (l ? WS_W1_O : WS_W0_O));
    bf16_t* w_gu_t = (bf16_t*)(l ? dob + DO_W1_GU : ws + WS_W0_GU); bf16_t* w_d_t = (bf16_t*)(l ? dob + DO_W1_D : ws + WS_W0_D);
    if (r < I_IN) { const int nblk = NIN / 64, kb = r / nblk, nb = r % nblk; return WItem{a.in[6] + (size_t)l * D * NIN, D, NIN, w_in_t, win_map(64 * nb), a.in[5] + l * D, kb, nb}; } r -= I_IN;
    if (r < I_SQ) { const int nblk = D / 64, kb = r / nblk, nb = r % nblk; return WItem{a.in[11] + (size_t)l * D * D, D, D, w_ab_t, 64 * nb, nullptr, kb, nb}; } r -= I_SQ;
    if (r < I_SQ) { const int nblk = D / 64, kb = r / nblk, nb = r % nblk; return WItem{a.in[13] + (size_t)l * D * D, D, D, w_ab_t, D + 64 * nb, nullptr, kb, nb}; } r -= I_SQ;
    if (r < I_SQ) { const int nblk = D / 64, kb = r / nblk, nb = r % nblk; return WItem{a.in[14] + (size_t)l * D * D, D, D, w_o_t, 64 * nb, nullptr, kb, nb}; } r -= I_SQ;
    if (r < I_GU) { const int nblk = DH / 64, kb = r / nblk, nb = r % nblk, n0 = 64 * nb; return WItem{a.in[16] + (size_t)l * D * DH, D, DH, w_gu_t, 256 * (n0 >> 7) + (n0 & 127), a.in[15] + l * D, kb, nb}; } r -= I_GU;
    if (r < I_GU) { const int nblk = DH / 64, kb = r / nblk, nb = r % nblk, n0 = 64 * nb; return WItem{a.in[17] + (size_t)l * D * DH, D, DH, w_gu_t, 256 * (n0 >> 7) + 128 + (n0 & 127), a.in[15] + l * D, kb, nb}; } r -= I_GU;
    { const int nblk = D / 64, kb = r / nblk, nb = r % nblk; return WItem{a.in[18] + (size_t)l * DH * D, DH, D, w_d_t, 64 * nb, nullptr, kb, nb}; }
}
constexpr int NW_G1 = 231  , NW_G4 = 242  , N_HELPERS = 256 - NW_G1, BG_ITEMS = (I_LAYER - I_IN) + I_LAYER, BG_A = I_LAYER - I_IN, BG_B = BG_A + I_IN, BG_C = BG_ITEMS - I_DN;
struct WgRole { bool compute; int cc, h, vnext; };
__device__ __forceinline__ WgRole wg_role(int vcu, int NW) {
    const int idle = 256 - NW, base = idle >> 3, extra = idle & 7, xq = vcu >> 5, xr = vcu & 31, hx = base + (xq < extra ? 1 : 0), before = base * xq + (xq < extra ? xq : extra);
    WgRole r; r.compute = xr < 32 - hx; r.cc = vcu - before; r.h = before + (xr - (32 - hx)); r.vnext = (xr + 1 < 32 - hx) ? vcu + 1 : (xq + 1) * 32; return r;
}
__device__ __forceinline__ void p0_background(KArgs ap, LAS unsigned char* lds, int h, int nh, int lo, int hi, int wave, int lane) {
    LAS float* scr = (LAS float*)(lds + wave * P0_SCR);
    int it = lo + h * 8 + wave; if (it >= hi) return;
    WItem cur = (it < I_LAYER - I_IN) ? p0_weight_desc(ap, 0, I_IN + it) : p0_weight_desc(ap, 1, it - (I_LAYER - I_IN));
    f32x4 va[16]; p0_item_load<true>(cur, lane, va);
    for (;;) {
        const int nit = it + nh * 8; const bool more = nit < hi;
        const int nr = more ? nit : it;
        const WItem nxt = (nr < I_LAYER - I_IN) ? p0_weight_desc(ap, 0, I_IN + nr) : p0_weight_desc(ap, 1, nr - (I_LAYER - I_IN));
        f32x4 vb[16];
        if (more) p0_item_load<true>(nxt, lane, vb);
        p0_item_finish<true>(cur, scr, lane, va);
        if (!more) break;
#pragma unroll
        for (int i = 0; i < 16; ++i) va[i] = vb[i];
        cur = nxt; it = nit;
    }
}
__device__ __forceinline__ void p0_prologue(KArgs ap, LAS unsigned char* lds, int gw, int NGW, int wave, int lane) {
    struct { const float* in[20]; float* out; unsigned char* ws; } a; a.ws = ap->ws; a.out = ap->out;
#pragma unroll
    for (int i = 0; i < 19; ++i) a.in[i] = ap->in[i];
    LAS float* scr = (LAS float*)(lds + wave * P0_SCR);
    unsigned char* ws = a.ws;
    for (int it = gw; it < (MK_N_LAUNCHES == 1 ? I_IN : 2 * I_LAYER); it += NGW) p0_weight_item(ap, it / I_LAYER, it % I_LAYER, scr, lane);
    bf16_t* H = (bf16_t*)(ws + WS_H); float* ssq0 = (float*)(ws + WS_SSQ);
    for (int row = gw; row < MPAD; row += NGW) {
        const float* src = nullptr;
        if (row < ROW_S0) { const int b = row / TP, t = row % TP; src = t < 16 ? a.in[4] + (size_t)t * D : a.in[0] + ((size_t)b * 2048 + (t - 16)) * D; }
        else if (row < MREAL) src = a.in[1] + (size_t)(row - ROW_S0) * D;
        float s = 0.f;
#pragma unroll
        for (int j = 0; j < 4; ++j) { f32x4 v = src ? __builtin_nontemporal_load((const f32x4*)(src + 256 * j + 4 * lane)) : (f32x4){0.f, 0.f, 0.f, 0.f};
            s += (v[0] * v[0] + v[1] * v[1]) + (v[2] * v[2] + v[3] * v[3]);
            u32x2 o; o.x = pk2(v[0], v[1]); o.y = pk2(v[2], v[3]); *(u32x2*)(H + (size_t)row * D + 256 * j + 4 * lane) = o; }
        s = wave_sum(s);
        if (lane < 16) ssq0[(size_t)lane * MPAD + row] = lane == 0 ? s : 0.f;
    }
    bf16_t* haloA = (bf16_t*)(ws + WS_HALOA); bf16_t* haloB = (bf16_t*)(ws + WS_HALOB);
    for (int it = gw; it < 2 * NSTREAM * 32; it += NGW) {
        const int l = it / (NSTREAM * 32), S = (it / 32) % NSTREAM, p = it % 32;
        const float* src = nullptr; bf16_t* dst;
        if (p < 30) { dst = haloA + ((size_t)(l * NSTREAM + S) * 30 + p) * D; if (S >= NPROMPT) src = a.in[2] + ((size_t)(l * NSAMP + (S - NPROMPT)) * 30 + p) * D; }
        else { dst = haloB + ((size_t)(l * NSTREAM + S) * 2 + (p - 30)) * D; if (S >= NPROMPT) src = a.in[3] + ((size_t)(l * NSAMP + (S - NPROMPT)) * 2 + (p - 30)) * D; }
#pragma unroll
        for (int j = 0; j < 4; ++j) { f32x4 v = src ? *(const f32x4*)(src + 256 * j + 4 * lane) : (f32x4){0.f, 0.f, 0.f, 0.f};
            u32x2 o; o.x = pk2(v[0], v[1]); o.y = pk2(v[2], v[3]); *(u32x2*)(dst + 256 * j + 4 * lane) = o; }
    }
}

static_assert(true, "");
constexpr int CR = 24, N_CONV_ITEMS = NPROMPT * (TP / CR) + NSAMP;
static_assert(TP % CR == 0, "conv chunking");
constexpr int CONV_STAGE_BYTES = (CR + 30) * 2048;
static_assert(CONV_STAGE_BYTES + 8 * CR * 2 * 4 + CR * 2 * 4 <= RING_BYTES, "conv LDS");
static_assert(8 * P0_SCR <= LDSCTL_OFF, "prologue LDS");
struct ConvItem { int S, t0, nrows; size_t rowS; };
__device__ __forceinline__ ConvItem conv_item(int it) {
    ConvItem ci;
    if (it < NPROMPT * (TP / CR)) { ci.S = it / (TP / CR); ci.t0 = (it % (TP / CR)) * CR; ci.nrows = CR; ci.rowS = (size_t)ci.S * TP; }
    else { ci.S = NPROMPT + (it - NPROMPT * (TP / CR)); ci.t0 = 0; ci.nrows = TS; ci.rowS = (size_t)ROW_S0 + (size_t)(ci.S - NPROMPT) * TS; }
    return ci;
}
__device__ __forceinline__ void conv_stage_a(LAS unsigned char* lds, const bf16_t* UA, const bf16_t* haloA_l, const ConvItem& ci, int wave, int lane) {
    const bf16_t* hA = haloA_l + (size_t)ci.S * 30 * D; const bf16_t* uS = UA + ci.rowS * D;
    for (int p = wave; p < 2 * (CR + 30); p += 8) { const int r = p >> 1, h = p & 1, tp = ci.t0 - 30 + r;
        const bf16_t* src = tp >= 0 ? uS + (size_t)tp * D : hA + (size_t)(30 + tp) * D;
        __builtin_amdgcn_global_load_lds((const unsigned*)((const char*)src + h * 1024 + lane * 16), (LAS unsigned*)(lds + r * 2048 + h * 1024), 16, 0, 2  ); }
}
__device__ __forceinline__ void conv_load_b(u32x4 (&zb)[8], u32x4 (&bb)[6], const bf16_t* ZB, const bf16_t* BB, const bf16_t* haloB_l, const ConvItem& ci, int cg, int rg) {
    const bf16_t* hB = haloB_l + (size_t)ci.S * 2 * D; const bf16_t* zS = ZB + ci.rowS * D; const int r0 = ci.t0 + 6 * rg;
    const bf16_t* z0p = r0 == 0 ? hB : zS + (size_t)(r0 - 2) * D; const bf16_t* z1p = r0 == 0 ? hB + D : zS + (size_t)(r0 - 1) * D;
    zb[0] = *(const u32x4*)(z0p + 8 * cg); zb[1] = *(const u32x4*)(z1p + 8 * cg);
    const bf16_t* zp = zS + (size_t)r0 * D + 8 * cg;
#pragma unroll
    for (int i = 0; i < 6; ++i) { zb[2 + i] = __builtin_nontemporal_load((const u32x4*)zp); zp += D; asm volatile("" : "+v"(zp)); }
    const bf16_t* bp = BB + (ci.rowS + r0) * D + 8 * cg;
#pragma unroll
    for (int i = 0; i < 6; ++i) { bb[i] = __builtin_nontemporal_load((const u32x4*)bp); bp += D; asm volatile("" : "+v"(bp)); }
}
__device__ __forceinline__ void conv_phase(KArgs ap, int l, LAS unsigned char* lds, int tid, int wave, int lane) {
    struct { const float* in[20]; float* out; unsigned char* ws; } a; a.ws = ap->ws; a.out = ap->out; a.in[2] = ap->in[2]; a.in[7] = ap->in[7]; a.in[8] = ap->in[8]; a.in[9] = ap->in[9]; a.in[10] = ap->in[10]; a.in[12] = ap->in[12];
    unsigned char* ws = a.ws;
    const bf16_t* UA = (const bf16_t*)(ws + WS_UA); const bf16_t* ZB = (const bf16_t*)(ws + WS_ZB); bf16_t* BB = (bf16_t*)(ws + WS_BB); bf16_t* CA = (bf16_t*)((unsigned char*)a.out + DO_CA);
    const bf16_t* haloA = (const bf16_t*)(ws + WS_HALOA) + (size_t)l * NSTREAM * 30 * D; const bf16_t* haloB = (const bf16_t*)(ws + WS_HALOB) + (size_t)l * NSTREAM * 2 * D;
    LAS float* red = (LAS float*)(lds + CONV_STAGE_BYTES);
    LAS float* fin = red + 8 * CR * 2;
    const LAS unsigned char* xl = lds + tid * 4;
    const int c0 = 2 * tid;
    const int cg = tid & 127, rg = tid >> 7;
    const float* cbw = a.in[12] + (size_t)l * 3 * D + 8 * cg;
    const f32x2 bias = *(const f32x2*)(a.in[8] + l * D + c0), lng = *(const f32x2*)(a.in[9] + l * D + c0), lnb = *(const f32x2*)(a.in[10] + l * D + c0);
    f32x4 wb[3][2];
#pragma unroll
    for (int k = 0; k < 3; ++k) { wb[k][0] = *(const f32x4*)(cbw + k * D); wb[k][1] = *(const f32x4*)(cbw + k * D + 4); }
    f32x2 w[31];
#define CONV_LOAD_TAPS() do { const float* wp = a.in[7] + (size_t)l * 31 * D + c0; asm volatile("" : "+v"(wp)); \
        _Pragma("unroll") for (int k = 0; k < 31; ++k) { w[k] = *(const f32x2*)wp; wp += D; asm volatile("" : "+v"(wp)); } } while (0)
    CONV_LOAD_TAPS();
    u32x4 zb[8], bb[6];
    int it = blockIdx.x; ConvItem ci = conv_item(it < N_CONV_ITEMS ? it : 0);
    __syncthreads();
    if (it < N_CONV_ITEMS) { conv_stage_a(lds, UA, haloA, ci, wave, lane); conv_load_b(zb, bb, ZB, BB, haloB, ci, cg, rg); }
    for (; it < N_CONV_ITEMS; it += gridDim.x) {
        VM_WAIT(); __syncthreads();
        f32x2 acc[CR];
#pragma unroll
        for (int i = 0; i < CR; ++i) acc[i] = bias;
#pragma unroll
        for (int j = 0; j < CR + 30; ++j) {
            const unsigned xw = *(const LAS unsigned*)(xl + j * 2048); const f32x2 xv = {bf_lo(xw), bf_hi(xw)};
#pragma unroll
            for (int i = (j - 30 > 0 ? j - 30 : 0); i <= (j < CR - 1 ? j : CR - 1); ++i) acc[i] = __builtin_elementwise_fma(w[j - i], xv, acc[i]);
            if ((j & 7) == 7) {
#pragma unroll
                for (int i = 0; i < CR; i += 4) asm volatile("" : "+v"(acc[i].x), "+v"(acc[i].y), "+v"(acc[i + 1].x), "+v"(acc[i + 1].y), "+v"(acc[i + 2].x), "+v"(acc[i + 2].y), "+v"(acc[i + 3].x), "+v"(acc[i + 3].y) :: "memory");
            }
        }
        { float pv[2 * CR];
#pragma unroll
          for (int i = 0; i < CR; ++i) { pv[2 * i] = acc[i].x + acc[i].y; pv[2 * i + 1] = acc[i].x * acc[i].x + acc[i].y * acc[i].y; }
          const float tot = reduce48(pv, lane);
          if (lane < 2 * CR) red[wave * 2 * CR + lane] = tot; }
#pragma unroll
        for (int j = 0; j < 6; ++j) if (6 * rg + j < ci.nrows) {
            unsigned o[4];
#pragma unroll
            for (int q = 0; q < 4; ++q) {
                const float c0v = wb[0][q >> 1][(2 * q) & 3] * bf_lo(zb[j][q]) + wb[1][q >> 1][(2 * q) & 3] * bf_lo(zb[j + 1][q]) + wb[2][q >> 1][(2 * q) & 3] * bf_lo(zb[j + 2][q]);
                const float c1v = wb[0][q >> 1][(2 * q + 1) & 3] * bf_hi(zb[j][q]) + wb[1][q >> 1][(2 * q + 1) & 3] * bf_hi(zb[j + 1][q]) + wb[2][q >> 1][(2 * q + 1) & 3] * bf_hi(zb[j + 2][q]);
                o[q] = cvt_pk_bf16_pin(bf_lo(bb[j][q]) * c0v, bf_hi(bb[j][q]) * c1v); }
            u32x4 w4; w4.x = o[0]; w4.y = o[1]; w4.z = o[2]; w4.w = o[3];
            __builtin_nontemporal_store(w4, (u32x4*)(BB + (ci.rowS + ci.t0 + 6 * rg + j) * D + 8 * cg)); }
        LDS_WAIT(); __syncthreads();
        const int nit = it + gridDim.x; const bool more = nit < N_CONV_ITEMS; const ConvItem cn = conv_item(more ? nit : it);
        if (more) conv_stage_a(lds, UA, haloA, cn, wave, lane);
        if (tid < CR) { float s1 = 0.f, s2 = 0.f;
#pragma unroll
            for (int wv = 0; wv < 8; ++wv) { s1 += red[(wv * CR + tid) * 2]; s2 += red[(wv * CR + tid) * 2 + 1]; }
            const float mean = s1 * (1.0f / D); float var = s2 * (1.0f / D) - mean * mean; var = var > 0.f ? var : 0.f;
            fin[tid * 2] = mean; fin[tid * 2 + 1] = __builtin_amdgcn_rsqf(var + LN_EPS); }
        LDS_WAIT(); __syncthreads();
#pragma unroll
        for (int i = 0; i < CR; ++i) if (i < ci.nrows) {
            const float mean = fin[i * 2], rstd = fin[i * 2 + 1];
            const float y0 = (acc[i].x - mean) * rstd * lng.x + lnb.x, y1 = (acc[i].y - mean) * rstd * lng.y + lnb.y;
            __builtin_nontemporal_store(cvt_pk_bf16_pin(y0 * sigmoid_fast(y0), y1 * sigmoid_fast(y1)), (unsigned*)(CA + (ci.rowS + ci.t0 + i) * D + c0)); }
        if (more) { conv_load_b(zb, bb, ZB, BB, haloB, cn, cg, rg); CONV_LOAD_TAPS(); }
        ci = cn;
    }
    VM_WAIT(); __syncthreads();
    for (int it = blockIdx.x; it < NSTREAM * 32; it += gridDim.x) {
        const int S = it / 32, p = it % 32; float* dst; f32x2 v;
        if (p < 30) {
            if (S < NPROMPT) { dst = a.out + OUT_NAP + ((size_t)(l * NPROMPT + S) * 30 + p) * D; const unsigned xw = *(const unsigned*)(UA + ((size_t)S * TP + (TP - 30) + p) * D + c0); v = (f32x2){bf_lo(xw), bf_hi(xw)}; }
            else { const int s = S - NPROMPT; dst = a.out + OUT_NAS + ((size_t)(l * NSAMP + s) * 30 + p) * D;
                if (p < 30 - TS) v = *(const f32x2*)(a.in[2] + ((size_t)(l * NSAMP + s) * 30 + TS + p) * D + c0);
                else { const unsigned xw = *(const unsigned*)(UA + ((size_t)ROW_S0 + (size_t)s * TS + (p - (30 - TS))) * D + c0); v = (f32x2){bf_lo(xw), bf_hi(xw)}; } }
        } else { const int q = p - 30;
            if (S < NPROMPT) { dst = a.out + OUT_NBP + ((size_t)(l * NPROMPT + S) * 2 + q) * D; const unsigned xw = *(const unsigned*)(ZB + ((size_t)S * TP + (TP - 2) + q) * D + c0); v = (f32x2){bf_lo(xw), bf_hi(xw)}; }
            else { const int s = S - NPROMPT; dst = a.out + OUT_NBS + ((size_t)(l * NSAMP + s) * 2 + q) * D; const unsigned xw = *(const unsigned*)(ZB + ((size_t)ROW_S0 + (size_t)s * TS + (TS - 2) + q) * D + c0); v = (f32x2){bf_lo(xw), bf_hi(xw)}; } }
        *(f32x2*)(dst + c0) = v;
    }
}

__device__ __forceinline__ void final_phase(KArgs ap, int gw, int NGW, int lane) {
    struct { const float* in[20]; float* out; unsigned char* ws; } a; a.ws = ap->ws; a.out = ap->out; a.in[19] = ap->in[19];
    const bf16_t* H = (const bf16_t*)(a.ws + WS_H); const float* ssq = (const float*)(a.ws + WS_SSQ + 4 * SSQ_ONE); const float* g = a.in[19];
    for (int row = gw; row < MREAL; row += NGW) {
        float* dst;
        if (row < ROW_S0) { const int b = row / TP, t = row % TP; if (t < 16) continue; dst = a.out + OUT_YP + ((size_t)b * 2048 + (t - 16)) * D; }
        else dst = a.out + OUT_YS + (size_t)(row - ROW_S0) * D;
        float s = lane < 16 ? ssq[(size_t)lane * MPAD + row] : 0.f; s = wave_sum(s);
        const float r = __builtin_amdgcn_rsqf(s * (1.0f / D) + RMS_EPS);
#pragma unroll
        for (int j = 0; j < 2; ++j) { const int c = 512 * j + 8 * lane; const u32x4 h = __builtin_nontemporal_load((const u32x4*)(H + (size_t)row * D + c));
            const f32x4 g0 = *(const f32x4*)(g + c), g1 = *(const f32x4*)(g + c + 4);
            f32x4 o0, o1; o0[0] = bf_lo(h.x) * r * g0[0]; o0[1] = bf_hi(h.x) * r * g0[1]; o0[2] = bf_lo(h.y) * r * g0[2]; o0[3] = bf_hi(h.y) * r * g0[3];
            o1[0] = bf_lo(h.z) * r * g1[0]; o1[1] = bf_hi(h.z) * r * g1[1]; o1[2] = bf_lo(h.w) * r * g1[2]; o1[3] = bf_hi(h.w) * r * g1[3];
            __builtin_nontemporal_store(o0, (f32x4*)(dst + c)); __builtin_nontemporal_store(o1, (f32x4*)(dst + c + 4)); }
    }
}

__global__ void __launch_bounds__(512, 2) mega_fwd(Args a_unused) {
    extern __shared__ __attribute__((aligned(16))) unsigned char lds_raw[];
    LAS unsigned char* lds = (LAS unsigned char*)lds_raw;
    const KArgs kp = (KArgs)__builtin_amdgcn_kernarg_segment_ptr();
    const int wave = __builtin_amdgcn_readfirstlane(threadIdx.x >> 6);
    const int G = gridDim.x, bx = blockIdx.x, vcu = (G % 8 == 0) ? (bx % 8) * (G / 8) + bx / 8 : bx;
    const int gw = vcu * 8 + wave, NGW = G * 8;
    volatile LAS unsigned* ctl = (volatile LAS unsigned*)(lds + LDSCTL_OFF);
    if (threadIdx.x < 64) ctl[threadIdx.x] = 0u;
    __syncthreads();
    XcdBarrier bar; bar.bar = (unsigned*)(kp->ws + WS_CTL); bar.x = 0; bar.st = nullptr;
    if (MK_N_LAUNCHES == 1) bar = xcd_barrier_post((unsigned*)(kp->ws + WS_CTL), ctl + 8);
    const unsigned my_xcc = xb_xcc_id();
    if (threadIdx.x == 0) __hip_atomic_store((unsigned*)(kp->ws + WS_XCCTAB) + vcu, my_xcc + 1u, __ATOMIC_RELAXED, __HIP_MEMORY_SCOPE_AGENT);
    const int lo = kp->ph_lo, hi = kp->ph_hi;
#define IN(k) (lo <= (k) && (k) < hi)
#define SEAM(k) do { if (IN(k) && IN((k) + 1)) xcd_barrier(bar, wave); } while (0)

    if (IN(0)) { for (int rep = 0; rep < REP_P0; ++rep) { p0_prologue(fresh(kp), lds, gw, NGW, wave, lane_id()); __syncthreads(); } SEAM(0); }

    const int same_next = (MK_N_LAUNCHES == 1 && vcu + 1 < G) ? (__builtin_amdgcn_readfirstlane(__hip_atomic_load((unsigned*)(kp->ws + WS_XCCTAB) + vcu + 1, __ATOMIC_RELAXED, __HIP_MEMORY_SCOPE_AGENT)) == my_xcc + 1u) : 0;
#pragma unroll 1
    for (int l = 0; l < 2; ++l) {
        const int pb = 1 + 6 * l;
        if (IN(pb + 0)) {
            const KArgs ap = fresh(kp); unsigned char* ws = ap->ws; unsigned char* dob = (unsigned char*)ap->out;
            const bf16_t* H = (const bf16_t*)(ws + WS_H); const bf16_t* w_in_t = (const bf16_t*)(l ? dob + DO_W1_IN : ws + WS_W0_IN);
            pg8::Gemm g{H, w_in_t, H, w_in_t}; pg8::StreamK<NIN / 256, D / 128, 0> S; S.init(vcu);
            Epi1 E{{(const float*)(ws + WS_SSQ + (size_t)(2 * l) * SSQ_ONE), lds + RSTD_OFF}, (bf16_t*)(ws + WS_UA)}; pg8::SlotIO io{dob + DO_CA, (unsigned*)(ws + WS_SKFLAG) + (size_t)(5 * l + 0) * 256 * 64, vcu, same_next};
            if (MK_N_LAUNCHES == 1) {
                const WgRole wr = wg_role(vcu, NW_G1);
                if (!wr.compute) p0_background(fresh(kp), lds, wr.h, N_HELPERS, l ? BG_B : 0, l ? BG_C : BG_A, wave, lane_id());
                else {
                    const KArgs ap2 = fresh(kp); unsigned char* ws2 = ap2->ws; unsigned char* dob2 = (unsigned char*)ap2->out;
                    const bf16_t* H2 = (const bf16_t*)(ws2 + WS_H); const bf16_t* w2 = (const bf16_t*)(l ? dob2 + DO_W1_IN : ws2 + WS_W0_IN);
                    const pg8::Gemm g2{H2, w2, H2, w2}; pg8::StreamK<NIN / 256, D / 128, 0, NW_G1> S2; S2.init(opaque_s(wr.cc));
                    const Epi1 E2{{(const float*)(ws2 + WS_SSQ + (size_t)(2 * l) * SSQ_ONE), lds + RSTD_OFF}, (bf16_t*)(ws2 + WS_UA)}; const pg8::SlotIO io2{dob2 + DO_CA, (unsigned*)(ws2 + WS_SKFLAG) + (size_t)(5 * l + 0) * 256 * 64, opaque_s(wr.cc), 0};
                    pg8::gemm_phase<Epi1, pg8::StreamK<NIN / 256, D / 128, 0, NW_G1>, D, 1 << 20>(lds, g2, S2, E2, io2, wave);
                }
            } else
            for (int rep = 0; rep < REP_G1; ++rep) pg8::gemm_phase<Epi1, pg8::StreamK<NIN / 256, D / 128, 0>, D, 1 << 20>(lds, g, S, E, io, wave);
            SEAM(pb + 0);
        }
        if (IN(pb + 1)) { const int l_ = lane_id(); conv_phase(fresh(kp), l, lds, wave * 64 + l_, wave, l_); SEAM(pb + 1); }
        if (IN(pb + 2)) {
            const KArgs ap = fresh(kp); unsigned char* ws = ap->ws; unsigned char* dob = (unsigned char*)ap->out;
            const bf16_t* w_ab_t = (const bf16_t*)(ws + (l ? WS_W1_AB : WS_W0_AB));
            pg8::Gemm g{(const bf16_t*)(dob + DO_CA), w_ab_t, (const bf16_t*)(ws + WS_BB), w_ab_t + (size_t)D * D}; pg8::StreamK<D / 256, 2 * D / 128, 16> S; S.init(vcu);
            Epi2 E{(bf16_t*)(ws + WS_SGA), (const bf16_t*)(ws + WS_SGB), (bf16_t*)(ws + WS_SGA)}; pg8::SlotIO io{ws + WS_UA, (unsigned*)(ws + WS_SKFLAG) + (size_t)(5 * l + 1) * 256 * 64, vcu, same_next};
            pg8::gemm_phase<Epi2, pg8::StreamK<D / 256, 2 * D / 128, 16>, D, 16>(lds, g, S, E, io, wave);
            SEAM(pb + 2);
        }
        if (IN(pb + 3)) {
            const KArgs ap = fresh(kp); unsigned char* ws = ap->ws;
            const bf16_t* MG = (const bf16_t*)(ws + WS_SGA); const bf16_t* w_o_t = (const bf16_t*)(ws + (l ? WS_W1_O : WS_W0_O));
            pg8::Gemm g{MG, w_o_t, MG, w_o_t}; pg8::StreamK<D / 256, D / 128, 0> S; S.init(vcu);
            EpiRes E{(bf16_t*)(ws + WS_H), (float*)(ws + WS_SSQ + (size_t)(2 * l + 1) * SSQ_ONE), (bf16_t*)(ws + WS_H)}; pg8::SlotIO io{ws + WS_UA, (unsigned*)(ws + WS_SKFLAG) + (size_t)(5 * l + 2) * 256 * 64, vcu, same_next};
            pg8::gemm_phase<EpiRes, pg8::StreamK<D / 256, D / 128, 0>, D, 1 << 20>(lds, g, S, E, io, wave);
            SEAM(pb + 3);
        }
        if (IN(pb + 4)) {
            const KArgs ap = fresh(kp); unsigned char* ws = ap->ws; unsigned char* dob = (unsigned char*)ap->out;
            const bf16_t* H = (const bf16_t*)(ws + WS_H); const bf16_t* w_gu_t = (const bf16_t*)(l ? dob + DO_W1_GU : ws + WS_W0_GU);
            pg8::Gemm g{H, w_gu_t, H, w_gu_t}; pg8::StreamK<NGU / 256, D / 128, 0> S; S.init(vcu);
            Epi4 E{{(const float*)(ws + WS_SSQ + (size_t)(2 * l + 1) * SSQ_ONE), lds + RSTD_OFF}, (bf16_t*)(ws + WS_F)}; pg8::SlotIO io{ws + WS_SGB, (unsigned*)(ws + WS_SKFLAG) + (size_t)(5 * l + 3) * 256 * 64, vcu, same_next};
            if (MK_N_LAUNCHES == 1) {
                const WgRole wr = wg_role(vcu, NW_G4);
                if (!wr.compute) p0_background(fresh(kp), lds, wr.h, 256 - NW_G4, l ? BG_C : BG_A, l ? BG_ITEMS : BG_B, wave, lane_id());
                else {
                    const KArgs ap2 = fresh(kp); unsigned char* ws2 = ap2->ws; unsigned char* dob2 = (unsigned char*)ap2->out;
                    const bf16_t* H2 = (const bf16_t*)(ws2 + WS_H); const bf16_t* w2 = (const bf16_t*)(l ? dob2 + DO_W1_GU : ws2 + WS_W0_GU);
                    const pg8::Gemm g2{H2, w2, H2, w2}; pg8::StreamK<NGU / 256, D / 128, 0, NW_G4> S2; S2.init(opaque_s(wr.cc));
                    const Epi4 E2{{(const float*)(ws2 + WS_SSQ + (size_t)(2 * l + 1) * SSQ_ONE), lds + RSTD_OFF}, (bf16_t*)(ws2 + WS_F)}; const pg8::SlotIO io2{ws2 + WS_SGB, (unsigned*)(ws2 + WS_SKFLAG) + (size_t)(5 * l + 3) * 256 * 64, opaque_s(wr.cc), 0};
                    pg8::gemm_phase<Epi4, pg8::StreamK<NGU / 256, D / 128, 0, NW_G4>, D, 1 << 20>(lds, g2, S2, E2, io2, wave);
                }
            } else
            for (int rep = 0; rep < REP_G4; ++rep) pg8::gemm_phase<Epi4, pg8::StreamK<NGU / 256, D / 128, 0>, D, 1 << 20>(lds, g, S, E, io, wave);
            SEAM(pb + 4);
        }
        if (IN(pb + 5)) {
            const KArgs ap = fresh(kp); unsigned char* ws = ap->ws; unsigned char* dob = (unsigned char*)ap->out;
            const bf16_t* F = (const bf16_t*)(ws + WS_F); const bf16_t* w_d_t = (const bf16_t*)(l ? dob + DO_W1_D : ws + WS_W0_D);
            pg8::Gemm g{F, w_d_t, F, w_d_t}; pg8::StreamK<D / 256, DH / 128, 0> S; S.init(vcu);
            EpiRes E{(bf16_t*)(ws + WS_H), (float*)(ws + WS_SSQ + (size_t)(2 * l + 2) * SSQ_ONE), (bf16_t*)(ws + WS_H)}; pg8::SlotIO io{ws + WS_SGB, (unsigned*)(ws + WS_SKFLAG) + (size_t)(5 * l + 4) * 256 * 64, vcu, same_next};
            pg8::gemm_phase<EpiRes, pg8::StreamK<D / 256, DH / 128, 0>, DH, 1 << 20>(lds, g, S, E, io, wave);
            SEAM(pb + 5);
        }
    }
    if (IN(13)) for (int rep = 0; rep < REP_FIN; ++rep) final_phase(fresh(kp), gw, NGW, lane_id());
#undef IN
#undef SEAM
}

extern "C" void kernel_launch(void* const* d_in, const int* in_sizes, int n_in, void* d_out, int out_size, void* d_ws, size_t ws_size, hipStream_t stream) {
    static int grid = 0;
    if (grid == 0) {
        if (n_in != 20 || (size_t)out_size != OUT_TOTAL || ws_size < WS_END) { fprintf(stderr, "kernel_launch: unexpected shapes (n_in %d, out %d, ws %zu); nothing launched\n", n_in, out_size, ws_size); grid = -1; return; }
        int dev = 0, cus = 0, per_cu = 0;
        if (hipGetDevice(&dev) != hipSuccess || hipDeviceGetAttribute(&cus, hipDeviceAttributeMultiprocessorCount, dev) != hipSuccess) { grid = -1; return; }
        if (hipFuncSetAttribute((const void*)mega_fwd, hipFuncAttributeMaxDynamicSharedMemorySize, LDS_BYTES) != hipSuccess) { fprintf(stderr, "kernel_launch: hipFuncSetAttribute failed\n"); grid = -1; return; }
        if (hipOccupancyMaxActiveBlocksPerMultiprocessor(&per_cu, (const void*)mega_fwd, 512, LDS_BYTES) != hipSuccess || per_cu < 1) { fprintf(stderr, "kernel_launch: occupancy query says %d blocks per CU\n", per_cu); per_cu = 1; }
        (void)hipGetLastError();
        if (cus != 256) { fprintf(stderr, "kernel_launch: built for a 256-CU device (got %d)\n", cus); grid = -1; return; }
        grid = cus;
    }
    if (grid < 0) return;
    if (hipMemsetAsync((char*)d_ws + WS_CTL, 0, CTL_ZERO_BYTES, stream) != hipSuccess) { fprintf(stderr, "kernel_launch: memset failed\n"); return; }
    Args a{};
    for (int i = 0; i < 20; ++i) a.in[i] = (const float*)d_in[i];
    a.out = (float*)d_out; a.ws = (unsigned char*)d_ws;
    for (int li = 0; li < MK_N_LAUNCHES; ++li) {
        a.ph_lo = (MK_N_LAUNCHES == 1) ? 0 : li; a.ph_hi = (MK_N_LAUNCHES == 1) ? NPHASE : li + 1;
        hipLaunchKernelGGL(mega_fwd, dim3(grid), dim3(512), LDS_BYTES, stream, a);
        const hipError_t le = hipPeekAtLastError();
        if (le != hipSuccess) { fprintf(stderr, "kernel_launch: launch %d failed: %s\n", li, hipGetErrorName(le)); break; }
    }
}
```
